# Optimizing an MI355X kernel written in HIP

```python
import jax, jax.numpy as jnp
from jax import lax
import numpy as np

D_MODEL = 1024
BATCH = 2
SEQ = 8192
DEPTH = 1

D_MIX = D_MODEL
ATT_HEAD_DIM = 64
ATT_HEADS = (D_MIX // 2) // ATT_HEAD_DIM
ATT_WIDTH = ATT_HEADS * ATT_HEAD_DIM
IDX_HEADS = 8
IDX_HEAD_DIM = 64
TOPK_MAX = 256
Q_BLOCK = 128
DN_HEAD_DIM = 128
DN_HEADS = (D_MIX - ATT_WIDTH) // DN_HEAD_DIM
DN_WIDTH = DN_HEADS * DN_HEAD_DIM
CONV_KERNEL = 4
CHUNK = 64
EPS = 1e-6
NEG = -1e30

SPLITS = (ATT_WIDTH, ATT_WIDTH, ATT_WIDTH, ATT_WIDTH,
          IDX_HEADS * IDX_HEAD_DIM, IDX_HEAD_DIM, IDX_HEADS,
          DN_WIDTH, DN_WIDTH, DN_WIDTH, DN_WIDTH,
          DN_HEADS, DN_HEADS)
D_IN = 4 * ATT_WIDTH + IDX_HEADS * IDX_HEAD_DIM + IDX_HEAD_DIM + IDX_HEADS + 4 * DN_WIDTH + 2 * DN_HEADS

kernel_name = "hybrid_dsa_gated_deltanet_parallel_heads"


def rms_norm(x, w):
    xf = x.astype(jnp.float32)
    y = xf * lax.rsqrt(jnp.mean(xf * xf, axis=-1, keepdims=True) + EPS)
    return (y * w.astype(jnp.float32)).astype(x.dtype)


def layer_norm_f32(x, w, b):
    xf = x.astype(jnp.float32)
    mu = jnp.mean(xf, axis=-1, keepdims=True)
    var = jnp.mean(jnp.square(xf - mu), axis=-1, keepdims=True)
    return (xf - mu) * lax.rsqrt(var + EPS) * w.astype(jnp.float32) + b.astype(jnp.float32)


def l2_norm_f32(x):
    return x * lax.rsqrt(jnp.sum(x * x, axis=-1, keepdims=True) + EPS)


def causal_depthwise_conv(x, w):
    width = w.shape[0]
    return lax.conv_general_dilated(
        x, w[:, None, :].astype(x.dtype), window_strides=(1,), padding=[(width - 1, 0)],
        dimension_numbers=("NWC", "WIO", "NWC"), feature_group_count=x.shape[-1])


def dsa_sparse_attention(q, k, v, q_idx, k_idx, w_idx):
    B, L, H, D = q.shape
    n_blk = L // Q_BLOCK
    topk = min(TOPK_MAX, L // 4)
    key_pos = jnp.arange(L)

    def blocks(t):
        return t.reshape(B, n_blk, Q_BLOCK, *t.shape[2:]).swapaxes(0, 1)

    def one_block(args):
        qb, qib, wb, blk = args
        q_pos = blk * Q_BLOCK + jnp.arange(Q_BLOCK)
        s = jnp.einsum("bqhd,bsd->bqhs", qib, k_idx)
        score = jnp.einsum("bqhs,bqh->bqs", jax.nn.relu(s), wb)
        causal = key_pos[None, :] <= q_pos[:, None]
        score = jnp.where(causal[None], score, NEG)
        _, idx = lax.top_k(score, topk)
        k_sel = jax.vmap(lambda kb, ib: kb[ib])(k, idx)
        v_sel = jax.vmap(lambda vb, ib: vb[ib])(v, idx)
        logits = jnp.einsum("bqhd,bqkhd->bhqk", qb.astype(jnp.float32),
                            k_sel.astype(jnp.float32)) * (D ** -0.5)
        valid = idx <= q_pos[None, :, None]
        logits = jnp.where(valid[:, None], logits, NEG)
        p = jax.nn.softmax(logits, axis=-1)
        o = jnp.einsum("bhqk,bqkhd->bqhd", p, v_sel.astype(jnp.float32))
        return o.astype(q.dtype)

    out = lax.map(one_block, (blocks(q), blocks(q_idx), blocks(w_idx), jnp.arange(n_blk)))
    return out.swapaxes(0, 1).reshape(B, L, H, D)


def chunk_gated_delta_rule(q, k, v, beta, g):
    B, L, H, Dk = q.shape
    Dv = v.shape[-1]
    N = L // CHUNK
    q = q * (Dk ** -0.5)

    def chunks(t):
        t = t.reshape(B, N, CHUNK, H, *t.shape[3:])
        return jnp.moveaxis(t, 3, 1)

    qc, kc, vc = chunks(q), chunks(k), chunks(v)
    bc, gc = chunks(beta), chunks(g)
    g_cum = jnp.cumsum(gc, axis=-1)
    lower = jnp.tril(jnp.ones((CHUNK, CHUNK), dtype=bool))
    strict = jnp.tril(jnp.ones((CHUNK, CHUNK), dtype=bool), -1)
    diff = g_cum[..., :, None] - g_cum[..., None, :]
    decay = jnp.exp(jnp.where(lower, diff, NEG))
    k_beta = kc * bc[..., None]
    v_beta = vc * bc[..., None]
    a_strict = jnp.where(strict, jnp.einsum("bhncd,bhnsd->bhncs", k_beta, kc) * decay, 0.0)
    m = a_strict + jnp.eye(CHUNK, dtype=a_strict.dtype)
    rhs = jnp.concatenate([v_beta, k_beta * jnp.exp(g_cum)[..., None]], axis=-1)
    sol = lax.linalg.triangular_solve(m, rhs, left_side=True, lower=True, unit_diagonal=True)
    u, w = sol[..., :Dv], sol[..., Dv:]
    intra = jnp.where(lower, jnp.einsum("bhncd,bhnsd->bhncs", qc, kc) * decay, 0.0)

    def to_scan(t):
        return jnp.moveaxis(t, 2, 0)

    def step(state, xs):
        q_i, k_i, u_i, w_i, a_i, g_i = xs
        v_new = u_i - jnp.einsum("bhcd,bhde->bhce", w_i, state)
        o_i = (jnp.einsum("bhcd,bhde->bhce", q_i * jnp.exp(g_i)[..., None], state)
               + jnp.einsum("bhcs,bhse->bhce", a_i, v_new))
        g_last = g_i[..., -1]
        state = (state * jnp.exp(g_last)[..., None, None]
                 + jnp.einsum("bhcd,bhce->bhde", k_i * jnp.exp(g_last[..., None] - g_i)[..., None], v_new))
        return state, o_i

    s0 = jnp.zeros((B, H, Dk, Dv), dtype=jnp.float32)
    _, o = lax.scan(step, s0, (to_scan(qc), to_scan(kc), to_scan(u), to_scan(w), to_scan(intra), to_scan(g_cum)))
    return jnp.transpose(o, (1, 0, 3, 2, 4)).reshape(B, L, H, Dv)


def setup_inputs(seed: int = 0) -> dict:
    key = jax.random.key(seed)
    ks = jax.random.split(key, 12)
    f32 = jnp.float32
    x = jax.random.normal(ks[0], (BATCH, SEQ, D_MODEL), f32)
    ln_w = 1.0 + 0.02 * jax.random.normal(ks[1], (DEPTH, D_MODEL), f32)
    w_in = jax.random.normal(ks[2], (DEPTH, D_MODEL, D_IN), f32) * D_MODEL ** -0.5
    attn_q_norm_w = 1.0 + 0.02 * jax.random.normal(ks[3], (DEPTH, ATT_HEAD_DIM), f32)
    attn_k_norm_w = 1.0 + 0.02 * jax.random.normal(ks[4], (DEPTH, ATT_HEAD_DIM), f32)
    idx_k_norm_w = 1.0 + 0.02 * jax.random.normal(ks[5], (DEPTH, IDX_HEAD_DIM), f32)
    idx_k_norm_b = 0.02 * jax.random.normal(ks[6], (DEPTH, IDX_HEAD_DIM), f32)
    dn_conv_w = jax.random.normal(ks[7], (DEPTH, CONV_KERNEL, 3 * DN_WIDTH), f32) * CONV_KERNEL ** -0.5
    dn_A_log = jnp.log(jax.random.uniform(ks[8], (DEPTH, DN_HEADS), f32, 1.0, 16.0))
    dt = jnp.exp(jax.random.uniform(ks[9], (DEPTH, DN_HEADS), f32, np.log(1e-3), np.log(1e-1)))
    dn_dt_bias = dt + jnp.log(-jnp.expm1(-dt))
    dn_norm_w = 1.0 + 0.02 * jax.random.normal(ks[10], (DEPTH, DN_HEAD_DIM), f32)
    w_out = jax.random.normal(ks[11], (DEPTH, D_MIX, D_MODEL), f32) * D_MIX ** -0.5
    return {"x": x, "ln_w": ln_w, "w_in": w_in, "attn_q_norm_w": attn_q_norm_w,
            "attn_k_norm_w": attn_k_norm_w, "idx_k_norm_w": idx_k_norm_w, "idx_k_norm_b": idx_k_norm_b,
            "dn_conv_w": dn_conv_w, "dn_A_log": dn_A_log, "dn_dt_bias": dn_dt_bias,
            "dn_norm_w": dn_norm_w, "w_out": w_out}


def reference(x, ln_w, w_in, attn_q_norm_w, attn_k_norm_w, idx_k_norm_w, idx_k_norm_b,
              dn_conv_w, dn_A_log, dn_dt_bias, dn_norm_w, w_out):
    B, L, _ = x.shape
    f32 = jnp.float32
    split_points = np.cumsum(np.array(SPLITS))[:-1].tolist()
    h = x
    for layer in range(DEPTH):
        hn = rms_norm(h, ln_w[layer])
        proj = hn @ w_in[layer]
        (aq, ak, av, ag, iq, ik, iw, dq, dk, dv, dz, db, da) = jnp.split(proj, split_points, axis=-1)

        q_a = rms_norm(aq.reshape(B, L, ATT_HEADS, ATT_HEAD_DIM), attn_q_norm_w[layer])
        k_a = rms_norm(ak.reshape(B, L, ATT_HEADS, ATT_HEAD_DIM), attn_k_norm_w[layer])
        v_a = av.reshape(B, L, ATT_HEADS, ATT_HEAD_DIM)
        q_i = iq.reshape(B, L, IDX_HEADS, IDX_HEAD_DIM).astype(f32)
        k_i = layer_norm_f32(ik, idx_k_norm_w[layer], idx_k_norm_b[layer])
        w_i = iw.astype(f32) * (IDX_HEADS ** -0.5) * (IDX_HEAD_DIM ** -0.5)
        o_a = dsa_sparse_attention(q_a, k_a, v_a, q_i, k_i, w_i).reshape(B, L, ATT_WIDTH)
        o_a = o_a * jax.nn.silu(ag)

        qkv = jax.nn.silu(causal_depthwise_conv(jnp.concatenate([dq, dk, dv], axis=-1), dn_conv_w[layer]))
        cq, ck, cv = jnp.split(qkv, [DN_WIDTH, 2 * DN_WIDTH], axis=-1)
        q_d = l2_norm_f32(cq.reshape(B, L, DN_HEADS, DN_HEAD_DIM).astype(f32))
        k_d = l2_norm_f32(ck.reshape(B, L, DN_HEADS, DN_HEAD_DIM).astype(f32))
        v_d = cv.reshape(B, L, DN_HEADS, DN_HEAD_DIM).astype(f32)
        beta = jax.nn.sigmoid(db.astype(f32))
        g = -jnp.exp(dn_A_log[layer].astype(f32)) * jax.nn.softplus(da.astype(f32) + dn_dt_bias[layer].astype(f32))
        o_d = chunk_gated_delta_rule(q_d, k_d, v_d, beta, g)
        o_d = rms_norm(o_d, dn_norm_w[layer]) * jax.nn.silu(dz.reshape(B, L, DN_HEADS, DN_HEAD_DIM).astype(f32))
        o_d = o_d.reshape(B, L, DN_WIDTH).astype(h.dtype)

        mix = jnp.concatenate([o_a.astype(h.dtype), o_d], axis=-1)
        h = h + mix @ w_out[layer]
    return h
```

```cpp
#include <hip/hip_runtime.h>
#include <hip/hip_cooperative_groups.h>
#include <cstdio>
#include <cstdint>
namespace cg = cooperative_groups;

#ifndef MEGA
#define MEGA 1
#endif

#define DI __device__ __forceinline__
typedef __attribute__((ext_vector_type(8))) short bf16x8;
typedef __attribute__((ext_vector_type(16))) float f32x16;
typedef __attribute__((ext_vector_type(4))) unsigned u32x4;
typedef __attribute__((ext_vector_type(2))) unsigned u32x2;
typedef __attribute__((ext_vector_type(2))) __bf16 bf2_t;
typedef unsigned short ush;
#define MFMA32(a, b, c) __builtin_amdgcn_mfma_f32_32x32x16_bf16((a), (b), (c), 0, 0, 0)

constexpr int NTOK = 16384;
constexpr int SEQL = 8192;
constexpr int NP = 4736;
constexpr int DIN = 4688;
constexpr int SMEM_BYTES = 70144;
constexpr int QSPLIT = 128;

struct Params {
  const float *x, *ln_w, *w_in, *aqw, *akw, *ikw, *ikb, *convw, *alog, *dtb, *dnw, *w_out;
  float* out;
  ush *Wt, *Wo, *XB, *MIX, *QA, *KA, *VA, *GA, *IQ, *DQ, *DK, *DV, *SZ, *IK, *INTRA;
  ush *UT, *WG, *QG, *KDT;
  float *IW, *BETA, *G, *GL, *OD;
  unsigned* counters;
  unsigned char *K8, *V8;
  int use_cg_sync, pad0;
};

DI ush f2bf(float x) { return __builtin_bit_cast(ush, (__bf16)x); }
DI float bf2f(ush b) { return __uint_as_float(((unsigned)b) << 16); }
DI unsigned pack2(float a, float b) { bf2_t v = {(__bf16)a, (__bf16)b}; return __builtin_bit_cast(unsigned, v); }
DI float bflo(unsigned u) { return __uint_as_float(u << 16); }
DI float bfhi(unsigned u) { return __uint_as_float(u & 0xffff0000u); }
DI int crow(int reg, int h) { return (reg & 3) + 8 * (reg >> 2) + 4 * h; }
DI float silu_f(float v) { return v / (1.f + __expf(-v)); }
DI f32x16 zero16() { f32x16 z; for (int i = 0; i < 16; ++i) z[i] = 0.f; return z; }

template <int CTRL> DI float dppmov(float x) {
  return __int_as_float(__builtin_amdgcn_update_dpp(0, __float_as_int(x), CTRL, 0xF, 0xF, true));
}
DI float red8(float d) {
  d += dppmov<0xB1>(d);
  d += dppmov<0x4E>(d);
  d += dppmov<0x141>(d);
  return d;
}
DI unsigned mbcnt64(unsigned long long m) {
  return __builtin_amdgcn_mbcnt_hi((unsigned)(m >> 32), __builtin_amdgcn_mbcnt_lo((unsigned)m, 0u));
}
DI int mapcol(int n) {
  if (n < 2560) return n;
  if (n < 4608) return n + 72;
  if (n < 4680) return n - 2048;
  if (n < 4688) return n;
  return -1;
}

DI void phase_prep(const Params& p, int gtid, int gsize, char* smem) {
  {
    unsigned* Ts = (unsigned*)smem;
    ush* Th = (ush*)smem;
    int t_ = threadIdx.x;
    asm volatile("" : "+v"(t_));
    const int t = t_;
    for (int tt = blockIdx.x; tt < 1472; tt += gridDim.x) {
      const bool is_in = tt < 1216;
      const int id = is_in ? tt : tt - 1216;
      const int nt = is_in ? id % 76 : (id & 15), kt = is_in ? id / 76 : (id >> 4);
      const float* src = is_in ? p.w_in : p.w_out;
      const int ld = is_in ? DIN : 1024;
      ush* dst = is_in ? p.Wt : p.Wo;
      {
        const int n = t & 63, ks = t >> 6;
        const int oc = is_in ? mapcol(nt * 64 + n) : nt * 64 + n;
#pragma unroll
        for (int it = 0; it < 16; ++it) {
          int k = it * 4 + ks;
          float v = oc >= 0 ? src[(size_t)(kt * 64 + k) * ld + oc] : 0.f;
          Th[n * 66 + k] = f2bf(v);
        }
      }
      __syncthreads();
      {
        const int n = t >> 2, kq = t & 3;
        u32x4 a, b;
#pragma unroll
        for (int i = 0; i < 4; ++i) { a[i] = Ts[n * 33 + kq * 8 + i]; b[i] = Ts[n * 33 + kq * 8 + 4 + i]; }
        u32x4* dp = (u32x4*)(dst + (size_t)(nt * 64 + n) * 1024 + kt * 64 + kq * 16);
        dp[0] = a; dp[1] = b;
      }
      __syncthreads();
    }
  }
  int wave = gtid >> 6, lane = gtid & 63, nw = gsize >> 6;
  for (int row = wave; row < NTOK; row += nw) {
    const float4* xr = (const float4*)(p.x + (size_t)row * 1024);
    float4 a[4];
    float ss = 0.f;
#pragma unroll
    for (int i = 0; i < 4; ++i) {
      a[i] = xr[lane + 64 * i];
      ss += a[i].x * a[i].x + a[i].y * a[i].y + a[i].z * a[i].z + a[i].w * a[i].w;
    }
#pragma unroll
    for (int o = 1; o < 64; o <<= 1) ss += __shfl_xor(ss, o);
    float rs = rsqrtf(ss * (1.f / 1024.f) + 1e-6f);
#pragma unroll
    for (int i = 0; i < 4; ++i) {
      float4 lw = ((const float4*)p.ln_w)[lane + 64 * i];
      u32x2 o;
      o[0] = pack2(a[i].x * rs * lw.x, a[i].y * rs * lw.y);
      o[1] = pack2(a[i].z * rs * lw.z, a[i].w * rs * lw.w);
      *(u32x2*)(p.XB + (size_t)row * 1024 + (lane + 64 * i) * 4) = o;
    }
  }
}

DI void gemm_tile(const ush* __restrict__ A, const ush* __restrict__ B, int m0, int n0, int K, char* smem,
                  f32x16 (&acc)[2][2]) {
  ush* As = (ush*)smem;
  ush* Bs = As + 128 * 72;
  int t_ = threadIdx.x;
  asm volatile("" : "+v"(t_));
  const int t = t_, lane = t & 63, w = t >> 6, wm = w >> 1, wn = w & 1, r = lane & 31, h = lane >> 5;
  u32x4 ra[4], rb[4];
#pragma unroll
  for (int i = 0; i < 2; ++i)
#pragma unroll
    for (int j = 0; j < 2; ++j) acc[i][j] = zero16();
#pragma unroll
  for (int i = 0; i < 4; ++i) {
    int c = t + 256 * i, row = c >> 3, kc = c & 7;
    ra[i] = *(const u32x4*)(A + (size_t)(m0 + row) * K + kc * 8);
    rb[i] = *(const u32x4*)(B + (size_t)(n0 + row) * K + kc * 8);
  }
  for (int k0 = 0; k0 < K; k0 += 64) {
    __syncthreads();
#pragma unroll
    for (int i = 0; i < 4; ++i) {
      int c = t + 256 * i, row = c >> 3, kc = c & 7;
      *(u32x4*)(As + row * 72 + kc * 8) = ra[i];
      *(u32x4*)(Bs + row * 72 + kc * 8) = rb[i];
    }
    __syncthreads();
    if (k0 + 64 < K) {
#pragma unroll
      for (int i = 0; i < 4; ++i) {
        int c = t + 256 * i, row = c >> 3, kc = c & 7;
        ra[i] = *(const u32x4*)(A + (size_t)(m0 + row) * K + k0 + 64 + kc * 8);
        rb[i] = *(const u32x4*)(B + (size_t)(n0 + row) * K + k0 + 64 + kc * 8);
      }
    }
#pragma unroll
    for (int s = 0; s < 4; ++s) {
      bf16x8 af[2], bfr[2];
#pragma unroll
      for (int i = 0; i < 2; ++i) af[i] = *(const bf16x8*)(As + (wm * 64 + i * 32 + r) * 72 + s * 16 + h * 8);
#pragma unroll
      for (int j = 0; j < 2; ++j) bfr[j] = *(const bf16x8*)(Bs + (wn * 64 + j * 32 + r) * 72 + s * 16 + h * 8);
#pragma unroll
      for (int i = 0; i < 2; ++i)
#pragma unroll
        for (int j = 0; j < 2; ++j) acc[i][j] = MFMA32(af[i], bfr[j], acc[i][j]);
    }
  }
  __syncthreads();
}

DI const float* stage_rows(f32x16 (&acc)[2][2], char* smem) {
  float* Cs = (float*)smem;
  int t_ = threadIdx.x;
  asm volatile("" : "+v"(t_));
  const int t = t_, lane = t & 63, w = t >> 6, wm = w >> 1, wn = w & 1, r = lane & 31, h = lane >> 5;
#pragma unroll
  for (int i = 0; i < 2; ++i)
#pragma unroll
    for (int j = 0; j < 2; ++j)
#pragma unroll
      for (int reg = 0; reg < 16; ++reg)
        Cs[(wm * 64 + i * 32 + crow(reg, h)) * 132 + wn * 64 + j * 32 + r] = acc[i][j][reg];
  __syncthreads();
  return Cs + (t & 127) * 132 + (t >> 7) * 64;
}
DI u32x4 pack8(float4 a, float4 b) {
  u32x4 o;
  o[0] = pack2(a.x, a.y); o[1] = pack2(a.z, a.w); o[2] = pack2(b.x, b.y); o[3] = pack2(b.z, b.w);
  return o;
}
DI float4 mul4(float4 a, float4 b) { return make_float4(a.x * b.x, a.y * b.y, a.z * b.z, a.w * b.w); }
DI float4 scl4(float4 a, float s) { return make_float4(a.x * s, a.y * s, a.z * s, a.w * s); }
DI unsigned cvt4_fp8(float a, float b, float c, float d) {
  int r = 0;
  r = __builtin_amdgcn_cvt_pk_fp8_f32(a, b, r, false);
  r = __builtin_amdgcn_cvt_pk_fp8_f32(c, d, r, true);
  return (unsigned)r;
}
DI float4 silu4(float4 a) { return make_float4(silu_f(a.x), silu_f(a.y), silu_f(a.z), silu_f(a.w)); }

DI void inproj_epilogue(const Params& p, int row, int nt, int half, const float4* cv) {
  if (nt < 36) {
    const int grp = nt >> 2;
    const int col = (nt & 3) * 128 + half * 64;
    ush* dst = (ush*)((char*)p.QA + (size_t)grp * (16u << 20));
    u32x4* dp = (u32x4*)(dst + (size_t)row * 512 + col);
    if (grp == 0) {
      float ss = 0.f;
#pragma unroll
      for (int q = 0; q < 16; ++q) { float4 f = cv[q]; ss += f.x * f.x + f.y * f.y + f.z * f.z + f.w * f.w; }
      const float rs = rsqrtf(ss * (1.f / 64.f) + 1e-6f);
      const float4* nw = (const float4*)p.aqw;
#pragma unroll
      for (int q = 0; q < 8; ++q)
        dp[q] = pack8(scl4(mul4(cv[2 * q], nw[2 * q]), rs), scl4(mul4(cv[2 * q + 1], nw[2 * q + 1]), rs));
    } else if (grp == 1) {
      float ss = 0.f;
#pragma unroll
      for (int q = 0; q < 16; ++q) { float4 f = cv[q]; ss += f.x * f.x + f.y * f.y + f.z * f.z + f.w * f.w; }
      const float rs = rsqrtf(ss * (1.f / 64.f) + 1e-6f);
      const float4* nw = (const float4*)p.akw;
      u32x4* d8 = (u32x4*)(p.K8 + (size_t)row * 512 + col);
#pragma unroll
      for (int q = 0; q < 4; ++q) {
        u32x4 o;
#pragma unroll
        for (int k = 0; k < 4; ++k) { float4 f = scl4(mul4(cv[4 * q + k], nw[4 * q + k]), rs); o[k] = cvt4_fp8(f.x, f.y, f.z, f.w); }
        d8[q] = o;
      }
    } else if (grp == 2) {
      u32x4* d8 = (u32x4*)(p.V8 + (size_t)row * 512 + col);
#pragma unroll
      for (int q = 0; q < 4; ++q) {
        u32x4 o;
#pragma unroll
        for (int k = 0; k < 4; ++k) { float4 f = cv[4 * q + k]; o[k] = cvt4_fp8(f.x, f.y, f.z, f.w); }
        d8[q] = o;
      }
    } else if (grp == 3 || grp == 8) {
#pragma unroll
      for (int q = 0; q < 8; ++q) dp[q] = pack8(silu4(cv[2 * q]), silu4(cv[2 * q + 1]));
    } else {
#pragma unroll
      for (int q = 0; q < 8; ++q) dp[q] = pack8(cv[2 * q], cv[2 * q + 1]);
    }
  } else {
    if (half == 0) {
      float mu = 0.f;
#pragma unroll
      for (int q = 0; q < 16; ++q) { float4 f = cv[q]; mu += f.x + f.y + f.z + f.w; }
      mu *= (1.f / 64.f);
      float var = 0.f;
#pragma unroll
      for (int q = 0; q < 16; ++q) {
        float4 f = cv[q];
        var += (f.x - mu) * (f.x - mu) + (f.y - mu) * (f.y - mu) + (f.z - mu) * (f.z - mu) + (f.w - mu) * (f.w - mu);
      }
      float rs = rsqrtf(var * (1.f / 64.f) + 1e-6f);
      const float4* kw = (const float4*)p.ikw;
      const float4* kb = (const float4*)p.ikb;
      u32x4* dp = (u32x4*)(p.IK + (size_t)row * 64);
#pragma unroll
      for (int q = 0; q < 8; ++q) {
        float4 a = cv[2 * q], c = cv[2 * q + 1], wa = kw[2 * q], wc = kw[2 * q + 1], ba = kb[2 * q], bc = kb[2 * q + 1];
        a = make_float4((a.x - mu) * rs * wa.x + ba.x, (a.y - mu) * rs * wa.y + ba.y, (a.z - mu) * rs * wa.z + ba.z, (a.w - mu) * rs * wa.w + ba.w);
        c = make_float4((c.x - mu) * rs * wc.x + bc.x, (c.y - mu) * rs * wc.y + bc.y, (c.z - mu) * rs * wc.z + bc.z, (c.w - mu) * rs * wc.w + bc.w);
        dp[q] = pack8(a, c);
      }
    } else {
      const float* v = (const float*)cv;
#pragma unroll
      for (int c = 0; c < 8; ++c) p.IW[(size_t)row * 8 + c] = v[c] * 0.044194173824159216f;
#pragma unroll
      for (int c = 0; c < 4; ++c) {
        p.BETA[(size_t)row * 4 + c] = 1.f / (1.f + expf(-v[8 + c]));
        float xx = v[12 + c] + p.dtb[c];
        float sp = xx > 20.f ? xx : log1pf(expf(xx));
        p.G[(size_t)row * 4 + c] = -expf(p.alog[c]) * sp;
      }
    }
  }
}

DI void inproj_tile(const Params& p, int tile, char* smem) {
  const int mt = tile / 37, nt = tile % 37;
  const int m0 = mt * 128, n0 = nt * 128;
  f32x16 acc[2][2];
  gemm_tile(p.XB, p.Wt, m0, n0, 1024, smem, acc);
  const float4* cv = (const float4*)stage_rows(acc, smem);
  const int t = threadIdx.x;
  inproj_epilogue(p, m0 + (t & 127), nt, t >> 7, cv);
}

DI void inproj_tile256(const Params& p, int tile, char* smem) {
  const int mt = tile / 19, n2 = tile % 19;
  const int m0 = mt * 128, n0 = n2 * 256;
  ush* As = (ush*)smem;
  ush* Bs = As + 128 * 72;
  int t_ = threadIdx.x;
  asm volatile("" : "+v"(t_));
  const int t = t_, lane = t & 63, w = t >> 6, wm = w >> 1, wn = w & 1, r = lane & 31, h = lane >> 5;
  f32x16 acc[2][4];
#pragma unroll
  for (int i = 0; i < 2; ++i)
#pragma unroll
    for (int j = 0; j < 4; ++j) acc[i][j] = zero16();
  u32x4 ra[4], rb[8];
  const int lrow = t >> 3, lkc = t & 7;
  const unsigned voff = (unsigned)(lrow * 1024 + lkc * 8) * 2u;
  const char* abase = (const char*)(p.XB + (size_t)m0 * 1024);
  const char* bbase = (const char*)(p.Wt + (size_t)n0 * 1024);
#pragma unroll
  for (int i = 0; i < 4; ++i) ra[i] = *(const u32x4*)(abase + (size_t)i * 65536 + voff);
#pragma unroll
  for (int i = 0; i < 8; ++i) rb[i] = *(const u32x4*)(bbase + (size_t)i * 65536 + voff);
  for (int k0 = 0; k0 < 1024; k0 += 64) {
    __syncthreads();
#pragma unroll
    for (int i = 0; i < 4; ++i) *(u32x4*)(As + (lrow + 32 * i) * 72 + lkc * 8) = ra[i];
#pragma unroll
    for (int i = 0; i < 8; ++i) *(u32x4*)(Bs + (lrow + 32 * i) * 72 + lkc * 8) = rb[i];
    __syncthreads();
    {
      const int kn = k0 + 64 < 1024 ? k0 + 64 : k0;
#pragma unroll
      for (int i = 0; i < 4; ++i) ra[i] = *(const u32x4*)(abase + ((size_t)i * 65536 + (size_t)kn * 2) + voff);
#pragma unroll
      for (int i = 0; i < 8; ++i) rb[i] = *(const u32x4*)(bbase + ((size_t)i * 65536 + (size_t)kn * 2) + voff);
    }
#pragma unroll
    for (int s = 0; s < 4; ++s) {
      bf16x8 af[2], bfr[4];
#pragma unroll
      for (int i = 0; i < 2; ++i) af[i] = *(const bf16x8*)(As + (wm * 64 + i * 32 + r) * 72 + s * 16 + h * 8);
#pragma unroll
      for (int j = 0; j < 4; ++j) bfr[j] = *(const bf16x8*)(Bs + (wn * 128 + j * 32 + r) * 72 + s * 16 + h * 8);
#pragma unroll
      for (int i = 0; i < 2; ++i)
#pragma unroll
        for (int j = 0; j < 4; ++j) acc[i][j] = MFMA32(af[i], bfr[j], acc[i][j]);
    }
  }
  __syncthreads();
  const int nt = __builtin_amdgcn_readfirstlane(2 * n2 + wn);
  if (nt < 37) {
    float* Cw = (float*)smem + w * 4384;
#pragma unroll
    for (int jp = 0; jp < 2; ++jp) {
#pragma unroll
      for (int i = 0; i < 2; ++i)
#pragma unroll
        for (int jj = 0; jj < 2; ++jj)
#pragma unroll
          for (int reg = 0; reg < 16; ++reg)
            Cw[(i * 32 + crow(reg, h)) * 68 + jj * 32 + r] = acc[i][2 * jp + jj][reg];
      inproj_epilogue(p, m0 + wm * 64 + lane, nt, jp, (const float4*)(Cw + lane * 68));
    }
  }
  __syncthreads();
}

DI void dn_prep_task(const Params& p, int task, char* smem) {
  int t_ = threadIdx.x;
  asm volatile("" : "+v"(t_));
  const int t = t_, lane = t & 63, w = t >> 6;
  const int h = task & 3, c = (task >> 2) & 127, b = task >> 9;
  const size_t ch = (size_t)(b * 4 + h) * 128 + c;
  const size_t row0 = (size_t)b * SEQL + c * 64;
  ush* Qs = (ush*)smem;
  ush* Ks = Qs + 64 * 136;
  ush* Vs = Ks + 64 * 136;
  float* As = (float*)(smem + 52224);
  float* gcs = (float*)(smem + 68608);
  float* bts = gcs + 64;
  float* ebg = bts + 64;
  float* ekd = ebg + 64;
  float* egc = ekd + 64;
  if (w == 0) {
    float g = p.G[(row0 + lane) * 4 + h];
#pragma unroll
    for (int o = 1; o < 64; o <<= 1) { float y = __shfl_up(g, o); if (lane >= o) g += y; }
    float bt = p.BETA[(row0 + lane) * 4 + h];
    float gl = __shfl(g, 63);
    gcs[lane] = g; bts[lane] = bt; ebg[lane] = bt * expf(g); ekd[lane] = expf(gl - g); egc[lane] = expf(g);
    if (lane == 63) p.GL[ch] = expf(g);
  }
  {
    float* cws = As;
    for (int e = t; e < 1536; e += 256) {
      int j = e / 384, rem = e - j * 384, X = rem >> 7, col = rem & 127;
      cws[e] = p.convw[(size_t)j * 1536 + X * 512 + h * 128 + col];
    }
  }
  __syncthreads();
  {
    const int i = t >> 2, cg = t & 3;
#pragma unroll 1
    for (int X = 0; X < 3; ++X) {
      const ush* src = X == 0 ? p.DQ : (X == 1 ? p.DK : p.DV);
      ush* dstS = X == 0 ? Qs : (X == 1 ? Ks : Vs);
      float y[32];
#pragma unroll
      for (int e = 0; e < 32; ++e) y[e] = 0.f;
#pragma unroll
      for (int j = 0; j < 4; ++j) {
        const int pos = c * 64 + i - 3 + j;
        const float vz = pos >= 0 ? 1.f : 0.f;
        const int posc = pos >= 0 ? pos : 0;
        {
          const u32x4* rp = (const u32x4*)(src + ((size_t)b * SEQL + posc) * 512 + h * 128 + cg * 32);
          const float4* wp = (const float4*)(As + (j * 3 + X) * 128 + cg * 32);
#pragma unroll
          for (int q = 0; q < 4; ++q) {
            u32x4 d = rp[q];
            float4 wa = wp[q * 2], wb = wp[q * 2 + 1];
            wa = scl4(wa, vz); wb = scl4(wb, vz);
            y[q * 8 + 0] += wa.x * bflo(d[0]); y[q * 8 + 1] += wa.y * bfhi(d[0]);
            y[q * 8 + 2] += wa.z * bflo(d[1]); y[q * 8 + 3] += wa.w * bfhi(d[1]);
            y[q * 8 + 4] += wb.x * bflo(d[2]); y[q * 8 + 5] += wb.y * bfhi(d[2]);
            y[q * 8 + 6] += wb.z * bflo(d[3]); y[q * 8 + 7] += wb.w * bfhi(d[3]);
          }
        }
      }
      float ss = 0.f;
#pragma unroll
      for (int e = 0; e < 32; ++e) { y[e] = silu_f(y[e]); ss += y[e] * y[e]; }
      float rs = 1.f;
      if (X < 2) {
        ss += __shfl_xor(ss, 1);
        ss += __shfl_xor(ss, 2);
        rs = rsqrtf(ss + 1e-6f);
        if (X == 0) rs *= 0.08838834764831845f;
      }
#pragma unroll
      for (int q = 0; q < 4; ++q) {
        u32x4 o;
        o[0] = pack2(y[q * 8 + 0] * rs, y[q * 8 + 1] * rs); o[1] = pack2(y[q * 8 + 2] * rs, y[q * 8 + 3] * rs);
        o[2] = pack2(y[q * 8 + 4] * rs, y[q * 8 + 5] * rs); o[3] = pack2(y[q * 8 + 6] * rs, y[q * 8 + 7] * rs);
        *(u32x4*)(dstS + i * 136 + cg * 32 + q * 8) = o;
      }
    }
  }
  __syncthreads();
  {
    const int ti = w >> 1, tj = w & 1, r = lane & 31, hh = lane >> 5;
    f32x16 skk = zero16(), sqk = zero16();
#pragma unroll
    for (int s = 0; s < 8; ++s) {
      bf16x8 ak = *(const bf16x8*)(Ks + (ti * 32 + r) * 136 + s * 16 + hh * 8);
      bf16x8 aq = *(const bf16x8*)(Qs + (ti * 32 + r) * 136 + s * 16 + hh * 8);
      bf16x8 bk = *(const bf16x8*)(Ks + (tj * 32 + r) * 136 + s * 16 + hh * 8);
      skk = MFMA32(ak, bk, skk);
      sqk = MFMA32(aq, bk, sqk);
    }
#pragma unroll
    for (int reg = 0; reg < 16; ++reg) {
      int ii = ti * 32 + crow(reg, hh), jj = tj * 32 + r;
      float dec = (jj <= ii) ? expf(gcs[ii] - gcs[jj]) : 0.f;
      As[ii * 64 + jj] = (jj < ii) ? bts[ii] * skk[reg] * dec : 0.f;
      p.INTRA[ch * 4096 + ii * 64 + jj] = f2bf(sqk[reg] * dec);
    }
  }
  __syncthreads();
  {
    float xs[64];
#pragma unroll
    for (int i = 0; i < 64; ++i) xs[i] = 0.f;
    const int col = t & 127;
    const bool isw = t >= 128;
#pragma unroll
    for (int i = 0; i < 64; ++i) {
      float a = isw ? ebg[i] * bf2f(Ks[i * 136 + col]) : bts[i] * bf2f(Vs[i * 136 + col]);
#pragma unroll
      for (int j4 = 0; j4 < (i + 3) / 4; ++j4) {
        float4 av = *(const float4*)(As + i * 64 + j4 * 4);
        a -= av.x * xs[j4 * 4 + 0];
        a -= av.y * xs[j4 * 4 + 1];
        a -= av.z * xs[j4 * 4 + 2];
        a -= av.w * xs[j4 * 4 + 3];
      }
      xs[i] = a;
    }
    if (!isw) {
#pragma unroll
      for (int q = 0; q < 8; ++q) {
        u32x4 o;
        o[0] = pack2(xs[q * 8 + 0], xs[q * 8 + 1]); o[1] = pack2(xs[q * 8 + 2], xs[q * 8 + 3]);
        o[2] = pack2(xs[q * 8 + 4], xs[q * 8 + 5]); o[3] = pack2(xs[q * 8 + 6], xs[q * 8 + 7]);
        *(u32x4*)(p.UT + ch * 8192 + col * 64 + q * 8) = o;
      }
    } else {
#pragma unroll
      for (int i = 0; i < 64; ++i) p.WG[ch * 8192 + i * 128 + col] = f2bf(xs[i]);
    }
  }
  {
    const int i = t >> 2, cg = t & 3;
    const float e = egc[i];
#pragma unroll
    for (int q = 0; q < 4; ++q) {
      u32x4 d = *(const u32x4*)(Qs + i * 136 + cg * 32 + q * 8);
      u32x4 o;
#pragma unroll
      for (int k = 0; k < 4; ++k) o[k] = pack2(bflo(d[k]) * e, bfhi(d[k]) * e);
      *(u32x4*)(p.QG + ch * 8192 + i * 128 + cg * 32 + q * 8) = o;
    }
    const int d_ = t & 127, ih = t >> 7;
#pragma unroll
    for (int q = 0; q < 4; ++q) {
      float vv[8];
#pragma unroll
      for (int k = 0; k < 8; ++k) { int ii = ih * 32 + q * 8 + k; vv[k] = bf2f(Ks[ii * 136 + d_]) * ekd[ii]; }
      u32x4 o;
      o[0] = pack2(vv[0], vv[1]); o[1] = pack2(vv[2], vv[3]); o[2] = pack2(vv[4], vv[5]); o[3] = pack2(vv[6], vv[7]);
      *(u32x4*)(p.KDT + ch * 8192 + d_ * 64 + ih * 32 + q * 8) = o;
    }
  }
  __syncthreads();
}

DI void dn_scan(const Params& p, int sw, char* smem) {
  int t_ = threadIdx.x;
  asm volatile("" : "+v"(t_));
  const int t = t_, lane = t & 63, w = t >> 6, r = lane & 31, hh = lane >> 5;
  const int bh = sw & 7, slice = sw >> 3;
  const int b = bh >> 2, h = bh & 3;
  ush* ST = (ush*)smem;
  ush* VNT = ST + 32 * 136;
  for (int i = t; i < 32 * 136 / 2; i += 256) ((unsigned*)ST)[i] = 0u;
  f32x16 S = zero16();
  const int wv = w & 1;
  const bool isP = w < 2;
  const ush* Abase = isP ? p.WG : p.QG;
  bf16x8 a32[8], kd[4], in4[4];
  u32x2 u4[4];
  bf16x8 na32[8], nkd[4], nin4[4];
  u32x2 nu4[4];
#pragma unroll
  for (int s = 0; s < 4; ++s) { in4[s] = (bf16x8){0,0,0,0,0,0,0,0}; nin4[s] = in4[s]; u4[s] = (u32x2){0u, 0u}; nu4[s] = u4[s]; }
  {
    const size_t ch = (size_t)bh * 128;
#pragma unroll
    for (int s = 0; s < 8; ++s) a32[s] = *(const bf16x8*)(Abase + ch * 8192 + (32 * wv + r) * 128 + s * 16 + hh * 8);
#pragma unroll
    for (int s = 0; s < 4; ++s) kd[s] = *(const bf16x8*)(p.KDT + ch * 8192 + (32 * w + r) * 64 + s * 16 + hh * 8);
    if (!isP) {
#pragma unroll
      for (int s = 0; s < 4; ++s) in4[s] = *(const bf16x8*)(p.INTRA + ch * 4096 + (32 * wv + r) * 64 + s * 16 + hh * 8);
    } else {
#pragma unroll
      for (int g = 0; g < 4; ++g) u4[g] = *(const u32x2*)(p.UT + ch * 8192 + (slice * 32 + r) * 64 + 32 * wv + 8 * g + 4 * hh);
    }
  }
  __syncthreads();
  for (int c = 0; c < 128; ++c) {
    {
      const size_t ch = (size_t)bh * 128 + (c + 1 < 128 ? c + 1 : 127);
#pragma unroll
      for (int s = 0; s < 8; ++s) na32[s] = *(const bf16x8*)(Abase + ch * 8192 + (32 * wv + r) * 128 + s * 16 + hh * 8);
#pragma unroll
      for (int s = 0; s < 4; ++s) nkd[s] = *(const bf16x8*)(p.KDT + ch * 8192 + (32 * w + r) * 64 + s * 16 + hh * 8);
      if (!isP) {
#pragma unroll
        for (int s = 0; s < 4; ++s) nin4[s] = *(const bf16x8*)(p.INTRA + ch * 4096 + (32 * wv + r) * 64 + s * 16 + hh * 8);
      } else {
#pragma unroll
        for (int g = 0; g < 4; ++g) nu4[g] = *(const u32x2*)(p.UT + ch * 8192 + (slice * 32 + r) * 64 + 32 * wv + 8 * g + 4 * hh);
      }
    }
    const float gl = p.GL[bh * 128 + c];
    f32x16 acc = zero16();
#pragma unroll
    for (int s = 0; s < 8; ++s) {
      bf16x8 bS = *(const bf16x8*)(ST + r * 136 + s * 16 + hh * 8);
      acc = MFMA32(a32[s], bS, acc);
    }
    if (isP) {
#pragma unroll
      for (int g = 0; g < 4; ++g) {
        float v0 = bflo(u4[g][0]) - acc[4 * g + 0], v1 = bfhi(u4[g][0]) - acc[4 * g + 1];
        float v2 = bflo(u4[g][1]) - acc[4 * g + 2], v3 = bfhi(u4[g][1]) - acc[4 * g + 3];
        u32x2 o; o[0] = pack2(v0, v1); o[1] = pack2(v2, v3);
        *(u32x2*)(VNT + r * 72 + 32 * wv + 8 * g + 4 * hh) = o;
      }
    }
    __syncthreads();
    bf16x8 bV[4];
#pragma unroll
    for (int s = 0; s < 4; ++s) bV[s] = *(const bf16x8*)(VNT + r * 72 + s * 16 + hh * 8);
    if (!isP) {
#pragma unroll
      for (int s = 0; s < 4; ++s) acc = MFMA32(in4[s], bV[s], acc);
      float* od = p.OD + ((size_t)b * SEQL + c * 64 + 32 * wv) * 512 + h * 128 + slice * 32 + r;
#pragma unroll
      for (int reg = 0; reg < 16; ++reg) od[(size_t)crow(reg, hh) * 512] = acc[reg];
    }
#pragma unroll
    for (int i = 0; i < 16; ++i) S[i] *= gl;
#pragma unroll
    for (int s = 0; s < 4; ++s) S = MFMA32(kd[s], bV[s], S);
#pragma unroll
    for (int g = 0; g < 4; ++g) {
      u32x2 o; o[0] = pack2(S[4 * g + 0], S[4 * g + 1]); o[1] = pack2(S[4 * g + 2], S[4 * g + 3]);
      *(u32x2*)(ST + r * 136 + 32 * w + 8 * g + 4 * hh) = o;
    }
    __syncthreads();
#pragma unroll
    for (int s = 0; s < 8; ++s) a32[s] = na32[s];
#pragma unroll
    for (int s = 0; s < 4; ++s) { kd[s] = nkd[s]; in4[s] = nin4[s]; u4[s] = nu4[s]; }
  }
}

DI float relu_i(float x) { int v = __float_as_int(x); return __int_as_float(v > 0 ? v : 0); }
DI unsigned ukey(float f) { unsigned u = __float_as_uint(f); return (u & 0x80000000u) ? ~u : (u | 0x80000000u); }

template <int CTRL> DI unsigned dppmov_u(unsigned x) {
  return (unsigned)__builtin_amdgcn_update_dpp(0, (int)x, CTRL, 0xF, 0xF, true);
}
DI unsigned wave_max_u32(unsigned v) {
  unsigned y;
  y = dppmov_u<0xB1>(v); v = v > y ? v : y;
  y = dppmov_u<0x4E>(v); v = v > y ? v : y;
  y = dppmov_u<0x141>(v); v = v > y ? v : y;
  y = dppmov_u<0x140>(v); v = v > y ? v : y;
  const unsigned a = (unsigned)__builtin_amdgcn_readlane((int)v, 0), b = (unsigned)__builtin_amdgcn_readlane((int)v, 16);
  const unsigned c = (unsigned)__builtin_amdgcn_readlane((int)v, 32), d = (unsigned)__builtin_amdgcn_readlane((int)v, 48);
  const unsigned ab = a > b ? a : b, cd = c > d ? c : d;
  return ab > cd ? ab : cd;
}
DI unsigned wave_min_u32(unsigned v) {
  unsigned y;
  y = dppmov_u<0xB1>(v); v = v < y ? v : y;
  y = dppmov_u<0x4E>(v); v = v < y ? v : y;
  y = dppmov_u<0x141>(v); v = v < y ? v : y;
  y = dppmov_u<0x140>(v); v = v < y ? v : y;
  const unsigned a = (unsigned)__builtin_amdgcn_readlane((int)v, 0), b = (unsigned)__builtin_amdgcn_readlane((int)v, 16);
  const unsigned c = (unsigned)__builtin_amdgcn_readlane((int)v, 32), d = (unsigned)__builtin_amdgcn_readlane((int)v, 48);
  const unsigned ab = a < b ? a : b, cd = c < d ? c : d;
  return ab < cd ? ab : cd;
}
DI unsigned inv_ukey(unsigned k) { return (k & 0x80000000u) ? (k & 0x7fffffffu) : ~k; }
DI void compact16(unsigned* bk, unsigned* bi, int& cnt, float& th_out, int lane) {
  const int n = cnt;
  unsigned k[8], ix[8], raw[8];
  unsigned kmx = 0u, kmn = 0xffffffffu;
#pragma unroll
  for (int q = 0; q < 8; ++q) {
    int e = lane + 64 * q; raw[q] = bk[e]; ix[q] = bi[e];
    const unsigned kk = ukey(__uint_as_float(raw[q]));
    const bool v = e < n;
    k[q] = v ? kk : 0u;
    kmx = (v && kk > kmx) ? kk : kmx;
    kmn = (v && kk < kmn) ? kk : kmn;
  }
  kmx = wave_max_u32(kmx); kmn = wave_min_u32(kmn);
  const unsigned diff = kmx ^ kmn;
  unsigned P = kmn;
  if (diff) {
    const int top = 31 - __builtin_clz(diff);
    P = kmx & ~((2u << top) - 1u);
#pragma unroll 1
    for (int bit = top; bit >= 0; --bit) {
      const unsigned tk = P | (1u << bit);
      int c = 0;
#pragma unroll
      for (int q = 0; q < 8; ++q) c += __popcll(__builtin_amdgcn_ballot_w64(k[q] >= tk));
      if (c >= 256) { P = tk; if (c <= 320) break; }
    }
  }
  int base = 0;
#pragma unroll
  for (int q = 0; q < 8; ++q) {
    const bool keep = k[q] >= P && k[q] != 0u;
    unsigned long long m = __builtin_amdgcn_ballot_w64(keep);
    int pre = base + (int)mbcnt64(m);
    if (keep) { bk[pre] = raw[q]; bi[pre] = ix[q]; }
    base += __popcll(m);
  }
  cnt = base;
  th_out = __uint_as_float(inv_ukey(P));
}

DI int final_select(unsigned* bk, unsigned* bi, int cnt, int lane) {
  if (cnt <= 256) return cnt;
  unsigned k[8], ix[8];
  unsigned kmx = 0u, kmn = 0xffffffffu;
#pragma unroll
  for (int q = 0; q < 8; ++q) {
    int e = lane + 64 * q; unsigned kk = ukey(__uint_as_float(bk[e])); ix[q] = bi[e];
    const bool v = e < cnt;
    k[q] = v ? kk : 0u;
    kmx = (v && kk > kmx) ? kk : kmx;
    kmn = (v && kk < kmn) ? kk : kmn;
  }
  kmx = wave_max_u32(kmx); kmn = wave_min_u32(kmn);
  const unsigned diff = kmx ^ kmn;
  unsigned P = kmn;
  if (diff) {
    const int top = 31 - __builtin_clz(diff);
    P = kmx & ~((2u << top) - 1u);
#pragma unroll 1
    for (int bit = top; bit >= 0; --bit) {
      const unsigned tk = P | (1u << bit);
      int c = 0;
#pragma unroll
      for (int q = 0; q < 8; ++q) c += __popcll(__ballot(k[q] >= tk));
      if (c >= 256) { P = tk; if (c == 256) break; }
    }
  }
  int cge = 0, cgt = 0;
#pragma unroll
  for (int q = 0; q < 8; ++q) { cge += __popcll(__ballot(k[q] >= P)); cgt += __popcll(__ballot(k[q] > P)); }
  const bool cut = (cge == 256);
  const int need = 256 - cgt;
  int base = 0, eqseen = 0;
#pragma unroll
  for (int q = 0; q < 8; ++q) {
    bool gt = k[q] > P, eq = k[q] == P, ge = k[q] >= P;
    unsigned long long me = __ballot(eq);
    int epre = eqseen + (int)mbcnt64(me);
    bool keep = cut ? ge : (gt || (eq && epre < need));
    unsigned long long m = __ballot(keep);
    int pre = base + (int)mbcnt64(m);
    if (keep) bi[pre] = ix[q];
    base += __popcll(m);
    eqseen += __popcll(me);
  }
  return base;
}

#define MFMA8(a, b, c) __builtin_amdgcn_mfma_f32_16x16x32_fp8_fp8((a), (b), (c), 0, 0, 0)
typedef __attribute__((ext_vector_type(4))) float f32x4v;
typedef __attribute__((ext_vector_type(2))) float f32x2v;
DI int pidx(int h, int key) { return h * 256 + (key ^ ((h & 1) << 5)); }
DI long mk64(unsigned lo, unsigned hi) { return (long)(((unsigned long long)hi << 32) | lo); }

DI void sparse_attn_query(const Params& p, size_t rowb, size_t row, const unsigned* sel, int nsel, float* pbuf, int lane) {
  const int m16 = lane & 15, kg = lane >> 4;
  long afr[16];
  {
    unsigned alo0, alo1, ahi0, ahi1;
    {
      const u32x4 qa = *(const u32x4*)(p.QA + row * 512 + (m16 & 7) * 64 + kg * 16);
      const u32x4 qb = *(const u32x4*)(p.QA + row * 512 + (m16 & 7) * 64 + kg * 16 + 8);
      alo0 = cvt4_fp8(bflo(qa[0]), bfhi(qa[0]), bflo(qa[1]), bfhi(qa[1]));
      alo1 = cvt4_fp8(bflo(qa[2]), bfhi(qa[2]), bflo(qa[3]), bfhi(qa[3]));
      ahi0 = cvt4_fp8(bflo(qb[0]), bfhi(qb[0]), bflo(qb[1]), bfhi(qb[1]));
      ahi1 = cvt4_fp8(bflo(qb[2]), bfhi(qb[2]), bflo(qb[3]), bfhi(qb[3]));
    }
#pragma unroll
    for (int s = 0; s < 16; ++s) {
      const bool on = (m16 == (s >> 1));
      afr[s] = mk64(on ? ((s & 1) ? ahi0 : alo0) : 0u, on ? ((s & 1) ? ahi1 : alo1) : 0u);
    }
  }
  const int ntile = (nsel + 15) >> 4;
  u32x4 bc[8], bn[8], bnn[8];
  {
    const int j = m16 < nsel ? m16 : nsel - 1;
    const unsigned char* kb = p.K8 + (rowb + sel[j]) * 512 + kg * 16;
#pragma unroll
    for (int h = 0; h < 8; ++h) { bc[h] = *(const u32x4*)(kb + h * 64); bn[h] = bc[h]; bnn[h] = bc[h]; }
    {
      const int kn = 16 + m16;
      const int j1 = kn < nsel ? kn : nsel - 1;
      const unsigned char* kb1 = p.K8 + (rowb + sel[j1]) * 512 + kg * 16;
#pragma unroll
      for (int h = 0; h < 8; ++h) bn[h] = *(const u32x4*)(kb1 + h * 64);
    }
  }
#pragma unroll 1
  for (int T = 0; T < ntile; ++T) {
    {
      const int kn = (T + 2) * 16 + m16;
      const int j = kn < nsel ? kn : nsel - 1;
      const unsigned char* kb = p.K8 + (rowb + sel[j]) * 512 + kg * 16;
#pragma unroll
      for (int h = 0; h < 8; ++h) bnn[h] = *(const u32x4*)(kb + h * 64);
    }
    f32x4v acc0 = {0.f, 0.f, 0.f, 0.f}, acc1 = {0.f, 0.f, 0.f, 0.f};
#pragma unroll
    for (int h = 0; h < 8; ++h) {
      acc0 = MFMA8(afr[2 * h], mk64(bc[h][0], bc[h][1]), acc0);
      acc1 = MFMA8(afr[2 * h + 1], mk64(bc[h][2], bc[h][3]), acc1);
    }
    const int key = T * 16 + m16;
    if (kg < 2) {
      const bool ok = key < nsel;
#pragma unroll
      for (int i = 0; i < 4; ++i) pbuf[pidx(4 * kg + i, key)] = ok ? (acc0[i] + acc1[i]) * 0.125f : -1e30f;
    }
#pragma unroll
    for (int h = 0; h < 8; ++h) { bc[h] = bn[h]; bn[h] = bnn[h]; }
  }
  for (int T = ntile; T < 16; ++T) {
    if (kg < 2) {
#pragma unroll
      for (int i = 0; i < 4; ++i) pbuf[pidx(4 * kg + i, T * 16 + m16)] = -1e30f;
    }
  }
  const int hl = lane >> 3, l8 = lane & 7;
  float inv;
  {
    float4 lg[8];
    float mx = -1e30f;
#pragma unroll
    for (int j = 0; j < 8; ++j) {
      lg[j] = *(const float4*)(pbuf + pidx(hl, 32 * j + 4 * l8));
      mx = fmaxf(mx, fmaxf(fmaxf(lg[j].x, lg[j].y), fmaxf(lg[j].z, lg[j].w)));
    }
    mx = fmaxf(mx, dppmov<0xB1>(mx));
    mx = fmaxf(mx, dppmov<0x4E>(mx));
    mx = fmaxf(mx, dppmov<0x141>(mx));
    float sum = 0.f;
#pragma unroll
    for (int j = 0; j < 8; ++j) {
      lg[j].x = __expf(lg[j].x - mx); lg[j].y = __expf(lg[j].y - mx); lg[j].z = __expf(lg[j].z - mx); lg[j].w = __expf(lg[j].w - mx);
      sum += (lg[j].x + lg[j].y) + (lg[j].z + lg[j].w);
      *(float4*)(pbuf + pidx(hl, 32 * j + 4 * l8)) = lg[j];
    }
    sum = red8(sum);
    inv = 1.f / sum;
  }
  const int kpar = lane >> 5, l5 = lane & 31, h16 = l5 >> 2;
  f32x2v o2[8];
#pragma unroll
  for (int e = 0; e < 8; ++e) o2[e] = (f32x2v){0.f, 0.f};
  const int nstep = (nsel + 15) >> 4;
  const unsigned char* vbase = p.V8 + rowb * 512 + l5 * 16;
  u32x4 vc[8], vn[8], vnn[8];
#define LOADV16(dst, J0)                                                            \
  {                                                                                 \
    _Pragma("unroll") for (int g = 0; g < 4; ++g) {                                 \
      const uint4 i4 = *(const uint4*)(sel + (J0) + 4 * g);                         \
      const unsigned ia = kpar ? i4.y : i4.x, ib = kpar ? i4.w : i4.z;              \
      const unsigned ida = ((J0) + 4 * g + kpar < nsel) ? ia : sel[0];              \
      const unsigned idb = ((J0) + 4 * g + 2 + kpar < nsel) ? ib : sel[0];          \
      dst[2 * g] = *(const u32x4*)(vbase + (size_t)ida * 512);                      \
      dst[2 * g + 1] = *(const u32x4*)(vbase + (size_t)idb * 512);                  \
    }                                                                               \
  }
  LOADV16(vc, 0);
#pragma unroll
  for (int e = 0; e < 8; ++e) { vn[e] = vc[e]; vnn[e] = vc[e]; }
  LOADV16(vn, 16);
#pragma unroll 1
  for (int st = 0; st < nstep; ++st) {
    { const int j0 = (st + 2) * 16; LOADV16(vnn, j0); }
#pragma unroll
    for (int e = 0; e < 8; ++e) {
      const float pj = pbuf[pidx(h16, st * 16 + 2 * e + kpar)];
      const f32x2v pp = {pj, pj};
      const u32x4 v = vc[e];
#pragma unroll
      for (int k = 0; k < 4; ++k) {
        o2[2 * k] = __builtin_elementwise_fma(__builtin_amdgcn_cvt_pk_f32_fp8((int)v[k], false), pp, o2[2 * k]);
        o2[2 * k + 1] = __builtin_elementwise_fma(__builtin_amdgcn_cvt_pk_f32_fp8((int)v[k], true), pp, o2[2 * k + 1]);
      }
    }
#pragma unroll
    for (int e = 0; e < 8; ++e) { vc[e] = vn[e]; vn[e] = vnn[e]; }
  }
#undef LOADV16
  float o[16];
#pragma unroll
  for (int e = 0; e < 8; ++e) { o[2 * e] = o2[e].x; o[2 * e + 1] = o2[e].y; }
#pragma unroll
  for (int e = 0; e < 16; ++e) o[e] += __shfl_xor(o[e], 32);
  const float invh = __shfl(inv, h16 * 8);
  if (kpar == 0) {
    const u32x4 ga0 = *(const u32x4*)(p.GA + row * 512 + l5 * 16);
    const u32x4 ga1 = *(const u32x4*)(p.GA + row * 512 + l5 * 16 + 8);
    u32x4 ov0, ov1;
#pragma unroll
    for (int k = 0; k < 4; ++k) {
      ov0[k] = pack2(o[2 * k] * invh * bflo(ga0[k]), o[2 * k + 1] * invh * bfhi(ga0[k]));
      ov1[k] = pack2(o[8 + 2 * k] * invh * bflo(ga1[k]), o[8 + 2 * k + 1] * invh * bfhi(ga1[k]));
    }
    *(u32x4*)(p.MIX + row * 1024 + l5 * 16) = ov0;
    *(u32x4*)(p.MIX + row * 1024 + l5 * 16 + 8) = ov1;
  }
}

DI void attn_task(const Params& p, int task, char* smem, int qsel = 0) {
  int t_ = threadIdx.x;
  asm volatile("" : "+v"(t_));
  const int t = t_, lane = t & 63, w = t >> 6, r = lane & 31, hh = lane >> 5;
  const int b = task & 1, s16 = 511 - (task >> 1);
  const int tq0 = s16 * 16 + 4 * w;
  const size_t rowb = (size_t)b * SEQL;
  unsigned* bkey = (unsigned*)smem + w * 4096;
  unsigned* bidx = bkey + 2048;
  const int ql = 2 * ((r >> 2) & 1) + (r >> 4), hd = (r & 3) + 4 * ((r >> 3) & 1);
  bf16x8 aq[4];
#pragma unroll
  for (int s = 0; s < 4; ++s) aq[s] = *(const bf16x8*)(p.IQ + (rowb + tq0 + ql) * 512 + hd * 64 + s * 16 + hh * 8);
  float w0[8], w1[8];
#pragma unroll
  for (int i = 0; i < 8; ++i) {
    w0[i] = p.IW[(rowb + tq0 + 2 * hh) * 8 + i];
    w1[i] = p.IW[(rowb + tq0 + 2 * hh + 1) * 8 + i];
  }
  const int tqa = tq0 + 2 * hh, tqb = tqa + 1;
  float tha = -__builtin_inff(), thb = -__builtin_inff();
  int cnt0 = 0, cnt1 = 0, cnt2 = 0, cnt3 = 0;
  const int ntile = ((s16 * 16 + 15) >> 5) + 1;
  const int offa = hh ? 1024 : 0, offb = hh ? 1536 : 512;
  auto tile_body = [&](const bf16x8 (&bt)[4], int kt) -> bool {
    f32x16 acc = zero16();
#pragma unroll
    for (int s = 0; s < 4; ++s) acc = MFMA32(aq[s], bt[s], acc);
    float sa = 0.f, sb = 0.f;
#pragma unroll
    for (int i = 0; i < 8; ++i) {
      sa = fmaf(w0[i], relu_i(acc[i]), sa);
      sb = fmaf(w1[i], relu_i(acc[8 + i]), sb);
    }
    const int key = kt * 32 + r;
    const bool pa = (key <= tqa) & (sa >= tha);
    const bool pb = (key <= tqb) & (sb >= thb);
    {
      const unsigned long long m = __builtin_amdgcn_ballot_w64(pa);
      const int nlo = __popc((unsigned)m), nhi = __popc((unsigned)(m >> 32));
      const int pos = (int)mbcnt64(m) + (hh ? cnt2 - nlo : cnt0);
      if (pa && pos < 512) { bkey[offa + pos] = __float_as_uint(sa); bidx[offa + pos] = (unsigned)key; }
      cnt0 += nlo; cnt2 += nhi;
    }
    {
      const unsigned long long m = __builtin_amdgcn_ballot_w64(pb);
      const int nlo = __popc((unsigned)m), nhi = __popc((unsigned)(m >> 32));
      const int pos = (int)mbcnt64(m) + (hh ? cnt3 - nlo : cnt1);
      if (pb && pos < 512) { bkey[offb + pos] = __float_as_uint(sb); bidx[offb + pos] = (unsigned)key; }
      cnt1 += nlo; cnt3 += nhi;
    }
    return (cnt0 > 480) | (cnt1 > 480) | (cnt2 > 480) | (cnt3 > 480);
  };
  {
    ush* tile = (ush*)(smem + 65536);
    __shared__ int s_need[2];
    const int lkey = t >> 3, lch = t & 7;
    const ush* gsrc = p.IK + (rowb + lkey) * 64 + lch * 8;
    const int lt = ntile - 1;
    u32x4 g = *(const u32x4*)(gsrc);
    if (t < 2) s_need[t] = 0;
    for (int kt = 0; kt < ntile; ++kt) {
      __syncthreads();
      const int need = kt > 0 ? s_need[(kt - 1) & 1] : 0;
      *(u32x4*)(tile + lkey * 72 + lch * 8) = g;
      __syncthreads();
      if (t == 0 && kt > 0) s_need[(kt - 1) & 1] = 0;
      {
        const int tn = kt + 1 < lt ? kt + 1 : lt;
        g = *(const u32x4*)(gsrc + (size_t)tn * 2048);
      }
      if (need) {
        if (cnt0 > 320) { float th; compact16(bkey, bidx, cnt0, th, lane); if (hh == 0) tha = th; }
        if (cnt1 > 320) { float th; compact16(bkey + 512, bidx + 512, cnt1, th, lane); if (hh == 0) thb = th; }
        if (cnt2 > 320) { float th; compact16(bkey + 1024, bidx + 1024, cnt2, th, lane); if (hh == 1) tha = th; }
        if (cnt3 > 320) { float th; compact16(bkey + 1536, bidx + 1536, cnt3, th, lane); if (hh == 1) thb = th; }
      }
      bf16x8 bt[4];
#pragma unroll
      for (int s = 0; s < 4; ++s) bt[s] = *(const bf16x8*)(tile + r * 72 + s * 16 + hh * 8);
      if (tile_body(bt, kt) && lane == 0) s_need[kt & 1] = 1;
    }
    __syncthreads();
  }
  const bool lo = qsel != 2, hi = qsel != 1;
  int nsel_q[4] = {0, 0, 0, 0};
  {
    int c0 = cnt0 > 512 ? 512 : cnt0, c1 = cnt1 > 512 ? 512 : cnt1, c2 = cnt2 > 512 ? 512 : cnt2, c3 = cnt3 > 512 ? 512 : cnt3;
    if (lo) {
      nsel_q[0] = final_select(bkey, bidx, c0, lane);
      nsel_q[1] = final_select(bkey + 512, bidx + 512, c1, lane);
    }
    if (hi) {
      nsel_q[2] = final_select(bkey + 1024, bidx + 1024, c2, lane);
      nsel_q[3] = final_select(bkey + 1536, bidx + 1536, c3, lane);
    }
  }
  float* pbuf = (float*)bkey;
#pragma unroll
  for (int q = 0; q < 4; ++q) {
    if (q < 2 ? lo : hi) sparse_attn_query(p, rowb, rowb + tq0 + q, bidx + q * 512, nsel_q[q], pbuf, lane);
  }
}

DI void dn_norm(const Params& p, int wave, int nw, int lane) {
  const float4* nwp = (const float4*)(p.dnw + (lane & 15) * 8);
  const float4 n0 = nwp[0], n1 = nwp[1];
  for (int row0 = wave; row0 < NTOK; row0 += 4 * nw) {
    float4 a[4], c[4];
    u32x4 z[4];
#pragma unroll
    for (int j = 0; j < 4; ++j) {
      const int row = row0 + j * nw;
      const float4* op = (const float4*)(p.OD + (size_t)row * 512 + lane * 8);
      a[j] = op[0]; c[j] = op[1];
      z[j] = *(const u32x4*)(p.SZ + (size_t)row * 512 + lane * 8);
    }
#pragma unroll
    for (int j = 0; j < 4; ++j) {
      const int row = row0 + j * nw;
      float ss = a[j].x * a[j].x + a[j].y * a[j].y + a[j].z * a[j].z + a[j].w * a[j].w + c[j].x * c[j].x + c[j].y * c[j].y + c[j].z * c[j].z + c[j].w * c[j].w;
      ss += __shfl_xor(ss, 1); ss += __shfl_xor(ss, 2); ss += __shfl_xor(ss, 4); ss += __shfl_xor(ss, 8);
      const float rs = rsqrtf(ss * (1.f / 128.f) + 1e-6f);
      u32x4 o;
      o[0] = pack2(a[j].x * rs * n0.x * bflo(z[j][0]), a[j].y * rs * n0.y * bfhi(z[j][0]));
      o[1] = pack2(a[j].z * rs * n0.z * bflo(z[j][1]), a[j].w * rs * n0.w * bfhi(z[j][1]));
      o[2] = pack2(c[j].x * rs * n1.x * bflo(z[j][2]), c[j].y * rs * n1.y * bfhi(z[j][2]));
      o[3] = pack2(c[j].z * rs * n1.z * bflo(z[j][3]), c[j].w * rs * n1.w * bfhi(z[j][3]));
      *(u32x4*)(p.MIX + (size_t)row * 1024 + 512 + lane * 8) = o;
    }
  }
}

DI void dn_norm_rows(const Params& p, int row_base, int lane) {
  const float4* nwp = (const float4*)(p.dnw + (lane & 15) * 8);
  const float4 n0 = nwp[0], n1 = nwp[1];
#pragma unroll 1
  for (int r4 = 0; r4 < 16; r4 += 4) {
    float4 a[4], c[4];
    u32x4 z[4];
#pragma unroll
    for (int j = 0; j < 4; ++j) {
      const int row = row_base + r4 + j;
      const float4* op = (const float4*)(p.OD + (size_t)row * 512 + lane * 8);
      a[j] = op[0]; c[j] = op[1];
      z[j] = *(const u32x4*)(p.SZ + (size_t)row * 512 + lane * 8);
    }
#pragma unroll
    for (int j = 0; j < 4; ++j) {
      const int row = row_base + r4 + j;
      float ss = a[j].x * a[j].x + a[j].y * a[j].y + a[j].z * a[j].z + a[j].w * a[j].w + c[j].x * c[j].x + c[j].y * c[j].y + c[j].z * c[j].z + c[j].w * c[j].w;
      ss += __shfl_xor(ss, 1); ss += __shfl_xor(ss, 2); ss += __shfl_xor(ss, 4); ss += __shfl_xor(ss, 8);
      const float rs = rsqrtf(ss * (1.f / 128.f) + 1e-6f);
      u32x4 o;
      o[0] = pack2(a[j].x * rs * n0.x * bflo(z[j][0]), a[j].y * rs * n0.y * bfhi(z[j][0]));
      o[1] = pack2(a[j].z * rs * n0.z * bflo(z[j][1]), a[j].w * rs * n0.w * bfhi(z[j][1]));
      o[2] = pack2(c[j].x * rs * n1.x * bflo(z[j][2]), c[j].y * rs * n1.y * bfhi(z[j][2]));
      o[3] = pack2(c[j].z * rs * n1.z * bflo(z[j][3]), c[j].w * rs * n1.w * bfhi(z[j][3]));
      *(u32x4*)(p.MIX + (size_t)row * 1024 + 512 + lane * 8) = o;
    }
  }
}

DI void outproj_tile(const Params& p, int tile, char* smem) {
  const int mt = tile >> 3, nt = tile & 7;
  const int m0 = mt * 128, n0 = nt * 128;
  f32x16 acc[2][2];
  gemm_tile(p.MIX, p.Wo, m0, n0, 1024, smem, acc);
  (void)stage_rows(acc, smem);
  int t_ = threadIdx.x;
  asm volatile("" : "+v"(t_));
  const int t = t_, c4 = t & 31, r0 = t >> 5;
  const float* Cs = (const float*)smem;
#pragma unroll 4
  for (int ps = 0; ps < 16; ++ps) {
    const int rr = ps * 8 + r0;
    const float4 f = *(const float4*)(Cs + rr * 132 + c4 * 4);
    const size_t off = (size_t)(m0 + rr) * 1024 + n0 + c4 * 4;
    const float4 xv = *(const float4*)(p.x + off);
    *(float4*)(p.out + off) = make_float4(xv.x + f.x, xv.y + f.y, xv.z + f.z, xv.w + f.w);
  }
}

#define XB_TMO      128
#define XB_XCNT(j)  (256  + 64 * (j))
#define XB_XSUB(j)  (1280 + 64 * (j))
#define XB_XGEN(j)  (2304 + 64 * (j))
#define XB_TOP      3328
#define XB_TOPGEN   3392
#define XCD_BAR_WORDS 3456
#define XB_SPIN_CAP (1u << 20)
#define LAS __attribute__((address_space(3)))
DI unsigned xb_ld(unsigned* p) { return __hip_atomic_load(p, __ATOMIC_RELAXED, __HIP_MEMORY_SCOPE_AGENT); }
DI unsigned xb_add(unsigned* p, unsigned v) { return __hip_atomic_fetch_add(p, v, __ATOMIC_RELAXED, __HIP_MEMORY_SCOPE_AGENT); }
DI unsigned xb_xcc_id() { return (unsigned)__builtin_amdgcn_s_getreg((3 << 11) | 20) & 0xFu; }
#define XB_SPIN(cond, bar) do { unsigned _sp = 0; while (cond) { __builtin_amdgcn_s_sleep(1); \
    if ((++_sp & 255u) == 0u) { if (xb_ld(&(bar)[XB_TMO])) break; if (_sp > XB_SPIN_CAP) { atomicAdd(&(bar)[XB_TMO], 1u); break; } } } } while (0)
struct XcdBarrier { unsigned* bar; unsigned x; volatile LAS unsigned* st; };
DI XcdBarrier xcd_barrier_post(unsigned* bar, volatile LAS unsigned* st) {
  XcdBarrier b; b.bar = bar; b.x = xb_xcc_id(); b.st = st;
  if (threadIdx.x == 0) (void)xb_add(&bar[XB_XCNT(b.x)], 1u);
  return b;
}
DI void xcd_barrier_complete(unsigned* bar, unsigned x, unsigned& nloc, unsigned& nx) {
  const unsigned G = gridDim.x * gridDim.y * gridDim.z;
  unsigned sum, cnt, mine, sp = 0u;
  for (;;) {
    sum = 0u; cnt = 0u; mine = 0u;
#pragma unroll
    for (unsigned j = 0; j < 16; ++j) { const unsigned c = xb_ld(&bar[XB_XCNT(j)]); sum += c; cnt += (c > 0u) ? 1u : 0u; mine = (j == x) ? c : mine; }
    if (sum == G) break;
    __builtin_amdgcn_s_sleep(1);
    if ((++sp & 255u) == 0u) { if (xb_ld(&bar[XB_TMO])) break; if (sp > XB_SPIN_CAP) { atomicAdd(&bar[XB_TMO], 1u); break; } }
  }
  nloc = mine > 0u ? mine : 1u; nx = cnt > 0u ? cnt : 1u;
}
DI void xcd_barrier(const XcdBarrier& b) {
  asm volatile("s_waitcnt vmcnt(0)" ::: "memory");
  __syncthreads();
  if (threadIdx.x == 0) {
    unsigned* bar = b.bar;
    __builtin_amdgcn_s_waitcnt(0);
    unsigned nloc = b.st[0], nx = b.st[1];
    if (nloc == 0u) { xcd_barrier_complete(bar, b.x, nloc, nx); b.st[0] = nloc; b.st[1] = nx; }
    const unsigned old = xb_add(&bar[XB_XSUB(b.x)], 1u);
    const unsigned gen = old / nloc;
    if (old + 1u == (gen + 1u) * nloc) {
      __builtin_amdgcn_fence(__ATOMIC_RELEASE, "agent");
      asm volatile("s_waitcnt vmcnt(0)" ::: "memory");
      const unsigned og = xb_add(&bar[XB_TOP], 1u);
      const unsigned tg = og / nx;
      if (og + 1u == (tg + 1u) * nx) xb_add(&bar[XB_TOPGEN], 1u);
      else XB_SPIN(xb_ld(&bar[XB_TOPGEN]) == tg, bar);
      __builtin_amdgcn_fence(__ATOMIC_ACQUIRE, "agent");
      xb_add(&bar[XB_XGEN(b.x)], 1u);
      asm volatile("s_waitcnt vmcnt(0)" ::: "memory");
    } else {
      XB_SPIN(xb_ld(&bar[XB_XGEN(b.x)]) == gen, bar);
      __builtin_amdgcn_fence(__ATOMIC_ACQUIRE, "agent");
      asm volatile("s_waitcnt vmcnt(0)" ::: "memory");
    }
  }
  __syncthreads();
}

__global__ void __launch_bounds__(256, 2) k_prep(Params p) {
  __shared__ __attribute__((aligned(16))) char smem[SMEM_BYTES];
  phase_prep(p, blockIdx.x * 256 + threadIdx.x, gridDim.x * 256, smem);
}
__global__ void __launch_bounds__(256, 2) k_inproj(Params p) {
  __shared__ __attribute__((aligned(16))) char smem[SMEM_BYTES];
  for (int tile = blockIdx.x; tile < 128 * 37; tile += gridDim.x) inproj_tile(p, tile, smem);
}
__global__ void __launch_bounds__(256, 2) k_dnprep(Params p) {
  __shared__ __attribute__((aligned(16))) char smem[SMEM_BYTES];
  for (int task = blockIdx.x; task < 1024; task += gridDim.x) dn_prep_task(p, task, smem);
}
__global__ void __launch_bounds__(256, 2) k_scan(Params p) {
  __shared__ __attribute__((aligned(16))) char smem[SMEM_BYTES];
  dn_scan(p, blockIdx.x, smem);
}
__global__ void __launch_bounds__(256, 2) k_attn(Params p) {
  __shared__ __attribute__((aligned(16))) char smem[SMEM_BYTES];
  for (int task = blockIdx.x; task < 1024; task += gridDim.x) attn_task(p, task, smem);
}
__global__ void __launch_bounds__(256, 2) k_dnnorm(Params p) {
  dn_norm(p, (blockIdx.x * 256 + threadIdx.x) >> 6, (gridDim.x * 256) >> 6, threadIdx.x & 63);
}
__global__ void __launch_bounds__(256, 2) k_outproj(Params p) {
  __shared__ __attribute__((aligned(16))) char smem[SMEM_BYTES];
  for (int tile = blockIdx.x; tile < 1024; tile += gridDim.x) outproj_tile(p, tile, smem);
}

__global__ void __launch_bounds__(256, 2) k_mega(Params p) {
  __shared__ __attribute__((aligned(16))) char smem[SMEM_BYTES];
  __shared__ uint4 xb_words;
  __shared__ int s_task;
  cg::grid_group grid = cg::this_grid();
  if (threadIdx.x == 0) xb_words = make_uint4(0u, 0u, 0u, 0u);
  __syncthreads();
  XcdBarrier xb = xcd_barrier_post(p.counters + 64, (volatile LAS unsigned*)&xb_words);
  const int gtid = blockIdx.x * 256 + threadIdx.x, gsize = gridDim.x * 256;
  phase_prep(p, gtid, gsize, smem);
  if (p.use_cg_sync) grid.sync();
  xcd_barrier(xb);
  for (int tile = blockIdx.x; tile < 128 * 19; tile += gridDim.x) inproj_tile256(p, tile, smem);
  xcd_barrier(xb);
  for (int task = blockIdx.x; task < 1024; task += gridDim.x) dn_prep_task(p, task, smem);
  xcd_barrier(xb);
  if (blockIdx.x < 32) {
    __builtin_amdgcn_s_setprio(3);
    dn_scan(p, blockIdx.x, smem);
    __builtin_amdgcn_s_setprio(0);
    asm volatile("s_waitcnt vmcnt(0)" ::: "memory");
    __syncthreads();
    if (threadIdx.x == 0) {
      __builtin_amdgcn_fence(__ATOMIC_RELEASE, "agent");
      asm volatile("s_waitcnt vmcnt(0)" ::: "memory");
      atomicAdd(&p.counters[32], 1u);
    }
    __syncthreads();
  }
  {
    int pb = (int)((xb.x >> 2) & 1u);
    int tries = 0;
    while (tries < 2) {
      if (threadIdx.x == 0) s_task = (int)atomicAdd(&p.counters[pb], 1u);
      __syncthreads();
      const int tk = s_task;
      __syncthreads();
      if (tk >= 512 + QSPLIT) { pb ^= 1; ++tries; continue; }
      if (tk < 512 - QSPLIT) attn_task(p, tk * 2 + pb, smem, 0);
      else { const int j = tk - (512 - QSPLIT); attn_task(p, ((512 - QSPLIT) + (j >> 1)) * 2 + pb, smem, 1 + (j & 1)); }
    }
  }
  {
    if (threadIdx.x == 0) {
      unsigned sp = 0;
      while (__hip_atomic_load(&p.counters[32], __ATOMIC_RELAXED, __HIP_MEMORY_SCOPE_AGENT) < 32u) {
        __builtin_amdgcn_s_sleep(4);
        if (++sp > (1u << 22)) break;
      }
      __builtin_amdgcn_fence(__ATOMIC_ACQUIRE, "agent");
      asm volatile("s_waitcnt vmcnt(0)" ::: "memory");
    }
    __syncthreads();
    while (true) {
      if (threadIdx.x == 0) s_task = (int)atomicAdd(&p.counters[33], 1u);
      __syncthreads();
      const int ck = s_task;
      __syncthreads();
      if (ck >= 256) break;
      int tn_ = threadIdx.x;
      asm volatile("" : "+v"(tn_));
      dn_norm_rows(p, ck * 64 + (tn_ >> 6) * 16, tn_ & 63);
    }
  }
  xcd_barrier(xb);
  for (int tile = blockIdx.x; tile < 1024; tile += gridDim.x) outproj_tile(p, tile, smem);
}

extern "C" void kernel_launch(void* const* d_in, const int* in_sizes, int n_in, void* d_out, int out_size, void* d_ws,
                              size_t ws_size, hipStream_t stream) {
  Params p{};
  p.x = (const float*)d_in[0]; p.ln_w = (const float*)d_in[1]; p.w_in = (const float*)d_in[2];
  p.aqw = (const float*)d_in[3]; p.akw = (const float*)d_in[4]; p.ikw = (const float*)d_in[5];
  p.ikb = (const float*)d_in[6]; p.convw = (const float*)d_in[7]; p.alog = (const float*)d_in[8];
  p.dtb = (const float*)d_in[9]; p.dnw = (const float*)d_in[10]; p.w_out = (const float*)d_in[11];
  p.out = (float*)d_out;
  char* ws = (char*)d_ws;
  const size_t MB = 1u << 20;
  p.Wt = (ush*)(ws + 0);
  p.Wo = (ush*)(ws + 10 * MB);
  p.XB = (ush*)(ws + 12 * MB);
  p.MIX = (ush*)(ws + 12 * MB);
  p.QA = (ush*)(ws + 45 * MB); p.KA = (ush*)(ws + 61 * MB); p.VA = (ush*)(ws + 77 * MB);
  p.GA = (ush*)(ws + 93 * MB); p.IQ = (ush*)(ws + 109 * MB); p.DQ = (ush*)(ws + 125 * MB);
  p.DK = (ush*)(ws + 141 * MB); p.DV = (ush*)(ws + 157 * MB); p.SZ = (ush*)(ws + 173 * MB);
  p.IK = (ush*)(ws + 189 * MB);
  p.IW = (float*)(ws + 191 * MB);
  p.BETA = (float*)(ws + 191 * MB + 512 * 1024);
  p.G = (float*)(ws + 191 * MB + 768 * 1024);
  p.INTRA = (ush*)(ws + 192 * MB);
  p.GL = (float*)(ws + 200 * MB);
  p.OD = (float*)(ws + 201 * MB);
  p.counters = (unsigned*)(ws + 233 * MB);
  p.K8 = (unsigned char*)(ws + 61 * MB);
  p.V8 = (unsigned char*)(ws + 77 * MB);
  char* o8 = (char*)d_out;
  p.UT = (ush*)(o8); p.WG = (ush*)(o8 + 16 * MB); p.QG = (ush*)(o8 + 32 * MB); p.KDT = (ush*)(o8 + 48 * MB);

#if MEGA
  static int grid_blocks = 0;
  if (!grid_blocks) {
    int dev = 0, cus = 0, per_cu = 0;
    hipGetDevice(&dev);
    hipDeviceGetAttribute(&cus, hipDeviceAttributeMultiprocessorCount, dev);
    hipOccupancyMaxActiveBlocksPerMultiprocessor(&per_cu, k_mega, 256, 0);
    if (per_cu > 2) per_cu = 2;
    grid_blocks = cus * per_cu;
  }
  hipMemsetAsync(p.counters, 0, (64 + XCD_BAR_WORDS) * sizeof(unsigned), stream);
  void* args[] = {&p};
  hipError_t e = hipLaunchCooperativeKernel((void*)k_mega, dim3(grid_blocks), dim3(256), args, 0, stream);
  if (e != hipSuccess) fprintf(stderr, "cooperative launch failed: %s (grid %d)\n", hipGetErrorString(e), grid_blocks);
#else
  k_prep<<<1024, 256, 0, stream>>>(p);
  k_inproj<<<128 * 37, 256, 0, stream>>>(p);
  k_dnprep<<<1024, 256, 0, stream>>>(p);
  k_scan<<<32, 256, 0, stream>>>(p);
  k_attn<<<1024, 256, 0, stream>>>(p);
  k_dnnorm<<<1024, 256, 0, stream>>>(p);
  k_outproj<<<1024, 256, 0, stream>>>(p);
#endif
}
```

```cpp
#include <hip/hip_runtime.h>
#include <hip/hip_cooperative_groups.h>
#include <cstdio>
#include <cstdint>
namespace cg = cooperative_groups;

#ifndef MEGA
#define MEGA 1
#endif

#define DI __device__ __forceinline__
typedef __attribute__((ext_vector_type(8))) short bf16x8;
typedef __attribute__((ext_vector_type(16))) float f32x16;
typedef __attribute__((ext_vector_type(4))) unsigned u32x4;
typedef __attribute__((ext_vector_type(2))) unsigned u32x2;
typedef __attribute__((ext_vector_type(2))) __bf16 bf2_t;
typedef unsigned short ush;
#define MFMA32(a, b, c) __builtin_amdgcn_mfma_f32_32x32x16_bf16((a), (b), (c), 0, 0, 0)

constexpr int NTOK = 16384;
constexpr int SEQL = 8192;
constexpr int NP = 4736;
constexpr int DIN = 4688;
constexpr int SMEM_BYTES = 74752;
constexpr int QSPLIT = 128;

struct Params {
  const float *x, *ln_w, *w_in, *aqw, *akw, *ikw, *ikb, *convw, *alog, *dtb, *dnw, *w_out;
  float* out;
  ush *Wt, *Wo, *XB, *MIX, *QA, *KA, *VA, *GA, *IQ, *DQ, *DK, *DV, *SZ, *IK, *INTRA;
  ush *UT, *WG, *QG, *KDT;
  float *IW, *BETA, *G, *GL, *OD;
  unsigned* counters;
  unsigned char *K8, *V8;
  int use_cg_sync, pad0;
};

DI ush f2bf(float x) { return __builtin_bit_cast(ush, (__bf16)x); }
DI float bf2f(ush b) { return __uint_as_float(((unsigned)b) << 16); }
DI unsigned pack2(float a, float b) { bf2_t v = {(__bf16)a, (__bf16)b}; return __builtin_bit_cast(unsigned, v); }
DI float bflo(unsigned u) { return __uint_as_float(u << 16); }
DI float bfhi(unsigned u) { return __uint_as_float(u & 0xffff0000u); }
DI int crow(int reg, int h) { return (reg & 3) + 8 * (reg >> 2) + 4 * h; }
DI float silu_f(float v) { return v / (1.f + __expf(-v)); }
DI f32x16 zero16() { f32x16 z; for (int i = 0; i < 16; ++i) z[i] = 0.f; return z; }

template <int CTRL> DI float dppmov(float x) {
  return __int_as_float(__builtin_amdgcn_update_dpp(0, __float_as_int(x), CTRL, 0xF, 0xF, true));
}
DI float red8(float d) {
  d += dppmov<0xB1>(d);
  d += dppmov<0x4E>(d);
  d += dppmov<0x141>(d);
  return d;
}
DI unsigned mbcnt64(unsigned long long m) {
  return __builtin_amdgcn_mbcnt_hi((unsigned)(m >> 32), __builtin_amdgcn_mbcnt_lo((unsigned)m, 0u));
}
DI int mapcol(int n) {
  if (n < 2560) return n;
  if (n < 4608) return n + 72;
  if (n < 4680) return n - 2048;
  if (n < 4688) return n;
  return -1;
}

DI void phase_prep(const Params& p, int gtid, int gsize, char* smem) {
  {
    unsigned* Ts = (unsigned*)smem;
    ush* Th = (ush*)smem;
    int t_ = threadIdx.x;
    asm volatile("" : "+v"(t_));
    const int t = t_;
    for (int tt = blockIdx.x; tt < 1472; tt += gridDim.x) {
      const bool is_in = tt < 1216;
      const int id = is_in ? tt : tt - 1216;
      const int nt = is_in ? id % 76 : (id & 15), kt = is_in ? id / 76 : (id >> 4);
      const float* src = is_in ? p.w_in : p.w_out;
      const int ld = is_in ? DIN : 1024;
      ush* dst = is_in ? p.Wt : p.Wo;
      {
        const int n = t & 63, ks = t >> 6;
        const int oc = is_in ? mapcol(nt * 64 + n) : nt * 64 + n;
#pragma unroll
        for (int it = 0; it < 16; ++it) {
          int k = it * 4 + ks;
          float v = oc >= 0 ? src[(size_t)(kt * 64 + k) * ld + oc] : 0.f;
          Th[n * 66 + k] = f2bf(v);
        }
      }
      __syncthreads();
      {
        const int n = t >> 2, kq = t & 3;
        u32x4 a, b;
#pragma unroll
        for (int i = 0; i < 4; ++i) { a[i] = Ts[n * 33 + kq * 8 + i]; b[i] = Ts[n * 33 + kq * 8 + 4 + i]; }
        u32x4* dp = (u32x4*)(dst + (size_t)(nt * 64 + n) * 1024 + kt * 64 + kq * 16);
        dp[0] = a; dp[1] = b;
      }
      __syncthreads();
    }
  }
  int wave = gtid >> 6, lane = gtid & 63, nw = gsize >> 6;
  for (int row = wave; row < NTOK; row += nw) {
    const float4* xr = (const float4*)(p.x + (size_t)row * 1024);
    float4 a[4];
    float ss = 0.f;
#pragma unroll
    for (int i = 0; i < 4; ++i) {
      a[i] = xr[lane + 64 * i];
      ss += a[i].x * a[i].x + a[i].y * a[i].y + a[i].z * a[i].z + a[i].w * a[i].w;
    }
#pragma unroll
    for (int o = 1; o < 64; o <<= 1) ss += __shfl_xor(ss, o);
    float rs = rsqrtf(ss * (1.f / 1024.f) + 1e-6f);
#pragma unroll
    for (int i = 0; i < 4; ++i) {
      float4 lw = ((const float4*)p.ln_w)[lane + 64 * i];
      u32x2 o;
      o[0] = pack2(a[i].x * rs * lw.x, a[i].y * rs * lw.y);
      o[1] = pack2(a[i].z * rs * lw.z, a[i].w * rs * lw.w);
      *(u32x2*)(p.XB + (size_t)row * 1024 + (lane + 64 * i) * 4) = o;
    }
  }
}

DI void gemm_tile(const ush* __restrict__ A, const ush* __restrict__ B, int m0, int n0, int K, char* smem,
                  f32x16 (&acc)[2][2]) {
  ush* As = (ush*)smem;
  ush* Bs = As + 128 * 72;
  int t_ = threadIdx.x;
  asm volatile("" : "+v"(t_));
  const int t = t_, lane = t & 63, w = t >> 6, wm = w >> 1, wn = w & 1, r = lane & 31, h = lane >> 5;
  u32x4 ra[4], rb[4];
#pragma unroll
  for (int i = 0; i < 2; ++i)
#pragma unroll
    for (int j = 0; j < 2; ++j) acc[i][j] = zero16();
#pragma unroll
  for (int i = 0; i < 4; ++i) {
    int c = t + 256 * i, row = c >> 3, kc = c & 7;
    ra[i] = *(const u32x4*)(A + (size_t)(m0 + row) * K + kc * 8);
    rb[i] = *(const u32x4*)(B + (size_t)(n0 + row) * K + kc * 8);
  }
  for (int k0 = 0; k0 < K; k0 += 64) {
    __syncthreads();
#pragma unroll
    for (int i = 0; i < 4; ++i) {
      int c = t + 256 * i, row = c >> 3, kc = c & 7;
      *(u32x4*)(As + row * 72 + kc * 8) = ra[i];
      *(u32x4*)(Bs + row * 72 + kc * 8) = rb[i];
    }
    __syncthreads();
    if (k0 + 64 < K) {
#pragma unroll
      for (int i = 0; i < 4; ++i) {
        int c = t + 256 * i, row = c >> 3, kc = c & 7;
        ra[i] = *(const u32x4*)(A + (size_t)(m0 + row) * K + k0 + 64 + kc * 8);
        rb[i] = *(const u32x4*)(B + (size_t)(n0 + row) * K + k0 + 64 + kc * 8);
      }
    }
#pragma unroll
    for (int s = 0; s < 4; ++s) {
      bf16x8 af[2], bfr[2];
#pragma unroll
      for (int i = 0; i < 2; ++i) af[i] = *(const bf16x8*)(As + (wm * 64 + i * 32 + r) * 72 + s * 16 + h * 8);
#pragma unroll
      for (int j = 0; j < 2; ++j) bfr[j] = *(const bf16x8*)(Bs + (wn * 64 + j * 32 + r) * 72 + s * 16 + h * 8);
#pragma unroll
      for (int i = 0; i < 2; ++i)
#pragma unroll
        for (int j = 0; j < 2; ++j) acc[i][j] = MFMA32(af[i], bfr[j], acc[i][j]);
    }
  }
  __syncthreads();
}

DI const float* stage_rows(f32x16 (&acc)[2][2], char* smem) {
  float* Cs = (float*)smem;
  int t_ = threadIdx.x;
  asm volatile("" : "+v"(t_));
  const int t = t_, lane = t & 63, w = t >> 6, wm = w >> 1, wn = w & 1, r = lane & 31, h = lane >> 5;
#pragma unroll
  for (int i = 0; i < 2; ++i)
#pragma unroll
    for (int j = 0; j < 2; ++j)
#pragma unroll
      for (int reg = 0; reg < 16; ++reg)
        Cs[(wm * 64 + i * 32 + crow(reg, h)) * 132 + wn * 64 + j * 32 + r] = acc[i][j][reg];
  __syncthreads();
  return Cs + (t & 127) * 132 + (t >> 7) * 64;
}
DI u32x4 pack8(float4 a, float4 b) {
  u32x4 o;
  o[0] = pack2(a.x, a.y); o[1] = pack2(a.z, a.w); o[2] = pack2(b.x, b.y); o[3] = pack2(b.z, b.w);
  return o;
}
DI float4 mul4(float4 a, float4 b) { return make_float4(a.x * b.x, a.y * b.y, a.z * b.z, a.w * b.w); }
DI float4 scl4(float4 a, float s) { return make_float4(a.x * s, a.y * s, a.z * s, a.w * s); }
DI unsigned cvt4_fp8(float a, float b, float c, float d) {
  int r = 0;
  r = __builtin_amdgcn_cvt_pk_fp8_f32(a, b, r, false);
  r = __builtin_amdgcn_cvt_pk_fp8_f32(c, d, r, true);
  return (unsigned)r;
}
DI float4 silu4(float4 a) { return make_float4(silu_f(a.x), silu_f(a.y), silu_f(a.z), silu_f(a.w)); }

DI void inproj_epilogue(const Params& p, int row, int nt, int half, const float4* cv) {
  if (nt < 36) {
    const int grp = nt >> 2;
    const int col = (nt & 3) * 128 + half * 64;
    ush* dst = (ush*)((char*)p.QA + (size_t)grp * (16u << 20));
    u32x4* dp = (u32x4*)(dst + (size_t)row * 512 + col);
    if (grp == 0) {
      float ss = 0.f;
#pragma unroll
      for (int q = 0; q < 16; ++q) { float4 f = cv[q]; ss += f.x * f.x + f.y * f.y + f.z * f.z + f.w * f.w; }
      const float rs = rsqrtf(ss * (1.f / 64.f) + 1e-6f);
      const float4* nw = (const float4*)p.aqw;
#pragma unroll
      for (int q = 0; q < 8; ++q)
        dp[q] = pack8(scl4(mul4(cv[2 * q], nw[2 * q]), rs), scl4(mul4(cv[2 * q + 1], nw[2 * q + 1]), rs));
    } else if (grp == 1) {
      float ss = 0.f;
#pragma unroll
      for (int q = 0; q < 16; ++q) { float4 f = cv[q]; ss += f.x * f.x + f.y * f.y + f.z * f.z + f.w * f.w; }
      const float rs = rsqrtf(ss * (1.f / 64.f) + 1e-6f);
      const float4* nw = (const float4*)p.akw;
      u32x4* d8 = (u32x4*)(p.K8 + (size_t)row * 512 + col);
#pragma unroll
      for (int q = 0; q < 4; ++q) {
        u32x4 o;
#pragma unroll
        for (int k = 0; k < 4; ++k) { float4 f = scl4(mul4(cv[4 * q + k], nw[4 * q + k]), rs); o[k] = cvt4_fp8(f.x, f.y, f.z, f.w); }
        d8[q] = o;
      }
    } else if (grp == 2) {
      u32x4* d8 = (u32x4*)(p.V8 + (size_t)row * 512 + col);
#pragma unroll
      for (int q = 0; q < 4; ++q) {
        u32x4 o;
#pragma unroll
        for (int k = 0; k < 4; ++k) { float4 f = cv[4 * q + k]; o[k] = cvt4_fp8(f.x, f.y, f.z, f.w); }
        d8[q] = o;
      }
    } else if (grp == 3 || grp == 8) {
#pragma unroll
      for (int q = 0; q < 8; ++q) dp[q] = pack8(silu4(cv[2 * q]), silu4(cv[2 * q + 1]));
    } else {
#pragma unroll
      for (int q = 0; q < 8; ++q) dp[q] = pack8(cv[2 * q], cv[2 * q + 1]);
    }
  } else {
    if (half == 0) {
      float mu = 0.f;
#pragma unroll
      for (int q = 0; q < 16; ++q) { float4 f = cv[q]; mu += f.x + f.y + f.z + f.w; }
      mu *= (1.f / 64.f);
      float var = 0.f;
#pragma unroll
      for (int q = 0; q < 16; ++q) {
        float4 f = cv[q];
        var += (f.x - mu) * (f.x - mu) + (f.y - mu) * (f.y - mu) + (f.z - mu) * (f.z - mu) + (f.w - mu) * (f.w - mu);
      }
      float rs = rsqrtf(var * (1.f / 64.f) + 1e-6f);
      const float4* kw = (const float4*)p.ikw;
      const float4* kb = (const float4*)p.ikb;
      u32x4* dp = (u32x4*)(p.IK + (size_t)row * 64);
#pragma unroll
      for (int q = 0; q < 8; ++q) {
        float4 a = cv[2 * q], c = cv[2 * q + 1], wa = kw[2 * q], wc = kw[2 * q + 1], ba = kb[2 * q], bc = kb[2 * q + 1];
        a = make_float4((a.x - mu) * rs * wa.x + ba.x, (a.y - mu) * rs * wa.y + ba.y, (a.z - mu) * rs * wa.z + ba.z, (a.w - mu) * rs * wa.w + ba.w);
        c = make_float4((c.x - mu) * rs * wc.x + bc.x, (c.y - mu) * rs * wc.y + bc.y, (c.z - mu) * rs * wc.z + bc.z, (c.w - mu) * rs * wc.w + bc.w);
        dp[q] = pack8(a, c);
      }
    } else {
      const float* v = (const float*)cv;
#pragma unroll
      for (int c = 0; c < 8; ++c) p.IW[(size_t)row * 8 + c] = v[c] * 0.044194173824159216f;
#pragma unroll
      for (int c = 0; c < 4; ++c) {
        p.BETA[(size_t)row * 4 + c] = 1.f / (1.f + expf(-v[8 + c]));
        float xx = v[12 + c] + p.dtb[c];
        float sp = xx > 20.f ? xx : log1pf(expf(xx));
        p.G[(size_t)row * 4 + c] = -expf(p.alog[c]) * sp;
      }
    }
  }
}

DI void inproj_tile(const Params& p, int tile, char* smem) {
  const int mt = tile / 37, nt = tile % 37;
  const int m0 = mt * 128, n0 = nt * 128;
  f32x16 acc[2][2];
  gemm_tile(p.XB, p.Wt, m0, n0, 1024, smem, acc);
  const float4* cv = (const float4*)stage_rows(acc, smem);
  const int t = threadIdx.x;
  inproj_epilogue(p, m0 + (t & 127), nt, t >> 7, cv);
}

DI void inproj_tile256(const Params& p, int tile, char* smem) {
  const int mt = tile / 19, n2 = tile % 19;
  const int m0 = mt * 128, n0 = n2 * 256;
  ush* As = (ush*)smem;
  ush* Bs = As + 128 * 72;
  int t_ = threadIdx.x;
  asm volatile("" : "+v"(t_));
  const int t = t_, lane = t & 63, w = t >> 6, wm = w >> 1, wn = w & 1, r = lane & 31, h = lane >> 5;
  f32x16 acc[2][4];
#pragma unroll
  for (int i = 0; i < 2; ++i)
#pragma unroll
    for (int j = 0; j < 4; ++j) acc[i][j] = zero16();
  u32x4 ra[4], rb[8];
  const int lrow = t >> 3, lkc = t & 7;
  const unsigned voff = (unsigned)(lrow * 1024 + lkc * 8) * 2u;
  const char* abase = (const char*)(p.XB + (size_t)m0 * 1024);
  const char* bbase = (const char*)(p.Wt + (size_t)n0 * 1024);
#pragma unroll
  for (int i = 0; i < 4; ++i) ra[i] = *(const u32x4*)(abase + (size_t)i * 65536 + voff);
#pragma unroll
  for (int i = 0; i < 8; ++i) rb[i] = *(const u32x4*)(bbase + (size_t)i * 65536 + voff);
  for (int k0 = 0; k0 < 1024; k0 += 64) {
    __syncthreads();
#pragma unroll
    for (int i = 0; i < 4; ++i) *(u32x4*)(As + (lrow + 32 * i) * 72 + lkc * 8) = ra[i];
#pragma unroll
    for (int i = 0; i < 8; ++i) *(u32x4*)(Bs + (lrow + 32 * i) * 72 + lkc * 8) = rb[i];
    __syncthreads();
    {
      const int kn = k0 + 64 < 1024 ? k0 + 64 : k0;
#pragma unroll
      for (int i = 0; i < 4; ++i) ra[i] = *(const u32x4*)(abase + ((size_t)i * 65536 + (size_t)kn * 2) + voff);
#pragma unroll
      for (int i = 0; i < 8; ++i) rb[i] = *(const u32x4*)(bbase + ((size_t)i * 65536 + (size_t)kn * 2) + voff);
    }
#pragma unroll
    for (int s = 0; s < 4; ++s) {
      bf16x8 af[2], bfr[4];
#pragma unroll
      for (int i = 0; i < 2; ++i) af[i] = *(const bf16x8*)(As + (wm * 64 + i * 32 + r) * 72 + s * 16 + h * 8);
#pragma unroll
      for (int j = 0; j < 4; ++j) bfr[j] = *(const bf16x8*)(Bs + (wn * 128 + j * 32 + r) * 72 + s * 16 + h * 8);
#pragma unroll
      for (int i = 0; i < 2; ++i)
#pragma unroll
        for (int j = 0; j < 4; ++j) acc[i][j] = MFMA32(af[i], bfr[j], acc[i][j]);
    }
  }
  __syncthreads();
  const int nt = __builtin_amdgcn_readfirstlane(2 * n2 + wn);
  if (nt < 37) {
    float* Cw = (float*)smem + w * 4384;
#pragma unroll
    for (int jp = 0; jp < 2; ++jp) {
#pragma unroll
      for (int i = 0; i < 2; ++i)
#pragma unroll
        for (int jj = 0; jj < 2; ++jj)
#pragma unroll
          for (int reg = 0; reg < 16; ++reg)
            Cw[(i * 32 + crow(reg, h)) * 68 + jj * 32 + r] = acc[i][2 * jp + jj][reg];
      inproj_epilogue(p, m0 + wm * 64 + lane, nt, jp, (const float4*)(Cw + lane * 68));
    }
  }
  __syncthreads();
}

DI void dn_prep_task(const Params& p, int task, char* smem) {
  int t_ = threadIdx.x;
  asm volatile("" : "+v"(t_));
  const int t = t_, lane = t & 63, w = t >> 6;
  const int h = task & 3, c = (task >> 2) & 127, b = task >> 9;
  const size_t ch = (size_t)(b * 4 + h) * 128 + c;
  const size_t row0 = (size_t)b * SEQL + c * 64;
  ush* Qs = (ush*)smem;
  ush* Ks = Qs + 64 * 136;
  ush* Vs = Ks + 64 * 136;
  float* As = (float*)(smem + 52224);
  float* gcs = (float*)(smem + 68608);
  float* bts = gcs + 64;
  float* ebg = bts + 64;
  float* ekd = ebg + 64;
  float* egc = ekd + 64;
  if (w == 0) {
    float g = p.G[(row0 + lane) * 4 + h];
#pragma unroll
    for (int o = 1; o < 64; o <<= 1) { float y = __shfl_up(g, o); if (lane >= o) g += y; }
    float bt = p.BETA[(row0 + lane) * 4 + h];
    float gl = __shfl(g, 63);
    gcs[lane] = g; bts[lane] = bt; ebg[lane] = bt * expf(g); ekd[lane] = expf(gl - g); egc[lane] = expf(g);
    if (lane == 63) p.GL[ch] = expf(g);
  }
  {
    float* cws = As;
    for (int e = t; e < 1536; e += 256) {
      int j = e / 384, rem = e - j * 384, X = rem >> 7, col = rem & 127;
      cws[e] = p.convw[(size_t)j * 1536 + X * 512 + h * 128 + col];
    }
  }
  __syncthreads();
  {
    const int i = t >> 2, cg = t & 3;
#pragma unroll 1
    for (int X = 0; X < 3; ++X) {
      const ush* src = X == 0 ? p.DQ : (X == 1 ? p.DK : p.DV);
      ush* dstS = X == 0 ? Qs : (X == 1 ? Ks : Vs);
      float y[32];
#pragma unroll
      for (int e = 0; e < 32; ++e) y[e] = 0.f;
#pragma unroll
      for (int j = 0; j < 4; ++j) {
        const int pos = c * 64 + i - 3 + j;
        const float vz = pos >= 0 ? 1.f : 0.f;
        const int posc = pos >= 0 ? pos : 0;
        {
          const u32x4* rp = (const u32x4*)(src + ((size_t)b * SEQL + posc) * 512 + h * 128 + cg * 32);
          const float4* wp = (const float4*)(As + (j * 3 + X) * 128 + cg * 32);
#pragma unroll
          for (int q = 0; q < 4; ++q) {
            u32x4 d = rp[q];
            float4 wa = wp[q * 2], wb = wp[q * 2 + 1];
            wa = scl4(wa, vz); wb = scl4(wb, vz);
            y[q * 8 + 0] += wa.x * bflo(d[0]); y[q * 8 + 1] += wa.y * bfhi(d[0]);
            y[q * 8 + 2] += wa.z * bflo(d[1]); y[q * 8 + 3] += wa.w * bfhi(d[1]);
            y[q * 8 + 4] += wb.x * bflo(d[2]); y[q * 8 + 5] += wb.y * bfhi(d[2]);
            y[q * 8 + 6] += wb.z * bflo(d[3]); y[q * 8 + 7] += wb.w * bfhi(d[3]);
          }
        }
      }
      float ss = 0.f;
#pragma unroll
      for (int e = 0; e < 32; ++e) { y[e] = silu_f(y[e]); ss += y[e] * y[e]; }
      float rs = 1.f;
      if (X < 2) {
        ss += __shfl_xor(ss, 1);
        ss += __shfl_xor(ss, 2);
        rs = rsqrtf(ss + 1e-6f);
        if (X == 0) rs *= 0.08838834764831845f;
      }
#pragma unroll
      for (int q = 0; q < 4; ++q) {
        u32x4 o;
        o[0] = pack2(y[q * 8 + 0] * rs, y[q * 8 + 1] * rs); o[1] = pack2(y[q * 8 + 2] * rs, y[q * 8 + 3] * rs);
        o[2] = pack2(y[q * 8 + 4] * rs, y[q * 8 + 5] * rs); o[3] = pack2(y[q * 8 + 6] * rs, y[q * 8 + 7] * rs);
        *(u32x4*)(dstS + i * 136 + cg * 32 + q * 8) = o;
      }
    }
  }
  __syncthreads();
  {
    const int ti = w >> 1, tj = w & 1, r = lane & 31, hh = lane >> 5;
    f32x16 skk = zero16(), sqk = zero16();
#pragma unroll
    for (int s = 0; s < 8; ++s) {
      bf16x8 ak = *(const bf16x8*)(Ks + (ti * 32 + r) * 136 + s * 16 + hh * 8);
      bf16x8 aq = *(const bf16x8*)(Qs + (ti * 32 + r) * 136 + s * 16 + hh * 8);
      bf16x8 bk = *(const bf16x8*)(Ks + (tj * 32 + r) * 136 + s * 16 + hh * 8);
      skk = MFMA32(ak, bk, skk);
      sqk = MFMA32(aq, bk, sqk);
    }
#pragma unroll
    for (int reg = 0; reg < 16; ++reg) {
      int ii = ti * 32 + crow(reg, hh), jj = tj * 32 + r;
      float dec = (jj <= ii) ? expf(gcs[ii] - gcs[jj]) : 0.f;
      As[ii * 64 + jj] = (jj < ii) ? bts[ii] * skk[reg] * dec : 0.f;
      p.INTRA[ch * 4096 + ii * 64 + jj] = f2bf(sqk[reg] * dec);
    }
  }
  __syncthreads();
  {
    float xs[64];
#pragma unroll
    for (int i = 0; i < 64; ++i) xs[i] = 0.f;
    const int col = t & 127;
    const bool isw = t >= 128;
#pragma unroll
    for (int i = 0; i < 64; ++i) {
      float a = isw ? ebg[i] * bf2f(Ks[i * 136 + col]) : bts[i] * bf2f(Vs[i * 136 + col]);
#pragma unroll
      for (int j4 = 0; j4 < (i + 3) / 4; ++j4) {
        float4 av = *(const float4*)(As + i * 64 + j4 * 4);
        a -= av.x * xs[j4 * 4 + 0];
        a -= av.y * xs[j4 * 4 + 1];
        a -= av.z * xs[j4 * 4 + 2];
        a -= av.w * xs[j4 * 4 + 3];
      }
      xs[i] = a;
    }
    if (!isw) {
#pragma unroll
      for (int q = 0; q < 8; ++q) {
        u32x4 o;
        o[0] = pack2(xs[q * 8 + 0], xs[q * 8 + 1]); o[1] = pack2(xs[q * 8 + 2], xs[q * 8 + 3]);
        o[2] = pack2(xs[q * 8 + 4], xs[q * 8 + 5]); o[3] = pack2(xs[q * 8 + 6], xs[q * 8 + 7]);
        *(u32x4*)(p.UT + ch * 8192 + col * 64 + q * 8) = o;
      }
    } else {
#pragma unroll
      for (int i = 0; i < 64; ++i) p.WG[ch * 8192 + i * 128 + col] = f2bf(xs[i]);
    }
  }
  {
    const int i = t >> 2, cg = t & 3;
    const float e = egc[i];
#pragma unroll
    for (int q = 0; q < 4; ++q) {
      u32x4 d = *(const u32x4*)(Qs + i * 136 + cg * 32 + q * 8);
      u32x4 o;
#pragma unroll
      for (int k = 0; k < 4; ++k) o[k] = pack2(bflo(d[k]) * e, bfhi(d[k]) * e);
      *(u32x4*)(p.QG + ch * 8192 + i * 128 + cg * 32 + q * 8) = o;
    }
    const int d_ = t & 127, ih = t >> 7;
#pragma unroll
    for (int q = 0; q < 4; ++q) {
      float vv[8];
#pragma unroll
      for (int k = 0; k < 8; ++k) { int ii = ih * 32 + q * 8 + k; vv[k] = bf2f(Ks[ii * 136 + d_]) * ekd[ii]; }
      u32x4 o;
      o[0] = pack2(vv[0], vv[1]); o[1] = pack2(vv[2], vv[3]); o[2] = pack2(vv[4], vv[5]); o[3] = pack2(vv[6], vv[7]);
      *(u32x4*)(p.KDT + ch * 8192 + d_ * 64 + ih * 32 + q * 8) = o;
    }
  }
  __syncthreads();
}

DI void dn_scan(const Params& p, int sw, char* smem) {
  int t_ = threadIdx.x;
  asm volatile("" : "+v"(t_));
  const int t = t_, lane = t & 63, w = t >> 6, r = lane & 31, hh = lane >> 5;
  const int bh = sw & 7, slice = sw >> 3;
  const int b = bh >> 2, h = bh & 3;
  ush* ST = (ush*)smem;
  ush* VNT = ST + 32 * 136;
  for (int i = t; i < 32 * 136 / 2; i += 256) ((unsigned*)ST)[i] = 0u;
  f32x16 S = zero16();
  const int wv = w & 1;
  const bool isP = w < 2;
  const ush* Abase = isP ? p.WG : p.QG;
  bf16x8 a32[8], kd[4], in4[4];
  u32x2 u4[4];
  bf16x8 na32[8], nkd[4], nin4[4];
  u32x2 nu4[4];
#pragma unroll
  for (int s = 0; s < 4; ++s) { in4[s] = (bf16x8){0,0,0,0,0,0,0,0}; nin4[s] = in4[s]; u4[s] = (u32x2){0u, 0u}; nu4[s] = u4[s]; }
  {
    const size_t ch = (size_t)bh * 128;
#pragma unroll
    for (int s = 0; s < 8; ++s) a32[s] = *(const bf16x8*)(Abase + ch * 8192 + (32 * wv + r) * 128 + s * 16 + hh * 8);
#pragma unroll
    for (int s = 0; s < 4; ++s) kd[s] = *(const bf16x8*)(p.KDT + ch * 8192 + (32 * w + r) * 64 + s * 16 + hh * 8);
    if (!isP) {
#pragma unroll
      for (int s = 0; s < 4; ++s) in4[s] = *(const bf16x8*)(p.INTRA + ch * 4096 + (32 * wv + r) * 64 + s * 16 + hh * 8);
    } else {
#pragma unroll
      for (int g = 0; g < 4; ++g) u4[g] = *(const u32x2*)(p.UT + ch * 8192 + (slice * 32 + r) * 64 + 32 * wv + 8 * g + 4 * hh);
    }
  }
  __syncthreads();
  for (int c = 0; c < 128; ++c) {
    {
      const size_t ch = (size_t)bh * 128 + (c + 1 < 128 ? c + 1 : 127);
#pragma unroll
      for (int s = 0; s < 8; ++s) na32[s] = *(const bf16x8*)(Abase + ch * 8192 + (32 * wv + r) * 128 + s * 16 + hh * 8);
#pragma unroll
      for (int s = 0; s < 4; ++s) nkd[s] = *(const bf16x8*)(p.KDT + ch * 8192 + (32 * w + r) * 64 + s * 16 + hh * 8);
      if (!isP) {
#pragma unroll
        for (int s = 0; s < 4; ++s) nin4[s] = *(const bf16x8*)(p.INTRA + ch * 4096 + (32 * wv + r) * 64 + s * 16 + hh * 8);
      } else {
#pragma unroll
        for (int g = 0; g < 4; ++g) nu4[g] = *(const u32x2*)(p.UT + ch * 8192 + (slice * 32 + r) * 64 + 32 * wv + 8 * g + 4 * hh);
      }
    }
    const float gl = p.GL[bh * 128 + c];
    f32x16 acc = zero16();
#pragma unroll
    for (int s = 0; s < 8; ++s) {
      bf16x8 bS = *(const bf16x8*)(ST + r * 136 + s * 16 + hh * 8);
      acc = MFMA32(a32[s], bS, acc);
    }
    if (isP) {
#pragma unroll
      for (int g = 0; g < 4; ++g) {
        float v0 = bflo(u4[g][0]) - acc[4 * g + 0], v1 = bfhi(u4[g][0]) - acc[4 * g + 1];
        float v2 = bflo(u4[g][1]) - acc[4 * g + 2], v3 = bfhi(u4[g][1]) - acc[4 * g + 3];
        u32x2 o; o[0] = pack2(v0, v1); o[1] = pack2(v2, v3);
        *(u32x2*)(VNT + r * 72 + 32 * wv + 8 * g + 4 * hh) = o;
      }
    }
    __syncthreads();
    bf16x8 bV[4];
#pragma unroll
    for (int s = 0; s < 4; ++s) bV[s] = *(const bf16x8*)(VNT + r * 72 + s * 16 + hh * 8);
    if (!isP) {
#pragma unroll
      for (int s = 0; s < 4; ++s) acc = MFMA32(in4[s], bV[s], acc);
      float* od = p.OD + ((size_t)b * SEQL + c * 64 + 32 * wv) * 512 + h * 128 + slice * 32 + r;
#pragma unroll
      for (int reg = 0; reg < 16; ++reg) od[(size_t)crow(reg, hh) * 512] = acc[reg];
    }
#pragma unroll
    for (int i = 0; i < 16; ++i) S[i] *= gl;
#pragma unroll
    for (int s = 0; s < 4; ++s) S = MFMA32(kd[s], bV[s], S);
#pragma unroll
    for (int g = 0; g < 4; ++g) {
      u32x2 o; o[0] = pack2(S[4 * g + 0], S[4 * g + 1]); o[1] = pack2(S[4 * g + 2], S[4 * g + 3]);
      *(u32x2*)(ST + r * 136 + 32 * w + 8 * g + 4 * hh) = o;
    }
    __syncthreads();
#pragma unroll
    for (int s = 0; s < 8; ++s) a32[s] = na32[s];
#pragma unroll
    for (int s = 0; s < 4; ++s) { kd[s] = nkd[s]; in4[s] = nin4[s]; u4[s] = nu4[s]; }
  }
}

DI float relu_i(float x) { int v = __float_as_int(x); return __int_as_float(v > 0 ? v : 0); }
DI unsigned ukey(float f) { unsigned u = __float_as_uint(f); return (u & 0x80000000u) ? ~u : (u | 0x80000000u); }

template <int CTRL> DI unsigned dppmov_u(unsigned x) {
  return (unsigned)__builtin_amdgcn_update_dpp(0, (int)x, CTRL, 0xF, 0xF, true);
}
DI unsigned wave_max_u32(unsigned v) {
  unsigned y;
  y = dppmov_u<0xB1>(v); v = v > y ? v : y;
  y = dppmov_u<0x4E>(v); v = v > y ? v : y;
  y = dppmov_u<0x141>(v); v = v > y ? v : y;
  y = dppmov_u<0x140>(v); v = v > y ? v : y;
  const unsigned a = (unsigned)__builtin_amdgcn_readlane((int)v, 0), b = (unsigned)__builtin_amdgcn_readlane((int)v, 16);
  const unsigned c = (unsigned)__builtin_amdgcn_readlane((int)v, 32), d = (unsigned)__builtin_amdgcn_readlane((int)v, 48);
  const unsigned ab = a > b ? a : b, cd = c > d ? c : d;
  return ab > cd ? ab : cd;
}
DI unsigned wave_min_u32(unsigned v) {
  unsigned y;
  y = dppmov_u<0xB1>(v); v = v < y ? v : y;
  y = dppmov_u<0x4E>(v); v = v < y ? v : y;
  y = dppmov_u<0x141>(v); v = v < y ? v : y;
  y = dppmov_u<0x140>(v); v = v < y ? v : y;
  const unsigned a = (unsigned)__builtin_amdgcn_readlane((int)v, 0), b = (unsigned)__builtin_amdgcn_readlane((int)v, 16);
  const unsigned c = (unsigned)__builtin_amdgcn_readlane((int)v, 32), d = (unsigned)__builtin_amdgcn_readlane((int)v, 48);
  const unsigned ab = a < b ? a : b, cd = c < d ? c : d;
  return ab < cd ? ab : cd;
}
DI unsigned inv_ukey(unsigned k) { return (k & 0x80000000u) ? (k & 0x7fffffffu) : ~k; }
DI void compact16(unsigned* bk, unsigned* bi, int& cnt, float& th_out, int lane) {
  const int n = cnt;
  unsigned k[8], ix[8], raw[8];
  unsigned kmx = 0u, kmn = 0xffffffffu;
#pragma unroll
  for (int q = 0; q < 8; ++q) {
    int e = lane + 64 * q; raw[q] = bk[e]; ix[q] = bi[e];
    const unsigned kk = ukey(__uint_as_float(raw[q]));
    const bool v = e < n;
    k[q] = v ? kk : 0u;
    kmx = (v && kk > kmx) ? kk : kmx;
    kmn = (v && kk < kmn) ? kk : kmn;
  }
  kmx = wave_max_u32(kmx); kmn = wave_min_u32(kmn);
  const unsigned diff = kmx ^ kmn;
  unsigned P = kmn;
  if (diff) {
    const int top = 31 - __builtin_clz(diff);
    P = kmx & ~((2u << top) - 1u);
#pragma unroll 1
    for (int bit = top; bit >= 0; --bit) {
      const unsigned tk = P | (1u << bit);
      int c = 0;
#pragma unroll
      for (int q = 0; q < 8; ++q) c += __popcll(__builtin_amdgcn_ballot_w64(k[q] >= tk));
      if (c >= 256) { P = tk; if (c <= 320) break; }
    }
  }
  int base = 0;
#pragma unroll
  for (int q = 0; q < 8; ++q) {
    const bool keep = k[q] >= P && k[q] != 0u;
    unsigned long long m = __builtin_amdgcn_ballot_w64(keep);
    int pre = base + (int)mbcnt64(m);
    if (keep) { bk[pre] = raw[q]; bi[pre] = ix[q]; }
    base += __popcll(m);
  }
  cnt = base;
  th_out = __uint_as_float(inv_ukey(P));
}

DI int final_select(unsigned* bk, unsigned* bi, int cnt, int lane) {
  if (cnt <= 256) return cnt;
  unsigned k[8], ix[8];
  unsigned kmx = 0u, kmn = 0xffffffffu;
#pragma unroll
  for (int q = 0; q < 8; ++q) {
    int e = lane + 64 * q; unsigned kk = ukey(__uint_as_float(bk[e])); ix[q] = bi[e];
    const bool v = e < cnt;
    k[q] = v ? kk : 0u;
    kmx = (v && kk > kmx) ? kk : kmx;
    kmn = (v && kk < kmn) ? kk : kmn;
  }
  kmx = wave_max_u32(kmx); kmn = wave_min_u32(kmn);
  const unsigned diff = kmx ^ kmn;
  unsigned P = kmn;
  if (diff) {
    const int top = 31 - __builtin_clz(diff);
    P = kmx & ~((2u << top) - 1u);
#pragma unroll 1
    for (int bit = top; bit >= 0; --bit) {
      const unsigned tk = P | (1u << bit);
      int c = 0;
#pragma unroll
      for (int q = 0; q < 8; ++q) c += __popcll(__ballot(k[q] >= tk));
      if (c >= 256) { P = tk; if (c == 256) break; }
    }
  }
  int cge = 0, cgt = 0;
#pragma unroll
  for (int q = 0; q < 8; ++q) { cge += __popcll(__ballot(k[q] >= P)); cgt += __popcll(__ballot(k[q] > P)); }
  const bool cut = (cge == 256);
  const int need = 256 - cgt;
  int base = 0, eqseen = 0;
#pragma unroll
  for (int q = 0; q < 8; ++q) {
    bool gt = k[q] > P, eq = k[q] == P, ge = k[q] >= P;
    unsigned long long me = __ballot(eq);
    int epre = eqseen + (int)mbcnt64(me);
    bool keep = cut ? ge : (gt || (eq && epre < need));
    unsigned long long m = __ballot(keep);
    int pre = base + (int)mbcnt64(m);
    if (keep) bi[pre] = ix[q];
    base += __popcll(m);
    eqseen += __popcll(me);
  }
  return base;
}

#define MFMA8(a, b, c) __builtin_amdgcn_mfma_f32_16x16x32_fp8_fp8((a), (b), (c), 0, 0, 0)
typedef __attribute__((ext_vector_type(4))) float f32x4v;
typedef __attribute__((ext_vector_type(2))) float f32x2v;
DI int pidx(int h, int key) { return h * 256 + (key ^ ((h & 1) << 5)); }
DI long mk64(unsigned lo, unsigned hi) { return (long)(((unsigned long long)hi << 32) | lo); }

DI void sparse_attn_query(const Params& p, size_t rowb, size_t row, const unsigned* sel, int nsel, float* pbuf, int lane) {
  const int m16 = lane & 15, kg = lane >> 4;
  long afr[16];
  {
    unsigned alo0, alo1, ahi0, ahi1;
    {
      const u32x4 qa = *(const u32x4*)(p.QA + row * 512 + (m16 & 7) * 64 + kg * 16);
      const u32x4 qb = *(const u32x4*)(p.QA + row * 512 + (m16 & 7) * 64 + kg * 16 + 8);
      alo0 = cvt4_fp8(bflo(qa[0]), bfhi(qa[0]), bflo(qa[1]), bfhi(qa[1]));
      alo1 = cvt4_fp8(bflo(qa[2]), bfhi(qa[2]), bflo(qa[3]), bfhi(qa[3]));
      ahi0 = cvt4_fp8(bflo(qb[0]), bfhi(qb[0]), bflo(qb[1]), bfhi(qb[1]));
      ahi1 = cvt4_fp8(bflo(qb[2]), bfhi(qb[2]), bflo(qb[3]), bfhi(qb[3]));
    }
#pragma unroll
    for (int s = 0; s < 16; ++s) {
      const bool on = (m16 == (s >> 1));
      afr[s] = mk64(on ? ((s & 1) ? ahi0 : alo0) : 0u, on ? ((s & 1) ? ahi1 : alo1) : 0u);
    }
  }
  const int ntile = (nsel + 15) >> 4;
  u32x4 bc[8], bn[8], bnn[8];
  {
    const int j = m16 < nsel ? m16 : nsel - 1;
    const unsigned char* kb = p.K8 + (rowb + sel[j]) * 512 + kg * 16;
#pragma unroll
    for (int h = 0; h < 8; ++h) { bc[h] = *(const u32x4*)(kb + h * 64); bn[h] = bc[h]; bnn[h] = bc[h]; }
    {
      const int kn = 16 + m16;
      const int j1 = kn < nsel ? kn : nsel - 1;
      const unsigned char* kb1 = p.K8 + (rowb + sel[j1]) * 512 + kg * 16;
#pragma unroll
      for (int h = 0; h < 8; ++h) bn[h] = *(const u32x4*)(kb1 + h * 64);
    }
  }
#pragma unroll 1
  for (int T = 0; T < ntile; ++T) {
    {
      const int kn = (T + 2) * 16 + m16;
      const int j = kn < nsel ? kn : nsel - 1;
      const unsigned char* kb = p.K8 + (rowb + sel[j]) * 512 + kg * 16;
#pragma unroll
      for (int h = 0; h < 8; ++h) bnn[h] = *(const u32x4*)(kb + h * 64);
    }
    f32x4v acc0 = {0.f, 0.f, 0.f, 0.f}, acc1 = {0.f, 0.f, 0.f, 0.f};
#pragma unroll
    for (int h = 0; h < 8; ++h) {
      acc0 = MFMA8(afr[2 * h], mk64(bc[h][0], bc[h][1]), acc0);
      acc1 = MFMA8(afr[2 * h + 1], mk64(bc[h][2], bc[h][3]), acc1);
    }
    const int key = T * 16 + m16;
    if (kg < 2) {
      const bool ok = key < nsel;
#pragma unroll
      for (int i = 0; i < 4; ++i) pbuf[pidx(4 * kg + i, key)] = ok ? (acc0[i] + acc1[i]) * 0.125f : -1e30f;
    }
#pragma unroll
    for (int h = 0; h < 8; ++h) { bc[h] = bn[h]; bn[h] = bnn[h]; }
  }
  for (int T = ntile; T < 16; ++T) {
    if (kg < 2) {
#pragma unroll
      for (int i = 0; i < 4; ++i) pbuf[pidx(4 * kg + i, T * 16 + m16)] = -1e30f;
    }
  }
  const int hl = lane >> 3, l8 = lane & 7;
  float inv;
  {
    float4 lg[8];
    float mx = -1e30f;
#pragma unroll
    for (int j = 0; j < 8; ++j) {
      lg[j] = *(const float4*)(pbuf + pidx(hl, 32 * j + 4 * l8));
      mx = fmaxf(mx, fmaxf(fmaxf(lg[j].x, lg[j].y), fmaxf(lg[j].z, lg[j].w)));
    }
    mx = fmaxf(mx, dppmov<0xB1>(mx));
    mx = fmaxf(mx, dppmov<0x4E>(mx));
    mx = fmaxf(mx, dppmov<0x141>(mx));
    float sum = 0.f;
#pragma unroll
    for (int j = 0; j < 8; ++j) {
      lg[j].x = __expf(lg[j].x - mx); lg[j].y = __expf(lg[j].y - mx); lg[j].z = __expf(lg[j].z - mx); lg[j].w = __expf(lg[j].w - mx);
      sum += (lg[j].x + lg[j].y) + (lg[j].z + lg[j].w);
      *(float4*)(pbuf + pidx(hl, 32 * j + 4 * l8)) = lg[j];
    }
    sum = red8(sum);
    inv = 1.f / sum;
  }
  const int kpar = lane >> 5, l5 = lane & 31, h16 = l5 >> 2;
  f32x2v o2[8];
#pragma unroll
  for (int e = 0; e < 8; ++e) o2[e] = (f32x2v){0.f, 0.f};
  const int nstep = (nsel + 15) >> 4;
  const unsigned char* vbase = p.V8 + rowb * 512 + l5 * 16;
  u32x4 vc[8], vn[8], vnn[8];
#define LOADV16(dst, J0)                                                            \
  {                                                                                 \
    _Pragma("unroll") for (int g = 0; g < 4; ++g) {                                 \
      const uint4 i4 = *(const uint4*)(sel + (J0) + 4 * g);                         \
      const unsigned ia = kpar ? i4.y : i4.x, ib = kpar ? i4.w : i4.z;              \
      const unsigned ida = ((J0) + 4 * g + kpar < nsel) ? ia : sel[0];              \
      const unsigned idb = ((J0) + 4 * g + 2 + kpar < nsel) ? ib : sel[0];          \
      dst[2 * g] = *(const u32x4*)(vbase + (size_t)ida * 512);                      \
      dst[2 * g + 1] = *(const u32x4*)(vbase + (size_t)idb * 512);                  \
    }                                                                               \
  }
  LOADV16(vc, 0);
#pragma unroll
  for (int e = 0; e < 8; ++e) { vn[e] = vc[e]; vnn[e] = vc[e]; }
  LOADV16(vn, 16);
#pragma unroll 1
  for (int st = 0; st < nstep; ++st) {
    { const int j0 = (st + 2) * 16; LOADV16(vnn, j0); }
#pragma unroll
    for (int e = 0; e < 8; ++e) {
      const float pj = pbuf[pidx(h16, st * 16 + 2 * e + kpar)];
      const f32x2v pp = {pj, pj};
      const u32x4 v = vc[e];
#pragma unroll
      for (int k = 0; k < 4; ++k) {
        o2[2 * k] = __builtin_elementwise_fma(__builtin_amdgcn_cvt_pk_f32_fp8((int)v[k], false), pp, o2[2 * k]);
        o2[2 * k + 1] = __builtin_elementwise_fma(__builtin_amdgcn_cvt_pk_f32_fp8((int)v[k], true), pp, o2[2 * k + 1]);
      }
    }
#pragma unroll
    for (int e = 0; e < 8; ++e) { vc[e] = vn[e]; vn[e] = vnn[e]; }
  }
#undef LOADV16
  float o[16];
#pragma unroll
  for (int e = 0; e < 8; ++e) { o[2 * e] = o2[e].x; o[2 * e + 1] = o2[e].y; }
#pragma unroll
  for (int e = 0; e < 16; ++e) o[e] += __shfl_xor(o[e], 32);
  const float invh = __shfl(inv, h16 * 8);
  if (kpar == 0) {
    const u32x4 ga0 = *(const u32x4*)(p.GA + row * 512 + l5 * 16);
    const u32x4 ga1 = *(const u32x4*)(p.GA + row * 512 + l5 * 16 + 8);
    u32x4 ov0, ov1;
#pragma unroll
    for (int k = 0; k < 4; ++k) {
      ov0[k] = pack2(o[2 * k] * invh * bflo(ga0[k]), o[2 * k + 1] * invh * bfhi(ga0[k]));
      ov1[k] = pack2(o[8 + 2 * k] * invh * bflo(ga1[k]), o[8 + 2 * k + 1] * invh * bfhi(ga1[k]));
    }
    *(u32x4*)(p.MIX + row * 1024 + l5 * 16) = ov0;
    *(u32x4*)(p.MIX + row * 1024 + l5 * 16 + 8) = ov1;
  }
}

DI void attn_task(const Params& p, int task, char* smem, int qsel = 0) {
  int t_ = threadIdx.x;
  asm volatile("" : "+v"(t_));
  const int t = t_, lane = t & 63, w = t >> 6, r = lane & 31, hh = lane >> 5;
  const int b = task & 1, s16 = 511 - (task >> 1);
  const int tq0 = s16 * 16 + 4 * w;
  const size_t rowb = (size_t)b * SEQL;
  unsigned* bkey = (unsigned*)smem + w * 4096;
  unsigned* bidx = bkey + 2048;
  const int ql = 2 * ((r >> 2) & 1) + (r >> 4), hd = (r & 3) + 4 * ((r >> 3) & 1);
  bf16x8 aq[4];
#pragma unroll
  for (int s = 0; s < 4; ++s) aq[s] = *(const bf16x8*)(p.IQ + (rowb + tq0 + ql) * 512 + hd * 64 + s * 16 + hh * 8);
  float w0[8], w1[8];
#pragma unroll
  for (int i = 0; i < 8; ++i) {
    w0[i] = p.IW[(rowb + tq0 + 2 * hh) * 8 + i];
    w1[i] = p.IW[(rowb + tq0 + 2 * hh + 1) * 8 + i];
  }
  const int tqa = tq0 + 2 * hh, tqb = tqa + 1;
  float tha = -__builtin_inff(), thb = -__builtin_inff();
  int cnt0 = 0, cnt1 = 0, cnt2 = 0, cnt3 = 0;
  const int ntile = ((s16 * 16 + 15) >> 5) + 1;
  const int offa = hh ? 1024 : 0, offb = hh ? 1536 : 512;
  auto tile_body = [&](const bf16x8 (&bt)[4], int kt) -> bool {
    f32x16 acc = zero16();
#pragma unroll
    for (int s = 0; s < 4; ++s) acc = MFMA32(aq[s], bt[s], acc);
    float sa = 0.f, sb = 0.f;
#pragma unroll
    for (int i = 0; i < 8; ++i) {
      sa = fmaf(w0[i], relu_i(acc[i]), sa);
      sb = fmaf(w1[i], relu_i(acc[8 + i]), sb);
    }
    const int key = kt * 32 + r;
    const bool pa = (key <= tqa) & (sa >= tha);
    const bool pb = (key <= tqb) & (sb >= thb);
    {
      const unsigned long long m = __builtin_amdgcn_ballot_w64(pa);
      const int nlo = __popc((unsigned)m), nhi = __popc((unsigned)(m >> 32));
      const int pos = (int)mbcnt64(m) + (hh ? cnt2 - nlo : cnt0);
      if (pa && pos < 512) { bkey[offa + pos] = __float_as_uint(sa); bidx[offa + pos] = (unsigned)key; }
      cnt0 += nlo; cnt2 += nhi;
    }
    {
      const unsigned long long m = __builtin_amdgcn_ballot_w64(pb);
      const int nlo = __popc((unsigned)m), nhi = __popc((unsigned)(m >> 32));
      const int pos = (int)mbcnt64(m) + (hh ? cnt3 - nlo : cnt1);
      if (pb && pos < 512) { bkey[offb + pos] = __float_as_uint(sb); bidx[offb + pos] = (unsigned)key; }
      cnt1 += nlo; cnt3 += nhi;
    }
    return (cnt0 > 448) | (cnt1 > 448) | (cnt2 > 448) | (cnt3 > 448);
  };
  {
    ush* tile = (ush*)(smem + 65536);
    __shared__ int s_need[2];
    const int lkey = t >> 3, lch = t & 7;
    const ush* gsrc = p.IK + (rowb + lkey) * 64 + lch * 8;
    const int npair = (ntile + 1) >> 1;
    const int lp = npair - 1;
    u32x4 g0 = *(const u32x4*)(gsrc), g1 = *(const u32x4*)(gsrc + 2048);
    if (t < 2) s_need[t] = 0;
    for (int kp = 0; kp < npair; ++kp) {
      __syncthreads();
      const int need = kp > 0 ? s_need[(kp - 1) & 1] : 0;
      *(u32x4*)(tile + lkey * 72 + lch * 8) = g0;
      *(u32x4*)(tile + (lkey + 32) * 72 + lch * 8) = g1;
      __syncthreads();
      if (t == 0 && kp > 0) s_need[(kp - 1) & 1] = 0;
      {
        const int pn = kp + 1 < lp ? kp + 1 : lp;
        g0 = *(const u32x4*)(gsrc + (size_t)pn * 4096);
        g1 = *(const u32x4*)(gsrc + (size_t)pn * 4096 + 2048);
      }
      if (need) {
        if (cnt0 > 320) { float th; compact16(bkey, bidx, cnt0, th, lane); if (hh == 0) tha = th; }
        if (cnt1 > 320) { float th; compact16(bkey + 512, bidx + 512, cnt1, th, lane); if (hh == 0) thb = th; }
        if (cnt2 > 320) { float th; compact16(bkey + 1024, bidx + 1024, cnt2, th, lane); if (hh == 1) tha = th; }
        if (cnt3 > 320) { float th; compact16(bkey + 1536, bidx + 1536, cnt3, th, lane); if (hh == 1) thb = th; }
      }
      bf16x8 bt[4];
#pragma unroll
      for (int s = 0; s < 4; ++s) bt[s] = *(const bf16x8*)(tile + r * 72 + s * 16 + hh * 8);
      bool nd = tile_body(bt, 2 * kp);
      if (2 * kp + 1 < ntile) {
#pragma unroll
        for (int s = 0; s < 4; ++s) bt[s] = *(const bf16x8*)(tile + (32 + r) * 72 + s * 16 + hh * 8);
        nd |= tile_body(bt, 2 * kp + 1);
      }
      if (nd && lane == 0) s_need[kp & 1] = 1;
    }
    __syncthreads();
  }
  const bool lo = qsel != 2, hi = qsel != 1;
  int nsel_q[4] = {0, 0, 0, 0};
  {
    int c0 = cnt0 > 512 ? 512 : cnt0, c1 = cnt1 > 512 ? 512 : cnt1, c2 = cnt2 > 512 ? 512 : cnt2, c3 = cnt3 > 512 ? 512 : cnt3;
    if (lo) {
      nsel_q[0] = final_select(bkey, bidx, c0, lane);
      nsel_q[1] = final_select(bkey + 512, bidx + 512, c1, lane);
    }
    if (hi) {
      nsel_q[2] = final_select(bkey + 1024, bidx + 1024, c2, lane);
      nsel_q[3] = final_select(bkey + 1536, bidx + 1536, c3, lane);
    }
  }
  float* pbuf = (float*)bkey;
#pragma unroll
  for (int q = 0; q < 4; ++q) {
    if (q < 2 ? lo : hi) sparse_attn_query(p, rowb, rowb + tq0 + q, bidx + q * 512, nsel_q[q], pbuf, lane);
  }
}

DI void dn_norm(const Params& p, int wave, int nw, int lane) {
  const float4* nwp = (const float4*)(p.dnw + (lane & 15) * 8);
  const float4 n0 = nwp[0], n1 = nwp[1];
  for (int row0 = wave; row0 < NTOK; row0 += 4 * nw) {
    float4 a[4], c[4];
    u32x4 z[4];
#pragma unroll
    for (int j = 0; j < 4; ++j) {
      const int row = row0 + j * nw;
      const float4* op = (const float4*)(p.OD + (size_t)row * 512 + lane * 8);
      a[j] = op[0]; c[j] = op[1];
      z[j] = *(const u32x4*)(p.SZ + (size_t)row * 512 + lane * 8);
    }
#pragma unroll
    for (int j = 0; j < 4; ++j) {
      const int row = row0 + j * nw;
      float ss = a[j].x * a[j].x + a[j].y * a[j].y + a[j].z * a[j].z + a[j].w * a[j].w + c[j].x * c[j].x + c[j].y * c[j].y + c[j].z * c[j].z + c[j].w * c[j].w;
      ss += __shfl_xor(ss, 1); ss += __shfl_xor(ss, 2); ss += __shfl_xor(ss, 4); ss += __shfl_xor(ss, 8);
      const float rs = rsqrtf(ss * (1.f / 128.f) + 1e-6f);
      u32x4 o;
      o[0] = pack2(a[j].x * rs * n0.x * bflo(z[j][0]), a[j].y * rs * n0.y * bfhi(z[j][0]));
      o[1] = pack2(a[j].z * rs * n0.z * bflo(z[j][1]), a[j].w * rs * n0.w * bfhi(z[j][1]));
      o[2] = pack2(c[j].x * rs * n1.x * bflo(z[j][2]), c[j].y * rs * n1.y * bfhi(z[j][2]));
      o[3] = pack2(c[j].z * rs * n1.z * bflo(z[j][3]), c[j].w * rs * n1.w * bfhi(z[j][3]));
      *(u32x4*)(p.MIX + (size_t)row * 1024 + 512 + lane * 8) = o;
    }
  }
}

DI void dn_norm_rows(const Params& p, int row_base, int lane) {
  const float4* nwp = (const float4*)(p.dnw + (lane & 15) * 8);
  const float4 n0 = nwp[0], n1 = nwp[1];
#pragma unroll 1
  for (int r4 = 0; r4 < 16; r4 += 4) {
    float4 a[4], c[4];
    u32x4 z[4];
#pragma unroll
    for (int j = 0; j < 4; ++j) {
      const int row = row_base + r4 + j;
      const float4* op = (const float4*)(p.OD + (size_t)row * 512 + lane * 8);
      a[j] = op[0]; c[j] = op[1];
      z[j] = *(const u32x4*)(p.SZ + (size_t)row * 512 + lane * 8);
    }
#pragma unroll
    for (int j = 0; j < 4; ++j) {
      const int row = row_base + r4 + j;
      float ss = a[j].x * a[j].x + a[j].y * a[j].y + a[j].z * a[j].z + a[j].w * a[j].w + c[j].x * c[j].x + c[j].y * c[j].y + c[j].z * c[j].z + c[j].w * c[j].w;
      ss += __shfl_xor(ss, 1); ss += __shfl_xor(ss, 2); ss += __shfl_xor(ss, 4); ss += __shfl_xor(ss, 8);
      const float rs = rsqrtf(ss * (1.f / 128.f) + 1e-6f);
      u32x4 o;
      o[0] = pack2(a[j].x * rs * n0.x * bflo(z[j][0]), a[j].y * rs * n0.y * bfhi(z[j][0]));
      o[1] = pack2(a[j].z * rs * n0.z * bflo(z[j][1]), a[j].w * rs * n0.w * bfhi(z[j][1]));
      o[2] = pack2(c[j].x * rs * n1.x * bflo(z[j][2]), c[j].y * rs * n1.y * bfhi(z[j][2]));
      o[3] = pack2(c[j].z * rs * n1.z * bflo(z[j][3]), c[j].w * rs * n1.w * bfhi(z[j][3]));
      *(u32x4*)(p.MIX + (size_t)row * 1024 + 512 + lane * 8) = o;
    }
  }
}

DI void outproj_tile(const Params& p, int tile, char* smem) {
  const int mt = tile >> 3, nt = tile & 7;
  const int m0 = mt * 128, n0 = nt * 128;
  f32x16 acc[2][2];
  gemm_tile(p.MIX, p.Wo, m0, n0, 1024, smem, acc);
  (void)stage_rows(acc, smem);
  int t_ = threadIdx.x;
  asm volatile("" : "+v"(t_));
  const int t = t_, c4 = t & 31, r0 = t >> 5;
  const float* Cs = (const float*)smem;
#pragma unroll 4
  for (int ps = 0; ps < 16; ++ps) {
    const int rr = ps * 8 + r0;
    const float4 f = *(const float4*)(Cs + rr * 132 + c4 * 4);
    const size_t off = (size_t)(m0 + rr) * 1024 + n0 + c4 * 4;
    const float4 xv = *(const float4*)(p.x + off);
    *(float4*)(p.out + off) = make_float4(xv.x + f.x, xv.y + f.y, xv.z + f.z, xv.w + f.w);
  }
}

#define XB_TMO      128
#define XB_XCNT(j)  (256  + 64 * (j))
#define XB_XSUB(j)  (1280 + 64 * (j))
#define XB_XGEN(j)  (2304 + 64 * (j))
#define XB_TOP      3328
#define XB_TOPGEN   3392
#define XCD_BAR_WORDS 3456
#define XB_SPIN_CAP (1u << 20)
#define LAS __attribute__((address_space(3)))
DI unsigned xb_ld(unsigned* p) { return __hip_atomic_load(p, __ATOMIC_RELAXED, __HIP_MEMORY_SCOPE_AGENT); }
DI unsigned xb_add(unsigned* p, unsigned v) { return __hip_atomic_fetch_add(p, v, __ATOMIC_RELAXED, __HIP_MEMORY_SCOPE_AGENT); }
DI unsigned xb_xcc_id() { return (unsigned)__builtin_amdgcn_s_getreg((3 << 11) | 20) & 0xFu; }
#define XB_SPIN(cond, bar) do { unsigned _sp = 0; while (cond) { __builtin_amdgcn_s_sleep(1); \
    if ((++_sp & 255u) == 0u) { if (xb_ld(&(bar)[XB_TMO])) break; if (_sp > XB_SPIN_CAP) { atomicAdd(&(bar)[XB_TMO], 1u); break; } } } } while (0)
struct XcdBarrier { unsigned* bar; unsigned x; volatile LAS unsigned* st; };
DI XcdBarrier xcd_barrier_post(unsigned* bar, volatile LAS unsigned* st) {
  XcdBarrier b; b.bar = bar; b.x = xb_xcc_id(); b.st = st;
  if (threadIdx.x == 0) (void)xb_add(&bar[XB_XCNT(b.x)], 1u);
  return b;
}
DI void xcd_barrier_complete(unsigned* bar, unsigned x, unsigned& nloc, unsigned& nx) {
  const unsigned G = gridDim.x * gridDim.y * gridDim.z;
  unsigned sum, cnt, mine, sp = 0u;
  for (;;) {
    sum = 0u; cnt = 0u; mine = 0u;
#pragma unroll
    for (unsigned j = 0; j < 16; ++j) { const unsigned c = xb_ld(&bar[XB_XCNT(j)]); sum += c; cnt += (c > 0u) ? 1u : 0u; mine = (j == x) ? c : mine; }
    if (sum == G) break;
    __builtin_amdgcn_s_sleep(1);
    if ((++sp & 255u) == 0u) { if (xb_ld(&bar[XB_TMO])) break; if (sp > XB_SPIN_CAP) { atomicAdd(&bar[XB_TMO], 1u); break; } }
  }
  nloc = mine > 0u ? mine : 1u; nx = cnt > 0u ? cnt : 1u;
}
DI void xcd_barrier(const XcdBarrier& b) {
  asm volatile("s_waitcnt vmcnt(0)" ::: "memory");
  __syncthreads();
  if (threadIdx.x == 0) {
    unsigned* bar = b.bar;
    __builtin_amdgcn_s_waitcnt(0);
    unsigned nloc = b.st[0], nx = b.st[1];
    if (nloc == 0u) { xcd_barrier_complete(bar, b.x, nloc, nx); b.st[0] = nloc; b.st[1] = nx; }
    const unsigned old = xb_add(&bar[XB_XSUB(b.x)], 1u);
    const unsigned gen = old / nloc;
    if (old + 1u == (gen + 1u) * nloc) {
      __builtin_amdgcn_fence(__ATOMIC_RELEASE, "agent");
      asm volatile("s_waitcnt vmcnt(0)" ::: "memory");
      const unsigned og = xb_add(&bar[XB_TOP], 1u);
      const unsigned tg = og / nx;
      if (og + 1u == (tg + 1u) * nx) xb_add(&bar[XB_TOPGEN], 1u);
      else XB_SPIN(xb_ld(&bar[XB_TOPGEN]) == tg, bar);
      __builtin_amdgcn_fence(__ATOMIC_ACQUIRE, "agent");
      xb_add(&bar[XB_XGEN(b.x)], 1u);
      asm volatile("s_waitcnt vmcnt(0)" ::: "memory");
    } else {
      XB_SPIN(xb_ld(&bar[XB_XGEN(b.x)]) == gen, bar);
      __builtin_amdgcn_fence(__ATOMIC_ACQUIRE, "agent");
      asm volatile("s_waitcnt vmcnt(0)" ::: "memory");
    }
  }
  __syncthreads();
}

__global__ void __launch_bounds__(256, 2) k_prep(Params p) {
  __shared__ __attribute__((aligned(16))) char smem[SMEM_BYTES];
  phase_prep(p, blockIdx.x * 256 + threadIdx.x, gridDim.x * 256, smem);
}
__global__ void __launch_bounds__(256, 2) k_inproj(Params p) {
  __shared__ __attribute__((aligned(16))) char smem[SMEM_BYTES];
  for (int tile = blockIdx.x; tile < 128 * 37; tile += gridDim.x) inproj_tile(p, tile, smem);
}
__global__ void __launch_bounds__(256, 2) k_dnprep(Params p) {
  __shared__ __attribute__((aligned(16))) char smem[SMEM_BYTES];
  for (int task = blockIdx.x; task < 1024; task += gridDim.x) dn_prep_task(p, task, smem);
}
__global__ void __launch_bounds__(256, 2) k_scan(Params p) {
  __shared__ __attribute__((aligned(16))) char smem[SMEM_BYTES];
  dn_scan(p, blockIdx.x, smem);
}
__global__ void __launch_bounds__(256, 2) k_attn(Params p) {
  __shared__ __attribute__((aligned(16))) char smem[SMEM_BYTES];
  for (int task = blockIdx.x; task < 1024; task += gridDim.x) attn_task(p, task, smem);
}
__global__ void __launch_bounds__(256, 2) k_dnnorm(Params p) {
  dn_norm(p, (blockIdx.x * 256 + threadIdx.x) >> 6, (gridDim.x * 256) >> 6, threadIdx.x & 63);
}
__global__ void __launch_bounds__(256, 2) k_outproj(Params p) {
  __shared__ __attribute__((aligned(16))) char smem[SMEM_BYTES];
  for (int tile = blockIdx.x; tile < 1024; tile += gridDim.x) outproj_tile(p, tile, smem);
}

__global__ void __launch_bounds__(256, 2) k_mega(Params p) {
  __shared__ __attribute__((aligned(16))) char smem[SMEM_BYTES];
  __shared__ uint4 xb_words;
  __shared__ int s_task;
  cg::grid_group grid = cg::this_grid();
  if (threadIdx.x == 0) xb_words = make_uint4(0u, 0u, 0u, 0u);
  __syncthreads();
  XcdBarrier xb = xcd_barrier_post(p.counters + 64, (volatile LAS unsigned*)&xb_words);
  const int gtid = blockIdx.x * 256 + threadIdx.x, gsize = gridDim.x * 256;
  phase_prep(p, gtid, gsize, smem);
  if (p.use_cg_sync) grid.sync();
  xcd_barrier(xb);
  for (int tile = blockIdx.x; tile < 128 * 19; tile += gridDim.x) inproj_tile256(p, tile, smem);
  xcd_barrier(xb);
  for (int task = blockIdx.x; task < 1024; task += gridDim.x) dn_prep_task(p, task, smem);
  xcd_barrier(xb);
  if (blockIdx.x < 32) {
    __builtin_amdgcn_s_setprio(3);
    dn_scan(p, blockIdx.x, smem);
    __builtin_amdgcn_s_setprio(0);
    asm volatile("s_waitcnt vmcnt(0)" ::: "memory");
    __syncthreads();
    if (threadIdx.x == 0) {
      __builtin_amdgcn_fence(__ATOMIC_RELEASE, "agent");
      asm volatile("s_waitcnt vmcnt(0)" ::: "memory");
      atomicAdd(&p.counters[32], 1u);
    }
    __syncthreads();
  }
  {
    int pb = (int)((xb.x >> 2) & 1u);
    int tries = 0;
    while (tries < 2) {
      if (threadIdx.x == 0) s_task = (int)atomicAdd(&p.counters[pb], 1u);
      __syncthreads();
      const int tk = s_task;
      __syncthreads();
      if (tk >= 512 + QSPLIT) { pb ^= 1; ++tries; continue; }
      if (tk < 512 - QSPLIT) attn_task(p, tk * 2 + pb, smem, 0);
      else { const int j = tk - (512 - QSPLIT); attn_task(p, ((512 - QSPLIT) + (j >> 1)) * 2 + pb, smem, 1 + (j & 1)); }
    }
  }
  {
    if (threadIdx.x == 0) {
      unsigned sp = 0;
      while (__hip_atomic_load(&p.counters[32], __ATOMIC_RELAXED, __HIP_MEMORY_SCOPE_AGENT) < 32u) {
        __builtin_amdgcn_s_sleep(4);
        if (++sp > (1u << 22)) break;
      }
      __builtin_amdgcn_fence(__ATOMIC_ACQUIRE, "agent");
      asm volatile("s_waitcnt vmcnt(0)" ::: "memory");
    }
    __syncthreads();
    while (true) {
      if (threadIdx.x == 0) s_task = (int)atomicAdd(&p.counters[33], 1u);
      __syncthreads();
      const int ck = s_task;
      __syncthreads();
      if (ck >= 256) break;
      int tn_ = threadIdx.x;
      asm volatile("" : "+v"(tn_));
      dn_norm_rows(p, ck * 64 + (tn_ >> 6) * 16, tn_ & 63);
    }
  }
  xcd_barrier(xb);
  for (int tile = blockIdx.x; tile < 1024; tile += gridDim.x) outproj_tile(p, tile, smem);
}

extern "C" void kernel_launch(void* const* d_in, const int* in_sizes, int n_in, void* d_out, int out_size, void* d_ws,
                              size_t ws_size, hipStream_t stream) {
  Params p{};
  p.x = (const float*)d_in[0]; p.ln_w = (const float*)d_in[1]; p.w_in = (const float*)d_in[2];
  p.aqw = (const float*)d_in[3]; p.akw = (const float*)d_in[4]; p.ikw = (const float*)d_in[5];
  p.ikb = (const float*)d_in[6]; p.convw = (const float*)d_in[7]; p.alog = (const float*)d_in[8];
  p.dtb = (const float*)d_in[9]; p.dnw = (const float*)d_in[10]; p.w_out = (const float*)d_in[11];
  p.out = (float*)d_out;
  char* ws = (char*)d_ws;
  const size_t MB = 1u << 20;
  p.Wt = (ush*)(ws + 0);
  p.Wo = (ush*)(ws + 10 * MB);
  p.XB = (ush*)(ws + 12 * MB);
  p.MIX = (ush*)(ws + 12 * MB);
  p.QA = (ush*)(ws + 45 * MB); p.KA = (ush*)(ws + 61 * MB); p.VA = (ush*)(ws + 77 * MB);
  p.GA = (ush*)(ws + 93 * MB); p.IQ = (ush*)(ws + 109 * MB); p.DQ = (ush*)(ws + 125 * MB);
  p.DK = (ush*)(ws + 141 * MB); p.DV = (ush*)(ws + 157 * MB); p.SZ = (ush*)(ws + 173 * MB);
  p.IK = (ush*)(ws + 189 * MB);
  p.IW = (float*)(ws + 191 * MB);
  p.BETA = (float*)(ws + 191 * MB + 512 * 1024);
  p.G = (float*)(ws + 191 * MB + 768 * 1024);
  p.INTRA = (ush*)(ws + 192 * MB);
  p.GL = (float*)(ws + 200 * MB);
  p.OD = (float*)(ws + 201 * MB);
  p.counters = (unsigned*)(ws + 233 * MB);
  p.K8 = (unsigned char*)(ws + 61 * MB);
  p.V8 = (unsigned char*)(ws + 77 * MB);
  char* o8 = (char*)d_out;
  p.UT = (ush*)(o8); p.WG = (ush*)(o8 + 16 * MB); p.QG = (ush*)(o8 + 32 * MB); p.KDT = (ush*)(o8 + 48 * MB);

#if MEGA
  static int grid_blocks = 0;
  if (!grid_blocks) {
    int dev = 0, cus = 0, per_cu = 0;
    hipGetDevice(&dev);
    hipDeviceGetAttribute(&cus, hipDeviceAttributeMultiprocessorCount, dev);
    hipOccupancyMaxActiveBlocksPerMultiprocessor(&per_cu, k_mega, 256, 0);
    if (per_cu > 2) per_cu = 2;
    grid_blocks = cus * per_cu;
  }
  hipMemsetAsync(p.counters, 0, (64 + XCD_BAR_WORDS) * sizeof(unsigned), stream);
  void* args[] = {&p};
  hipError_t e = hipLaunchCooperativeKernel((void*)k_mega, dim3(grid_blocks), dim3(256), args, 0, stream);
  if (e != hipSuccess) fprintf(stderr, "cooperative launch failed: %s (grid %d)\n", hipGetErrorString(e), grid_blocks);
#else
  k_prep<<<1024, 256, 0, stream>>>(p);
  k_inproj<<<128 * 37, 256, 0, stream>>>(p);
  k_dnprep<<<1024, 256, 0, stream>>>(p);
  k_scan<<<32, 256, 0, stream>>>(p);
  k_attn<<<1024, 256, 0, stream>>>(p);
  k_dnnorm<<<1024, 256, 0, stream>>>(p);
  k_outproj<<<1024, 256, 0, stream>>>(p);
#endif
}
```

```cpp
#include <hip/hip_runtime.h>
#include <hip/hip_cooperative_groups.h>
#include <cstdio>
#include <cstdint>
namespace cg = cooperative_groups;

#ifndef MEGA
#define MEGA 1
#endif

#define DI __device__ __forceinline__
typedef __attribute__((ext_vector_type(8))) short bf16x8;
typedef __attribute__((ext_vector_type(16))) float f32x16;
typedef __attribute__((ext_vector_type(4))) unsigned u32x4;
typedef __attribute__((ext_vector_type(2))) unsigned u32x2;
typedef __attribute__((ext_vector_type(2))) __bf16 bf2_t;
typedef unsigned short ush;
#define MFMA32(a, b, c) __builtin_amdgcn_mfma_f32_32x32x16_bf16((a), (b), (c), 0, 0, 0)

constexpr int NTOK = 16384;
constexpr int SEQL = 8192;
constexpr int NP = 4736;
constexpr int DIN = 4688;
constexpr int SMEM_BYTES = 74752;
constexpr int QSPLIT = 128;

struct Params {
  const float *x, *ln_w, *w_in, *aqw, *akw, *ikw, *ikb, *convw, *alog, *dtb, *dnw, *w_out;
  float* out;
  ush *Wt, *Wo, *XB, *MIX, *QA, *KA, *VA, *GA, *IQ, *DQ, *DK, *DV, *SZ, *IK, *INTRA;
  ush *UT, *WG, *QG, *KDT;
  float *IW, *BETA, *G, *GL, *OD;
  unsigned* counters;
  unsigned char *K8, *V8;
  int use_cg_sync, pad0;
};

DI ush f2bf(float x) { return __builtin_bit_cast(ush, (__bf16)x); }
DI float bf2f(ush b) { return __uint_as_float(((unsigned)b) << 16); }
DI unsigned pack2(float a, float b) { bf2_t v = {(__bf16)a, (__bf16)b}; return __builtin_bit_cast(unsigned, v); }
DI float bflo(unsigned u) { return __uint_as_float(u << 16); }
DI float bfhi(unsigned u) { return __uint_as_float(u & 0xffff0000u); }
DI int crow(int reg, int h) { return (reg & 3) + 8 * (reg >> 2) + 4 * h; }
DI float silu_f(float v) { return v / (1.f + __expf(-v)); }
DI f32x16 zero16() { f32x16 z; for (int i = 0; i < 16; ++i) z[i] = 0.f; return z; }

template <int CTRL> DI float dppmov(float x) {
  return __int_as_float(__builtin_amdgcn_update_dpp(0, __float_as_int(x), CTRL, 0xF, 0xF, true));
}
DI float red8(float d) {
  d += dppmov<0xB1>(d);
  d += dppmov<0x4E>(d);
  d += dppmov<0x141>(d);
  return d;
}
DI unsigned mbcnt64(unsigned long long m) {
  return __builtin_amdgcn_mbcnt_hi((unsigned)(m >> 32), __builtin_amdgcn_mbcnt_lo((unsigned)m, 0u));
}
DI int mapcol(int n) {
  if (n < 2560) return n;
  if (n < 4608) return n + 72;
  if (n < 4680) return n - 2048;
  if (n < 4688) return n;
  return -1;
}

DI void phase_prep(const Params& p, int gtid, int gsize, char* smem) {
  {
    unsigned* Ts = (unsigned*)smem;
    ush* Th = (ush*)smem;
    int t_ = threadIdx.x;
    asm volatile("" : "+v"(t_));
    const int t = t_;
    for (int tt = blockIdx.x; tt < 1472; tt += gridDim.x) {
      const bool is_in = tt < 1216;
      const int id = is_in ? tt : tt - 1216;
      const int nt = is_in ? id % 76 : (id & 15), kt = is_in ? id / 76 : (id >> 4);
      const float* src = is_in ? p.w_in : p.w_out;
      const int ld = is_in ? DIN : 1024;
      ush* dst = is_in ? p.Wt : p.Wo;
      {
        const int n = t & 63, ks = t >> 6;
        const int oc = is_in ? mapcol(nt * 64 + n) : nt * 64 + n;
#pragma unroll
        for (int it = 0; it < 16; ++it) {
          int k = it * 4 + ks;
          float v = oc >= 0 ? src[(size_t)(kt * 64 + k) * ld + oc] : 0.f;
          Th[n * 66 + k] = f2bf(v);
        }
      }
      __syncthreads();
      {
        const int n = t >> 2, kq = t & 3;
        u32x4 a, b;
#pragma unroll
        for (int i = 0; i < 4; ++i) { a[i] = Ts[n * 33 + kq * 8 + i]; b[i] = Ts[n * 33 + kq * 8 + 4 + i]; }
        u32x4* dp = (u32x4*)(dst + (size_t)(nt * 64 + n) * 1024 + kt * 64 + kq * 16);
        dp[0] = a; dp[1] = b;
      }
      __syncthreads();
    }
  }
  int wave = gtid >> 6, lane = gtid & 63, nw = gsize >> 6;
  for (int row = wave; row < NTOK; row += nw) {
    const float4* xr = (const float4*)(p.x + (size_t)row * 1024);
    float4 a[4];
    float ss = 0.f;
#pragma unroll
    for (int i = 0; i < 4; ++i) {
      a[i] = xr[lane + 64 * i];
      ss += a[i].x * a[i].x + a[i].y * a[i].y + a[i].z * a[i].z + a[i].w * a[i].w;
    }
#pragma unroll
    for (int o = 1; o < 64; o <<= 1) ss += __shfl_xor(ss, o);
    float rs = rsqrtf(ss * (1.f / 1024.f) + 1e-6f);
#pragma unroll
    for (int i = 0; i < 4; ++i) {
      float4 lw = ((const float4*)p.ln_w)[lane + 64 * i];
      u32x2 o;
      o[0] = pack2(a[i].x * rs * lw.x, a[i].y * rs * lw.y);
      o[1] = pack2(a[i].z * rs * lw.z, a[i].w * rs * lw.w);
      *(u32x2*)(p.XB + (size_t)row * 1024 + (lane + 64 * i) * 4) = o;
    }
  }
}

DI void gemm_tile(const ush* __restrict__ A, const ush* __restrict__ B, int m0, int n0, int K, char* smem,
                  f32x16 (&acc)[2][2]) {
  ush* As = (ush*)smem;
  ush* Bs = As + 128 * 72;
  int t_ = threadIdx.x;
  asm volatile("" : "+v"(t_));
  const int t = t_, lane = t & 63, w = t >> 6, wm = w >> 1, wn = w & 1, r = lane & 31, h = lane >> 5;
  u32x4 ra[4], rb[4];
#pragma unroll
  for (int i = 0; i < 2; ++i)
#pragma unroll
    for (int j = 0; j < 2; ++j) acc[i][j] = zero16();
#pragma unroll
  for (int i = 0; i < 4; ++i) {
    int c = t + 256 * i, row = c >> 3, kc = c & 7;
    ra[i] = *(const u32x4*)(A + (size_t)(m0 + row) * K + kc * 8);
    rb[i] = *(const u32x4*)(B + (size_t)(n0 + row) * K + kc * 8);
  }
  for (int k0 = 0; k0 < K; k0 += 64) {
    __syncthreads();
#pragma unroll
    for (int i = 0; i < 4; ++i) {
      int c = t + 256 * i, row = c >> 3, kc = c & 7;
      *(u32x4*)(As + row * 72 + kc * 8) = ra[i];
      *(u32x4*)(Bs + row * 72 + kc * 8) = rb[i];
    }
    __syncthreads();
    if (k0 + 64 < K) {
#pragma unroll
      for (int i = 0; i < 4; ++i) {
        int c = t + 256 * i, row = c >> 3, kc = c & 7;
        ra[i] = *(const u32x4*)(A + (size_t)(m0 + row) * K + k0 + 64 + kc * 8);
        rb[i] = *(const u32x4*)(B + (size_t)(n0 + row) * K + k0 + 64 + kc * 8);
      }
    }
#pragma unroll
    for (int s = 0; s < 4; ++s) {
      bf16x8 af[2], bfr[2];
#pragma unroll
      for (int i = 0; i < 2; ++i) af[i] = *(const bf16x8*)(As + (wm * 64 + i * 32 + r) * 72 + s * 16 + h * 8);
#pragma unroll
      for (int j = 0; j < 2; ++j) bfr[j] = *(const bf16x8*)(Bs + (wn * 64 + j * 32 + r) * 72 + s * 16 + h * 8);
#pragma unroll
      for (int i = 0; i < 2; ++i)
#pragma unroll
        for (int j = 0; j < 2; ++j) acc[i][j] = MFMA32(af[i], bfr[j], acc[i][j]);
    }
  }
  __syncthreads();
}

DI const float* stage_rows(f32x16 (&acc)[2][2], char* smem) {
  float* Cs = (float*)smem;
  int t_ = threadIdx.x;
  asm volatile("" : "+v"(t_));
  const int t = t_, lane = t & 63, w = t >> 6, wm = w >> 1, wn = w & 1, r = lane & 31, h = lane >> 5;
#pragma unroll
  for (int i = 0; i < 2; ++i)
#pragma unroll
    for (int j = 0; j < 2; ++j)
#pragma unroll
      for (int reg = 0; reg < 16; ++reg)
        Cs[(wm * 64 + i * 32 + crow(reg, h)) * 132 + wn * 64 + j * 32 + r] = acc[i][j][reg];
  __syncthreads();
  return Cs + (t & 127) * 132 + (t >> 7) * 64;
}
DI u32x4 pack8(float4 a, float4 b) {
  u32x4 o;
  o[0] = pack2(a.x, a.y); o[1] = pack2(a.z, a.w); o[2] = pack2(b.x, b.y); o[3] = pack2(b.z, b.w);
  return o;
}
DI float4 mul4(float4 a, float4 b) { return make_float4(a.x * b.x, a.y * b.y, a.z * b.z, a.w * b.w); }
DI float4 scl4(float4 a, float s) { return make_float4(a.x * s, a.y * s, a.z * s, a.w * s); }
DI unsigned cvt4_fp8(float a, float b, float c, float d) {
  int r = 0;
  r = __builtin_amdgcn_cvt_pk_fp8_f32(a, b, r, false);
  r = __builtin_amdgcn_cvt_pk_fp8_f32(c, d, r, true);
  return (unsigned)r;
}
DI float4 silu4(float4 a) { return make_float4(silu_f(a.x), silu_f(a.y), silu_f(a.z), silu_f(a.w)); }

DI void inproj_epilogue(const Params& p, int row, int nt, int half, const float4* cv) {
  if (nt < 36) {
    const int grp = nt >> 2;
    const int col = (nt & 3) * 128 + half * 64;
    ush* dst = (ush*)((char*)p.QA + (size_t)grp * (16u << 20));
    u32x4* dp = (u32x4*)(dst + (size_t)row * 512 + col);
    if (grp == 0) {
      float ss = 0.f;
#pragma unroll
      for (int q = 0; q < 16; ++q) { float4 f = cv[q]; ss += f.x * f.x + f.y * f.y + f.z * f.z + f.w * f.w; }
      const float rs = rsqrtf(ss * (1.f / 64.f) + 1e-6f);
      const float4* nw = (const float4*)p.aqw;
#pragma unroll
      for (int q = 0; q < 8; ++q)
        dp[q] = pack8(scl4(mul4(cv[2 * q], nw[2 * q]), rs), scl4(mul4(cv[2 * q + 1], nw[2 * q + 1]), rs));
    } else if (grp == 1) {
      float ss = 0.f;
#pragma unroll
      for (int q = 0; q < 16; ++q) { float4 f = cv[q]; ss += f.x * f.x + f.y * f.y + f.z * f.z + f.w * f.w; }
      const float rs = rsqrtf(ss * (1.f / 64.f) + 1e-6f);
      const float4* nw = (const float4*)p.akw;
      u32x4* d8 = (u32x4*)(p.K8 + (size_t)row * 512 + col);
#pragma unroll
      for (int q = 0; q < 4; ++q) {
        u32x4 o;
#pragma unroll
        for (int k = 0; k < 4; ++k) { float4 f = scl4(mul4(cv[4 * q + k], nw[4 * q + k]), rs); o[k] = cvt4_fp8(f.x, f.y, f.z, f.w); }
        d8[q] = o;
      }
    } else if (grp == 2) {
      u32x4* d8 = (u32x4*)(p.V8 + (size_t)row * 512 + col);
#pragma unroll
      for (int q = 0; q < 4; ++q) {
        u32x4 o;
#pragma unroll
        for (int k = 0; k < 4; ++k) { float4 f = cv[4 * q + k]; o[k] = cvt4_fp8(f.x, f.y, f.z, f.w); }
        d8[q] = o;
      }
    } else if (grp == 3 || grp == 8) {
#pragma unroll
      for (int q = 0; q < 8; ++q) dp[q] = pack8(silu4(cv[2 * q]), silu4(cv[2 * q + 1]));
    } else {
#pragma unroll
      for (int q = 0; q < 8; ++q) dp[q] = pack8(cv[2 * q], cv[2 * q + 1]);
    }
  } else {
    if (half == 0) {
      float mu = 0.f;
#pragma unroll
      for (int q = 0; q < 16; ++q) { float4 f = cv[q]; mu += f.x + f.y + f.z + f.w; }
      mu *= (1.f / 64.f);
      float var = 0.f;
#pragma unroll
      for (int q = 0; q < 16; ++q) {
        float4 f = cv[q];
        var += (f.x - mu) * (f.x - mu) + (f.y - mu) * (f.y - mu) + (f.z - mu) * (f.z - mu) + (f.w - mu) * (f.w - mu);
      }
      float rs = rsqrtf(var * (1.f / 64.f) + 1e-6f);
      const float4* kw = (const float4*)p.ikw;
      const float4* kb = (const float4*)p.ikb;
      u32x4* dp = (u32x4*)(p.IK + (size_t)row * 64);
#pragma unroll
      for (int q = 0; q < 8; ++q) {
        float4 a = cv[2 * q], c = cv[2 * q + 1], wa = kw[2 * q], wc = kw[2 * q + 1], ba = kb[2 * q], bc = kb[2 * q + 1];
        a = make_float4((a.x - mu) * rs * wa.x + ba.x, (a.y - mu) * rs * wa.y + ba.y, (a.z - mu) * rs * wa.z + ba.z, (a.w - mu) * rs * wa.w + ba.w);
        c = make_float4((c.x - mu) * rs * wc.x + bc.x, (c.y - mu) * rs * wc.y + bc.y, (c.z - mu) * rs * wc.z + bc.z, (c.w - mu) * rs * wc.w + bc.w);
        dp[q] = pack8(a, c);
      }
    } else {
      const float* v = (const float*)cv;
#pragma unroll
      for (int c = 0; c < 8; ++c) p.IW[(size_t)row * 8 + c] = v[c] * 0.044194173824159216f;
#pragma unroll
      for (int c = 0; c < 4; ++c) {
        p.BETA[(size_t)row * 4 + c] = 1.f / (1.f + expf(-v[8 + c]));
        float xx = v[12 + c] + p.dtb[c];
        float sp = xx > 20.f ? xx : log1pf(expf(xx));
        p.G[(size_t)row * 4 + c] = -expf(p.alog[c]) * sp;
      }
    }
  }
}

DI void inproj_tile(const Params& p, int tile, char* smem) {
  const int mt = tile / 37, nt = tile % 37;
  const int m0 = mt * 128, n0 = nt * 128;
  f32x16 acc[2][2];
  gemm_tile(p.XB, p.Wt, m0, n0, 1024, smem, acc);
  const float4* cv = (const float4*)stage_rows(acc, smem);
  const int t = threadIdx.x;
  inproj_epilogue(p, m0 + (t & 127), nt, t >> 7, cv);
}

DI void inproj_tile256(const Params& p, int tile, char* smem) {
  const int mt = tile / 19, n2 = tile % 19;
  const int m0 = mt * 128, n0 = n2 * 256;
  ush* As = (ush*)smem;
  ush* Bs = As + 128 * 72;
  int t_ = threadIdx.x;
  asm volatile("" : "+v"(t_));
  const int t = t_, lane = t & 63, w = t >> 6, wm = w >> 1, wn = w & 1, r = lane & 31, h = lane >> 5;
  f32x16 acc[2][4];
#pragma unroll
  for (int i = 0; i < 2; ++i)
#pragma unroll
    for (int j = 0; j < 4; ++j) acc[i][j] = zero16();
  u32x4 ra[4], rb[8];
  const int lrow = t >> 3, lkc = t & 7;
  const unsigned voff = (unsigned)(lrow * 1024 + lkc * 8) * 2u;
  const char* abase = (const char*)(p.XB + (size_t)m0 * 1024);
  const char* bbase = (const char*)(p.Wt + (size_t)n0 * 1024);
#pragma unroll
  for (int i = 0; i < 4; ++i) ra[i] = *(const u32x4*)(abase + (size_t)i * 65536 + voff);
#pragma unroll
  for (int i = 0; i < 8; ++i) rb[i] = *(const u32x4*)(bbase + (size_t)i * 65536 + voff);
  for (int k0 = 0; k0 < 1024; k0 += 64) {
    __syncthreads();
#pragma unroll
    for (int i = 0; i < 4; ++i) *(u32x4*)(As + (lrow + 32 * i) * 72 + lkc * 8) = ra[i];
#pragma unroll
    for (int i = 0; i < 8; ++i) *(u32x4*)(Bs + (lrow + 32 * i) * 72 + lkc * 8) = rb[i];
    __syncthreads();
    {
      const int kn = k0 + 64 < 1024 ? k0 + 64 : k0;
#pragma unroll
      for (int i = 0; i < 4; ++i) ra[i] = *(const u32x4*)(abase + ((size_t)i * 65536 + (size_t)kn * 2) + voff);
#pragma unroll
      for (int i = 0; i < 8; ++i) rb[i] = *(const u32x4*)(bbase + ((size_t)i * 65536 + (size_t)kn * 2) + voff);
    }
#pragma unroll
    for (int s = 0; s < 4; ++s) {
      bf16x8 af[2], bfr[4];
#pragma unroll
      for (int i = 0; i < 2; ++i) af[i] = *(const bf16x8*)(As + (wm * 64 + i * 32 + r) * 72 + s * 16 + h * 8);
#pragma unroll
      for (int j = 0; j < 4; ++j) bfr[j] = *(const bf16x8*)(Bs + (wn * 128 + j * 32 + r) * 72 + s * 16 + h * 8);
#pragma unroll
      for (int i = 0; i < 2; ++i)
#pragma unroll
        for (int j = 0; j < 4; ++j) acc[i][j] = MFMA32(af[i], bfr[j], acc[i][j]);
    }
  }
  __syncthreads();
  const int nt = __builtin_amdgcn_readfirstlane(2 * n2 + wn);
  if (nt < 37) {
    float* Cw = (float*)smem + w * 4384;
#pragma unroll
    for (int jp = 0; jp < 2; ++jp) {
#pragma unroll
      for (int i = 0; i < 2; ++i)
#pragma unroll
        for (int jj = 0; jj < 2; ++jj)
#pragma unroll
          for (int reg = 0; reg < 16; ++reg)
            Cw[(i * 32 + crow(reg, h)) * 68 + jj * 32 + r] = acc[i][2 * jp + jj][reg];
      inproj_epilogue(p, m0 + wm * 64 + lane, nt, jp, (const float4*)(Cw + lane * 68));
    }
  }
  __syncthreads();
}

DI void dn_prep_task(const Params& p, int task, char* smem) {
  int t_ = threadIdx.x;
  asm volatile("" : "+v"(t_));
  const int t = t_, lane = t & 63, w = t >> 6;
  const int h = task & 3, c = (task >> 2) & 127, b = task >> 9;
  const size_t ch = (size_t)(b * 4 + h) * 128 + c;
  const size_t row0 = (size_t)b * SEQL + c * 64;
  ush* Qs = (ush*)smem;
  ush* Ks = Qs + 64 * 136;
  ush* Vs = Ks + 64 * 136;
  float* As = (float*)(smem + 52224);
  float* gcs = (float*)(smem + 68608);
  float* bts = gcs + 64;
  float* ebg = bts + 64;
  float* ekd = ebg + 64;
  float* egc = ekd + 64;
  if (w == 0) {
    float g = p.G[(row0 + lane) * 4 + h];
#pragma unroll
    for (int o = 1; o < 64; o <<= 1) { float y = __shfl_up(g, o); if (lane >= o) g += y; }
    float bt = p.BETA[(row0 + lane) * 4 + h];
    float gl = __shfl(g, 63);
    gcs[lane] = g; bts[lane] = bt; ebg[lane] = bt * expf(g); ekd[lane] = expf(gl - g); egc[lane] = expf(g);
    if (lane == 63) p.GL[ch] = expf(g);
  }
  {
    float* cws = As;
    for (int e = t; e < 1536; e += 256) {
      int j = e / 384, rem = e - j * 384, X = rem >> 7, col = rem & 127;
      cws[e] = p.convw[(size_t)j * 1536 + X * 512 + h * 128 + col];
    }
  }
  __syncthreads();
  {
    const int i = t >> 2, cg = t & 3;
#pragma unroll 1
    for (int X = 0; X < 3; ++X) {
      const ush* src = X == 0 ? p.DQ : (X == 1 ? p.DK : p.DV);
      ush* dstS = X == 0 ? Qs : (X == 1 ? Ks : Vs);
      float y[32];
#pragma unroll
      for (int e = 0; e < 32; ++e) y[e] = 0.f;
#pragma unroll
      for (int j = 0; j < 4; ++j) {
        const int pos = c * 64 + i - 3 + j;
        const float vz = pos >= 0 ? 1.f : 0.f;
        const int posc = pos >= 0 ? pos : 0;
        {
          const u32x4* rp = (const u32x4*)(src + ((size_t)b * SEQL + posc) * 512 + h * 128 + cg * 32);
          const float4* wp = (const float4*)(As + (j * 3 + X) * 128 + cg * 32);
#pragma unroll
          for (int q = 0; q < 4; ++q) {
            u32x4 d = rp[q];
            float4 wa = wp[q * 2], wb = wp[q * 2 + 1];
            wa = scl4(wa, vz); wb = scl4(wb, vz);
            y[q * 8 + 0] += wa.x * bflo(d[0]); y[q * 8 + 1] += wa.y * bfhi(d[0]);
            y[q * 8 + 2] += wa.z * bflo(d[1]); y[q * 8 + 3] += wa.w * bfhi(d[1]);
            y[q * 8 + 4] += wb.x * bflo(d[2]); y[q * 8 + 5] += wb.y * bfhi(d[2]);
            y[q * 8 + 6] += wb.z * bflo(d[3]); y[q * 8 + 7] += wb.w * bfhi(d[3]);
          }
        }
      }
      float ss = 0.f;
#pragma unroll
      for (int e = 0; e < 32; ++e) { y[e] = silu_f(y[e]); ss += y[e] * y[e]; }
      float rs = 1.f;
      if (X < 2) {
        ss += __shfl_xor(ss, 1);
        ss += __shfl_xor(ss, 2);
        rs = rsqrtf(ss + 1e-6f);
        if (X == 0) rs *= 0.08838834764831845f;
      }
#pragma unroll
      for (int q = 0; q < 4; ++q) {
        u32x4 o;
        o[0] = pack2(y[q * 8 + 0] * rs, y[q * 8 + 1] * rs); o[1] = pack2(y[q * 8 + 2] * rs, y[q * 8 + 3] * rs);
        o[2] = pack2(y[q * 8 + 4] * rs, y[q * 8 + 5] * rs); o[3] = pack2(y[q * 8 + 6] * rs, y[q * 8 + 7] * rs);
        *(u32x4*)(dstS + i * 136 + cg * 32 + q * 8) = o;
      }
    }
  }
  __syncthreads();
  {
    const int ti = w >> 1, tj = w & 1, r = lane & 31, hh = lane >> 5;
    f32x16 skk = zero16(), sqk = zero16();
#pragma unroll
    for (int s = 0; s < 8; ++s) {
      bf16x8 ak = *(const bf16x8*)(Ks + (ti * 32 + r) * 136 + s * 16 + hh * 8);
      bf16x8 aq = *(const bf16x8*)(Qs + (ti * 32 + r) * 136 + s * 16 + hh * 8);
      bf16x8 bk = *(const bf16x8*)(Ks + (tj * 32 + r) * 136 + s * 16 + hh * 8);
      skk = MFMA32(ak, bk, skk);
      sqk = MFMA32(aq, bk, sqk);
    }
#pragma unroll
    for (int reg = 0; reg < 16; ++reg) {
      int ii = ti * 32 + crow(reg, hh), jj = tj * 32 + r;
      float dec = (jj <= ii) ? expf(gcs[ii] - gcs[jj]) : 0.f;
      As[ii * 64 + jj] = (jj < ii) ? bts[ii] * skk[reg] * dec : 0.f;
      p.INTRA[ch * 4096 + ii * 64 + jj] = f2bf(sqk[reg] * dec);
    }
  }
  __syncthreads();
  {
    float xs[64];
#pragma unroll
    for (int i = 0; i < 64; ++i) xs[i] = 0.f;
    const int col = t & 127;
    const bool isw = t >= 128;
#pragma unroll
    for (int i = 0; i < 64; ++i) {
      float a = isw ? ebg[i] * bf2f(Ks[i * 136 + col]) : bts[i] * bf2f(Vs[i * 136 + col]);
#pragma unroll
      for (int j4 = 0; j4 < (i + 3) / 4; ++j4) {
        float4 av = *(const float4*)(As + i * 64 + j4 * 4);
        a -= av.x * xs[j4 * 4 + 0];
        a -= av.y * xs[j4 * 4 + 1];
        a -= av.z * xs[j4 * 4 + 2];
        a -= av.w * xs[j4 * 4 + 3];
      }
      xs[i] = a;
    }
    if (!isw) {
#pragma unroll
      for (int q = 0; q < 8; ++q) {
        u32x4 o;
        o[0] = pack2(xs[q * 8 + 0], xs[q * 8 + 1]); o[1] = pack2(xs[q * 8 + 2], xs[q * 8 + 3]);
        o[2] = pack2(xs[q * 8 + 4], xs[q * 8 + 5]); o[3] = pack2(xs[q * 8 + 6], xs[q * 8 + 7]);
        *(u32x4*)(p.UT + ch * 8192 + col * 64 + q * 8) = o;
      }
    } else {
#pragma unroll
      for (int i = 0; i < 64; ++i) p.WG[ch * 8192 + i * 128 + col] = f2bf(xs[i]);
    }
  }
  {
    const int i = t >> 2, cg = t & 3;
    const float e = egc[i];
#pragma unroll
    for (int q = 0; q < 4; ++q) {
      u32x4 d = *(const u32x4*)(Qs + i * 136 + cg * 32 + q * 8);
      u32x4 o;
#pragma unroll
      for (int k = 0; k < 4; ++k) o[k] = pack2(bflo(d[k]) * e, bfhi(d[k]) * e);
      *(u32x4*)(p.QG + ch * 8192 + i * 128 + cg * 32 + q * 8) = o;
    }
    const int d_ = t & 127, ih = t >> 7;
#pragma unroll
    for (int q = 0; q < 4; ++q) {
      float vv[8];
#pragma unroll
      for (int k = 0; k < 8; ++k) { int ii = ih * 32 + q * 8 + k; vv[k] = bf2f(Ks[ii * 136 + d_]) * ekd[ii]; }
      u32x4 o;
      o[0] = pack2(vv[0], vv[1]); o[1] = pack2(vv[2], vv[3]); o[2] = pack2(vv[4], vv[5]); o[3] = pack2(vv[6], vv[7]);
      *(u32x4*)(p.KDT + ch * 8192 + d_ * 64 + ih * 32 + q * 8) = o;
    }
  }
  __syncthreads();
}

DI void dn_scan(const Params& p, int sw, char* smem) {
  int t_ = threadIdx.x;
  asm volatile("" : "+v"(t_));
  const int t = t_, lane = t & 63, w = t >> 6, r = lane & 31, hh = lane >> 5;
  const int bh = sw & 7, slice = sw >> 3;
  const int b = bh >> 2, h = bh & 3;
  ush* ST = (ush*)smem;
  ush* VNT = ST + 32 * 136;
  for (int i = t; i < 32 * 136 / 2; i += 256) ((unsigned*)ST)[i] = 0u;
  f32x16 S = zero16();
  const int wv = w & 1;
  const bool isP = w < 2;
  const ush* Abase = isP ? p.WG : p.QG;
  bf16x8 a32[8], kd[4], in4[4];
  u32x2 u4[4];
  bf16x8 na32[8], nkd[4], nin4[4];
  u32x2 nu4[4];
#pragma unroll
  for (int s = 0; s < 4; ++s) { in4[s] = (bf16x8){0,0,0,0,0,0,0,0}; nin4[s] = in4[s]; u4[s] = (u32x2){0u, 0u}; nu4[s] = u4[s]; }
  {
    const size_t ch = (size_t)bh * 128;
#pragma unroll
    for (int s = 0; s < 8; ++s) a32[s] = *(const bf16x8*)(Abase + ch * 8192 + (32 * wv + r) * 128 + s * 16 + hh * 8);
#pragma unroll
    for (int s = 0; s < 4; ++s) kd[s] = *(const bf16x8*)(p.KDT + ch * 8192 + (32 * w + r) * 64 + s * 16 + hh * 8);
    if (!isP) {
#pragma unroll
      for (int s = 0; s < 4; ++s) in4[s] = *(const bf16x8*)(p.INTRA + ch * 4096 + (32 * wv + r) * 64 + s * 16 + hh * 8);
    } else {
#pragma unroll
      for (int g = 0; g < 4; ++g) u4[g] = *(const u32x2*)(p.UT + ch * 8192 + (slice * 32 + r) * 64 + 32 * wv + 8 * g + 4 * hh);
    }
  }
  __syncthreads();
  for (int c = 0; c < 128; ++c) {
    {
      const size_t ch = (size_t)bh * 128 + (c + 1 < 128 ? c + 1 : 127);
#pragma unroll
      for (int s = 0; s < 8; ++s) na32[s] = *(const bf16x8*)(Abase + ch * 8192 + (32 * wv + r) * 128 + s * 16 + hh * 8);
#pragma unroll
      for (int s = 0; s < 4; ++s) nkd[s] = *(const bf16x8*)(p.KDT + ch * 8192 + (32 * w + r) * 64 + s * 16 + hh * 8);
      if (!isP) {
#pragma unroll
        for (int s = 0; s < 4; ++s) nin4[s] = *(const bf16x8*)(p.INTRA + ch * 4096 + (32 * wv + r) * 64 + s * 16 + hh * 8);
      } else {
#pragma unroll
        for (int g = 0; g < 4; ++g) nu4[g] = *(const u32x2*)(p.UT + ch * 8192 + (slice * 32 + r) * 64 + 32 * wv + 8 * g + 4 * hh);
      }
    }
    const float gl = p.GL[bh * 128 + c];
    f32x16 acc = zero16();
#pragma unroll
    for (int s = 0; s < 8; ++s) {
      bf16x8 bS = *(const bf16x8*)(ST + r * 136 + s * 16 + hh * 8);
      acc = MFMA32(a32[s], bS, acc);
    }
    if (isP) {
#pragma unroll
      for (int g = 0; g < 4; ++g) {
        float v0 = bflo(u4[g][0]) - acc[4 * g + 0], v1 = bfhi(u4[g][0]) - acc[4 * g + 1];
        float v2 = bflo(u4[g][1]) - acc[4 * g + 2], v3 = bfhi(u4[g][1]) - acc[4 * g + 3];
        u32x2 o; o[0] = pack2(v0, v1); o[1] = pack2(v2, v3);
        *(u32x2*)(VNT + r * 72 + 32 * wv + 8 * g + 4 * hh) = o;
      }
    }
    __syncthreads();
    bf16x8 bV[4];
#pragma unroll
    for (int s = 0; s < 4; ++s) bV[s] = *(const bf16x8*)(VNT + r * 72 + s * 16 + hh * 8);
    if (!isP) {
#pragma unroll
      for (int s = 0; s < 4; ++s) acc = MFMA32(in4[s], bV[s], acc);
      float* od = p.OD + ((size_t)b * SEQL + c * 64 + 32 * wv) * 512 + h * 128 + slice * 32 + r;
#pragma unroll
      for (int reg = 0; reg < 16; ++reg) od[(size_t)crow(reg, hh) * 512] = acc[reg];
    }
#pragma unroll
    for (int i = 0; i < 16; ++i) S[i] *= gl;
#pragma unroll
    for (int s = 0; s < 4; ++s) S = MFMA32(kd[s], bV[s], S);
#pragma unroll
    for (int g = 0; g < 4; ++g) {
      u32x2 o; o[0] = pack2(S[4 * g + 0], S[4 * g + 1]); o[1] = pack2(S[4 * g + 2], S[4 * g + 3]);
      *(u32x2*)(ST + r * 136 + 32 * w + 8 * g + 4 * hh) = o;
    }
    __syncthreads();
#pragma unroll
    for (int s = 0; s < 8; ++s) a32[s] = na32[s];
#pragma unroll
    for (int s = 0; s < 4; ++s) { kd[s] = nkd[s]; in4[s] = nin4[s]; u4[s] = nu4[s]; }
  }
}

DI float relu_i(float x) { int v = __float_as_int(x); return __int_as_float(v > 0 ? v : 0); }
DI unsigned ukey(float f) { unsigned u = __float_as_uint(f); return (u & 0x80000000u) ? ~u : (u | 0x80000000u); }

template <int CTRL> DI unsigned dppmov_u(unsigned x) {
  return (unsigned)__builtin_amdgcn_update_dpp(0, (int)x, CTRL, 0xF, 0xF, true);
}
DI unsigned wave_max_u32(unsigned v) {
  unsigned y;
  y = dppmov_u<0xB1>(v); v = v > y ? v : y;
  y = dppmov_u<0x4E>(v); v = v > y ? v : y;
  y = dppmov_u<0x141>(v); v = v > y ? v : y;
  y = dppmov_u<0x140>(v); v = v > y ? v : y;
  const unsigned a = (unsigned)__builtin_amdgcn_readlane((int)v, 0), b = (unsigned)__builtin_amdgcn_readlane((int)v, 16);
  const unsigned c = (unsigned)__builtin_amdgcn_readlane((int)v, 32), d = (unsigned)__builtin_amdgcn_readlane((int)v, 48);
  const unsigned ab = a > b ? a : b, cd = c > d ? c : d;
  return ab > cd ? ab : cd;
}
DI unsigned wave_min_u32(unsigned v) {
  unsigned y;
  y = dppmov_u<0xB1>(v); v = v < y ? v : y;
  y = dppmov_u<0x4E>(v); v = v < y ? v : y;
  y = dppmov_u<0x141>(v); v = v < y ? v : y;
  y = dppmov_u<0x140>(v); v = v < y ? v : y;
  const unsigned a = (unsigned)__builtin_amdgcn_readlane((int)v, 0), b = (unsigned)__builtin_amdgcn_readlane((int)v, 16);
  const unsigned c = (unsigned)__builtin_amdgcn_readlane((int)v, 32), d = (unsigned)__builtin_amdgcn_readlane((int)v, 48);
  const unsigned ab = a < b ? a : b, cd = c < d ? c : d;
  return ab < cd ? ab : cd;
}
DI unsigned inv_ukey(unsigned k) { return (k & 0x80000000u) ? (k & 0x7fffffffu) : ~k; }
DI void compact16(unsigned* bk, unsigned* bi, int& cnt, float& th_out, int lane) {
  const int n = cnt;
  unsigned k[8], ix[8], raw[8];
  unsigned kmx = 0u, kmn = 0xffffffffu;
#pragma unroll
  for (int q = 0; q < 8; ++q) {
    int e = lane + 64 * q; raw[q] = bk[e]; ix[q] = bi[e];
    const unsigned kk = ukey(__uint_as_float(raw[q]));
    const bool v = e < n;
    k[q] = v ? kk : 0u;
    kmx = (v && kk > kmx) ? kk : kmx;
    kmn = (v && kk < kmn) ? kk : kmn;
  }
  kmx = wave_max_u32(kmx); kmn = wave_min_u32(kmn);
  const unsigned diff = kmx ^ kmn;
  unsigned P = kmn;
  if (diff) {
    const int top = 31 - __builtin_clz(diff);
    P = kmx & ~((2u << top) - 1u);
#pragma unroll 1
    for (int bit = top; bit >= 0; --bit) {
      const unsigned tk = P | (1u << bit);
      int c = 0;
#pragma unroll
      for (int q = 0; q < 8; ++q) c += __popcll(__builtin_amdgcn_ballot_w64(k[q] >= tk));
      if (c >= 256) { P = tk; if (c <= 320) break; }
    }
  }
  int base = 0;
#pragma unroll
  for (int q = 0; q < 8; ++q) {
    const bool keep = k[q] >= P && k[q] != 0u;
    unsigned long long m = __builtin_amdgcn_ballot_w64(keep);
    int pre = base + (int)mbcnt64(m);
    if (keep) { bk[pre] = raw[q]; bi[pre] = ix[q]; }
    base += __popcll(m);
  }
  cnt = base;
  th_out = __uint_as_float(inv_ukey(P));
}

DI int final_select(unsigned* bk, unsigned* bi, int cnt, int lane) {
  if (cnt <= 256) return cnt;
  unsigned k[8], ix[8];
  unsigned kmx = 0u, kmn = 0xffffffffu;
#pragma unroll
  for (int q = 0; q < 8; ++q) {
    int e = lane + 64 * q; unsigned kk = ukey(__uint_as_float(bk[e])); ix[q] = bi[e];
    const bool v = e < cnt;
    k[q] = v ? kk : 0u;
    kmx = (v && kk > kmx) ? kk : kmx;
    kmn = (v && kk < kmn) ? kk : kmn;
  }
  kmx = wave_max_u32(kmx); kmn = wave_min_u32(kmn);
  const unsigned diff = kmx ^ kmn;
  unsigned P = kmn;
  if (diff) {
    const int top = 31 - __builtin_clz(diff);
    P = kmx & ~((2u << top) - 1u);
#pragma unroll 1
    for (int bit = top; bit >= 0; --bit) {
      const unsigned tk = P | (1u << bit);
      int c = 0;
#pragma unroll
      for (int q = 0; q < 8; ++q) c += __popcll(__ballot(k[q] >= tk));
      if (c >= 256) { P = tk; if (c == 256) break; }
    }
  }
  int cge = 0, cgt = 0;
#pragma unroll
  for (int q = 0; q < 8; ++q) { cge += __popcll(__ballot(k[q] >= P)); cgt += __popcll(__ballot(k[q] > P)); }
  const bool cut = (cge == 256);
  const int need = 256 - cgt;
  int base = 0, eqseen = 0;
#pragma unroll
  for (int q = 0; q < 8; ++q) {
    bool gt = k[q] > P, eq = k[q] == P, ge = k[q] >= P;
    unsigned long long me = __ballot(eq);
    int epre = eqseen + (int)mbcnt64(me);
    bool keep = cut ? ge : (gt || (eq && epre < need));
    unsigned long long m = __ballot(keep);
    int pre = base + (int)mbcnt64(m);
    if (keep) bi[pre] = ix[q];
    base += __popcll(m);
    eqseen += __popcll(me);
  }
  return base;
}

#define MFMA8(a, b, c) __builtin_amdgcn_mfma_f32_16x16x32_fp8_fp8((a), (b), (c), 0, 0, 0)
typedef __attribute__((ext_vector_type(4))) float f32x4v;
typedef __attribute__((ext_vector_type(2))) float f32x2v;
DI int pidx(int h, int key) { return h * 256 + (key ^ ((h & 1) << 5)); }
DI long mk64(unsigned lo, unsigned hi) { return (long)(((unsigned long long)hi << 32) | lo); }

DI void sparse_attn_query(const Params& p, size_t rowb, size_t row, const unsigned* sel, int nsel, float* pbuf, int lane) {
  const int m16 = lane & 15, kg = lane >> 4;
  long afr[16];
  {
    unsigned alo0, alo1, ahi0, ahi1;
    {
      const u32x4 qa = *(const u32x4*)(p.QA + row * 512 + (m16 & 7) * 64 + kg * 16);
      const u32x4 qb = *(const u32x4*)(p.QA + row * 512 + (m16 & 7) * 64 + kg * 16 + 8);
      alo0 = cvt4_fp8(bflo(qa[0]), bfhi(qa[0]), bflo(qa[1]), bfhi(qa[1]));
      alo1 = cvt4_fp8(bflo(qa[2]), bfhi(qa[2]), bflo(qa[3]), bfhi(qa[3]));
      ahi0 = cvt4_fp8(bflo(qb[0]), bfhi(qb[0]), bflo(qb[1]), bfhi(qb[1]));
      ahi1 = cvt4_fp8(bflo(qb[2]), bfhi(qb[2]), bflo(qb[3]), bfhi(qb[3]));
    }
#pragma unroll
    for (int s = 0; s < 16; ++s) {
      const bool on = (m16 == (s >> 1));
      afr[s] = mk64(on ? ((s & 1) ? ahi0 : alo0) : 0u, on ? ((s & 1) ? ahi1 : alo1) : 0u);
    }
  }
  const int ntile = (nsel + 15) >> 4;
  u32x4 bc[8], bn[8], bnn[8];
  {
    const int j = m16 < nsel ? m16 : nsel - 1;
    const unsigned char* kb = p.K8 + (rowb + sel[j]) * 512 + kg * 16;
#pragma unroll
    for (int h = 0; h < 8; ++h) { bc[h] = *(const u32x4*)(kb + h * 64); bn[h] = bc[h]; bnn[h] = bc[h]; }
    {
      const int kn = 16 + m16;
      const int j1 = kn < nsel ? kn : nsel - 1;
      const unsigned char* kb1 = p.K8 + (rowb + sel[j1]) * 512 + kg * 16;
#pragma unroll
      for (int h = 0; h < 8; ++h) bn[h] = *(const u32x4*)(kb1 + h * 64);
    }
  }
#pragma unroll 1
  for (int T = 0; T < ntile; ++T) {
    {
      const int kn = (T + 2) * 16 + m16;
      const int j = kn < nsel ? kn : nsel - 1;
      const unsigned char* kb = p.K8 + (rowb + sel[j]) * 512 + kg * 16;
#pragma unroll
      for (int h = 0; h < 8; ++h) bnn[h] = *(const u32x4*)(kb + h * 64);
    }
    f32x4v acc0 = {0.f, 0.f, 0.f, 0.f}, acc1 = {0.f, 0.f, 0.f, 0.f};
#pragma unroll
    for (int h = 0; h < 8; ++h) {
      acc0 = MFMA8(afr[2 * h], mk64(bc[h][0], bc[h][1]), acc0);
      acc1 = MFMA8(afr[2 * h + 1], mk64(bc[h][2], bc[h][3]), acc1);
    }
    const int key = T * 16 + m16;
    if (kg < 2) {
      const bool ok = key < nsel;
#pragma unroll
      for (int i = 0; i < 4; ++i) pbuf[pidx(4 * kg + i, key)] = ok ? (acc0[i] + acc1[i]) * 0.125f : -1e30f;
    }
#pragma unroll
    for (int h = 0; h < 8; ++h) { bc[h] = bn[h]; bn[h] = bnn[h]; }
  }
  for (int T = ntile; T < 16; ++T) {
    if (kg < 2) {
#pragma unroll
      for (int i = 0; i < 4; ++i) pbuf[pidx(4 * kg + i, T * 16 + m16)] = -1e30f;
    }
  }
  const int hl = lane >> 3, l8 = lane & 7;
  float inv;
  {
    float4 lg[8];
    float mx = -1e30f;
#pragma unroll
    for (int j = 0; j < 8; ++j) {
      lg[j] = *(const float4*)(pbuf + pidx(hl, 32 * j + 4 * l8));
      mx = fmaxf(mx, fmaxf(fmaxf(lg[j].x, lg[j].y), fmaxf(lg[j].z, lg[j].w)));
    }
    mx = fmaxf(mx, dppmov<0xB1>(mx));
    mx = fmaxf(mx, dppmov<0x4E>(mx));
    mx = fmaxf(mx, dppmov<0x141>(mx));
    float sum = 0.f;
#pragma unroll
    for (int j = 0; j < 8; ++j) {
      lg[j].x = __expf(lg[j].x - mx); lg[j].y = __expf(lg[j].y - mx); lg[j].z = __expf(lg[j].z - mx); lg[j].w = __expf(lg[j].w - mx);
      sum += (lg[j].x + lg[j].y) + (lg[j].z + lg[j].w);
      *(float4*)(pbuf + pidx(hl, 32 * j + 4 * l8)) = lg[j];
    }
    sum = red8(sum);
    inv = 1.f / sum;
  }
  const int kpar = lane >> 5, l5 = lane & 31, h16 = l5 >> 2;
  f32x2v o2[8];
#pragma unroll
  for (int e = 0; e < 8; ++e) o2[e] = (f32x2v){0.f, 0.f};
  const int nstep = (nsel + 15) >> 4;
  const unsigned char* vbase = p.V8 + rowb * 512 + l5 * 16;
  u32x4 vc[8], vn[8], vnn[8];
#define LOADV16(dst, J0)                                                            \
  {                                                                                 \
    _Pragma("unroll") for (int g = 0; g < 4; ++g) {                                 \
      const uint4 i4 = *(const uint4*)(sel + (J0) + 4 * g);                         \
      const unsigned ia = kpar ? i4.y : i4.x, ib = kpar ? i4.w : i4.z;              \
      const unsigned ida = ((J0) + 4 * g + kpar < nsel) ? ia : sel[0];              \
      const unsigned idb = ((J0) + 4 * g + 2 + kpar < nsel) ? ib : sel[0];          \
      dst[2 * g] = *(const u32x4*)(vbase + (size_t)ida * 512);                      \
      dst[2 * g + 1] = *(const u32x4*)(vbase + (size_t)idb * 512);                  \
    }                                                                               \
  }
  LOADV16(vc, 0);
#pragma unroll
  for (int e = 0; e < 8; ++e) { vn[e] = vc[e]; vnn[e] = vc[e]; }
  LOADV16(vn, 16);
#pragma unroll 1
  for (int st = 0; st < nstep; ++st) {
    { const int j0 = (st + 2) * 16; LOADV16(vnn, j0); }
#pragma unroll
    for (int e = 0; e < 8; ++e) {
      const float pj = pbuf[pidx(h16, st * 16 + 2 * e + kpar)];
      const f32x2v pp = {pj, pj};
      const u32x4 v = vc[e];
#pragma unroll
      for (int k = 0; k < 4; ++k) {
        o2[2 * k] = __builtin_elementwise_fma(__builtin_amdgcn_cvt_pk_f32_fp8((int)v[k], false), pp, o2[2 * k]);
        o2[2 * k + 1] = __builtin_elementwise_fma(__builtin_amdgcn_cvt_pk_f32_fp8((int)v[k], true), pp, o2[2 * k + 1]);
      }
    }
#pragma unroll
    for (int e = 0; e < 8; ++e) { vc[e] = vn[e]; vn[e] = vnn[e]; }
  }
#undef LOADV16
  float o[16];
#pragma unroll
  for (int e = 0; e < 8; ++e) { o[2 * e] = o2[e].x; o[2 * e + 1] = o2[e].y; }
#pragma unroll
  for (int e = 0; e < 16; ++e) o[e] += __shfl_xor(o[e], 32);
  const float invh = __shfl(inv, h16 * 8);
  if (kpar == 0) {
    const u32x4 ga0 = *(const u32x4*)(p.GA + row * 512 + l5 * 16);
    const u32x4 ga1 = *(const u32x4*)(p.GA + row * 512 + l5 * 16 + 8);
    u32x4 ov0, ov1;
#pragma unroll
    for (int k = 0; k < 4; ++k) {
      ov0[k] = pack2(o[2 * k] * invh * bflo(ga0[k]), o[2 * k + 1] * invh * bfhi(ga0[k]));
      ov1[k] = pack2(o[8 + 2 * k] * invh * bflo(ga1[k]), o[8 + 2 * k + 1] * invh * bfhi(ga1[k]));
    }
    *(u32x4*)(p.MIX + row * 1024 + l5 * 16) = ov0;
    *(u32x4*)(p.MIX + row * 1024 + l5 * 16 + 8) = ov1;
  }
}

DI void attn_task(const Params& p, int task, char* smem, int qsel = 0) {
  int t_ = threadIdx.x;
  asm volatile("" : "+v"(t_));
  const int t = t_, lane = t & 63, w = t >> 6, r = lane & 31, hh = lane >> 5;
  const int b = task & 1, s16 = 511 - (task >> 1);
  const int tq0 = s16 * 16 + 4 * w;
  const size_t rowb = (size_t)b * SEQL;
  unsigned* bkey = (unsigned*)smem + w * 4096;
  unsigned* bidx = bkey + 2048;
  const int ql = 2 * ((r >> 2) & 1) + (r >> 4), hd = (r & 3) + 4 * ((r >> 3) & 1);
  bf16x8 aq[4];
#pragma unroll
  for (int s = 0; s < 4; ++s) aq[s] = *(const bf16x8*)(p.IQ + (rowb + tq0 + ql) * 512 + hd * 64 + s * 16 + hh * 8);
  float w0[8], w1[8];
#pragma unroll
  for (int i = 0; i < 8; ++i) {
    w0[i] = p.IW[(rowb + tq0 + 2 * hh) * 8 + i];
    w1[i] = p.IW[(rowb + tq0 + 2 * hh + 1) * 8 + i];
  }
  const int tqa = tq0 + 2 * hh, tqb = tqa + 1;
  float tha = -__builtin_inff(), thb = -__builtin_inff();
  int cnt0 = 0, cnt1 = 0, cnt2 = 0, cnt3 = 0;
  const int ntile = ((s16 * 16 + 15) >> 5) + 1;
  const int offa = hh ? 1024 : 0, offb = hh ? 1536 : 512;
  auto tile_body = [&](const f32x16& acc, int kt) -> bool {
    float sa = 0.f, sb = 0.f;
#pragma unroll
    for (int i = 0; i < 8; ++i) {
      sa = fmaf(w0[i], relu_i(acc[i]), sa);
      sb = fmaf(w1[i], relu_i(acc[8 + i]), sb);
    }
    const int key = kt * 32 + r;
    const bool pa = (key <= tqa) & (sa >= tha);
    const bool pb = (key <= tqb) & (sb >= thb);
    {
      const unsigned long long m = __builtin_amdgcn_ballot_w64(pa);
      const int nlo = __popc((unsigned)m), nhi = __popc((unsigned)(m >> 32));
      const int pos = (int)mbcnt64(m) + (hh ? cnt2 - nlo : cnt0);
      if (pa && pos < 512) { bkey[offa + pos] = __float_as_uint(sa); bidx[offa + pos] = (unsigned)key; }
      cnt0 += nlo; cnt2 += nhi;
    }
    {
      const unsigned long long m = __builtin_amdgcn_ballot_w64(pb);
      const int nlo = __popc((unsigned)m), nhi = __popc((unsigned)(m >> 32));
      const int pos = (int)mbcnt64(m) + (hh ? cnt3 - nlo : cnt1);
      if (pb && pos < 512) { bkey[offb + pos] = __float_as_uint(sb); bidx[offb + pos] = (unsigned)key; }
      cnt1 += nlo; cnt3 += nhi;
    }
    return (cnt0 > 448) | (cnt1 > 448) | (cnt2 > 448) | (cnt3 > 448);
  };
  {
    ush* tile = (ush*)(smem + 65536);
    __shared__ int s_need[2];
    const int lkey = t >> 3, lch = t & 7;
    const ush* gsrc = p.IK + (rowb + lkey) * 64 + lch * 8;
    const int npair = (ntile + 1) >> 1;
    const int lp = npair - 1;
    u32x4 g0 = *(const u32x4*)(gsrc), g1 = *(const u32x4*)(gsrc + 2048);
    if (t < 2) s_need[t] = 0;
    for (int kp = 0; kp < npair; ++kp) {
      __syncthreads();
      const int need = kp > 0 ? s_need[(kp - 1) & 1] : 0;
      *(u32x4*)(tile + lkey * 72 + lch * 8) = g0;
      *(u32x4*)(tile + (lkey + 32) * 72 + lch * 8) = g1;
      __syncthreads();
      if (t == 0 && kp > 0) s_need[(kp - 1) & 1] = 0;
      {
        const int pn = kp + 1 < lp ? kp + 1 : lp;
        g0 = *(const u32x4*)(gsrc + (size_t)pn * 4096);
        g1 = *(const u32x4*)(gsrc + (size_t)pn * 4096 + 2048);
      }
      if (need) {
        if (cnt0 > 320) { float th; compact16(bkey, bidx, cnt0, th, lane); if (hh == 0) tha = th; }
        if (cnt1 > 320) { float th; compact16(bkey + 512, bidx + 512, cnt1, th, lane); if (hh == 0) thb = th; }
        if (cnt2 > 320) { float th; compact16(bkey + 1024, bidx + 1024, cnt2, th, lane); if (hh == 1) tha = th; }
        if (cnt3 > 320) { float th; compact16(bkey + 1536, bidx + 1536, cnt3, th, lane); if (hh == 1) thb = th; }
      }
      bf16x8 bta[4], btb[4];
#pragma unroll
      for (int s = 0; s < 4; ++s) {
        bta[s] = *(const bf16x8*)(tile + r * 72 + s * 16 + hh * 8);
        btb[s] = *(const bf16x8*)(tile + (32 + r) * 72 + s * 16 + hh * 8);
      }
      f32x16 acca = zero16(), accb = zero16();
#pragma unroll
      for (int s = 0; s < 4; ++s) { acca = MFMA32(aq[s], bta[s], acca); accb = MFMA32(aq[s], btb[s], accb); }
      bool nd = tile_body(acca, 2 * kp);
      if (2 * kp + 1 < ntile) nd |= tile_body(accb, 2 * kp + 1);
      if (nd && lane == 0) s_need[kp & 1] = 1;
    }
    __syncthreads();
  }
  const bool lo = qsel != 2, hi = qsel != 1;
  int nsel_q[4] = {0, 0, 0, 0};
  {
    int c0 = cnt0 > 512 ? 512 : cnt0, c1 = cnt1 > 512 ? 512 : cnt1, c2 = cnt2 > 512 ? 512 : cnt2, c3 = cnt3 > 512 ? 512 : cnt3;
    if (lo) {
      nsel_q[0] = final_select(bkey, bidx, c0, lane);
      nsel_q[1] = final_select(bkey + 512, bidx + 512, c1, lane);
    }
    if (hi) {
      nsel_q[2] = final_select(bkey + 1024, bidx + 1024, c2, lane);
      nsel_q[3] = final_select(bkey + 1536, bidx + 1536, c3, lane);
    }
  }
  float* pbuf = (float*)bkey;
#pragma unroll
  for (int q = 0; q < 4; ++q) {
    if (q < 2 ? lo : hi) sparse_attn_query(p, rowb, rowb + tq0 + q, bidx + q * 512, nsel_q[q], pbuf, lane);
  }
}

DI void dn_norm(const Params& p, int wave, int nw, int lane) {
  const float4* nwp = (const float4*)(p.dnw + (lane & 15) * 8);
  const float4 n0 = nwp[0], n1 = nwp[1];
  for (int row0 = wave; row0 < NTOK; row0 += 4 * nw) {
    float4 a[4], c[4];
    u32x4 z[4];
#pragma unroll
    for (int j = 0; j < 4; ++j) {
      const int row = row0 + j * nw;
      const float4* op = (const float4*)(p.OD + (size_t)row * 512 + lane * 8);
      a[j] = op[0]; c[j] = op[1];
      z[j] = *(const u32x4*)(p.SZ + (size_t)row * 512 + lane * 8);
    }
#pragma unroll
    for (int j = 0; j < 4; ++j) {
      const int row = row0 + j * nw;
      float ss = a[j].x * a[j].x + a[j].y * a[j].y + a[j].z * a[j].z + a[j].w * a[j].w + c[j].x * c[j].x + c[j].y * c[j].y + c[j].z * c[j].z + c[j].w * c[j].w;
      ss += __shfl_xor(ss, 1); ss += __shfl_xor(ss, 2); ss += __shfl_xor(ss, 4); ss += __shfl_xor(ss, 8);
      const float rs = rsqrtf(ss * (1.f / 128.f) + 1e-6f);
      u32x4 o;
      o[0] = pack2(a[j].x * rs * n0.x * bflo(z[j][0]), a[j].y * rs * n0.y * bfhi(z[j][0]));
      o[1] = pack2(a[j].z * rs * n0.z * bflo(z[j][1]), a[j].w * rs * n0.w * bfhi(z[j][1]));
      o[2] = pack2(c[j].x * rs * n1.x * bflo(z[j][2]), c[j].y * rs * n1.y * bfhi(z[j][2]));
      o[3] = pack2(c[j].z * rs * n1.z * bflo(z[j][3]), c[j].w * rs * n1.w * bfhi(z[j][3]));
      *(u32x4*)(p.MIX + (size_t)row * 1024 + 512 + lane * 8) = o;
    }
  }
}

DI void dn_norm_rows(const Params& p, int row_base, int lane) {
  const float4* nwp = (const float4*)(p.dnw + (lane & 15) * 8);
  const float4 n0 = nwp[0], n1 = nwp[1];
#pragma unroll 1
  for (int r4 = 0; r4 < 16; r4 += 4) {
    float4 a[4], c[4];
    u32x4 z[4];
#pragma unroll
    for (int j = 0; j < 4; ++j) {
      const int row = row_base + r4 + j;
      const float4* op = (const float4*)(p.OD + (size_t)row * 512 + lane * 8);
      a[j] = op[0]; c[j] = op[1];
      z[j] = *(const u32x4*)(p.SZ + (size_t)row * 512 + lane * 8);
    }
#pragma unroll
    for (int j = 0; j < 4; ++j) {
      const int row = row_base + r4 + j;
      float ss = a[j].x * a[j].x + a[j].y * a[j].y + a[j].z * a[j].z + a[j].w * a[j].w + c[j].x * c[j].x + c[j].y * c[j].y + c[j].z * c[j].z + c[j].w * c[j].w;
      ss += __shfl_xor(ss, 1); ss += __shfl_xor(ss, 2); ss += __shfl_xor(ss, 4); ss += __shfl_xor(ss, 8);
      const float rs = rsqrtf(ss * (1.f / 128.f) + 1e-6f);
      u32x4 o;
      o[0] = pack2(a[j].x * rs * n0.x * bflo(z[j][0]), a[j].y * rs * n0.y * bfhi(z[j][0]));
      o[1] = pack2(a[j].z * rs * n0.z * bflo(z[j][1]), a[j].w * rs * n0.w * bfhi(z[j][1]));
      o[2] = pack2(c[j].x * rs * n1.x * bflo(z[j][2]), c[j].y * rs * n1.y * bfhi(z[j][2]));
      o[3] = pack2(c[j].z * rs * n1.z * bflo(z[j][3]), c[j].w * rs * n1.w * bfhi(z[j][3]));
      *(u32x4*)(p.MIX + (size_t)row * 1024 + 512 + lane * 8) = o;
    }
  }
}

DI void outproj_tile(const Params& p, int tile, char* smem) {
  const int mt = tile >> 3, nt = tile & 7;
  const int m0 = mt * 128, n0 = nt * 128;
  f32x16 acc[2][2];
  gemm_tile(p.MIX, p.Wo, m0, n0, 1024, smem, acc);
  (void)stage_rows(acc, smem);
  int t_ = threadIdx.x;
  asm volatile("" : "+v"(t_));
  const int t = t_, c4 = t & 31, r0 = t >> 5;
  const float* Cs = (const float*)smem;
#pragma unroll 4
  for (int ps = 0; ps < 16; ++ps) {
    const int rr = ps * 8 + r0;
    const float4 f = *(const float4*)(Cs + rr * 132 + c4 * 4);
    const size_t off = (size_t)(m0 + rr) * 1024 + n0 + c4 * 4;
    const float4 xv = *(const float4*)(p.x + off);
    *(float4*)(p.out + off) = make_float4(xv.x + f.x, xv.y + f.y, xv.z + f.z, xv.w + f.w);
  }
}

#define XB_TMO      128
#define XB_XCNT(j)  (256  + 64 * (j))
#define XB_XSUB(j)  (1280 + 64 * (j))
#define XB_XGEN(j)  (2304 + 64 * (j))
#define XB_TOP      3328
#define XB_TOPGEN   3392
#define XCD_BAR_WORDS 3456
#define XB_SPIN_CAP (1u << 20)
#define LAS __attribute__((address_space(3)))
DI unsigned xb_ld(unsigned* p) { return __hip_atomic_load(p, __ATOMIC_RELAXED, __HIP_MEMORY_SCOPE_AGENT); }
DI unsigned xb_add(unsigned* p, unsigned v) { return __hip_atomic_fetch_add(p, v, __ATOMIC_RELAXED, __HIP_MEMORY_SCOPE_AGENT); }
DI unsigned xb_xcc_id() { return (unsigned)__builtin_amdgcn_s_getreg((3 << 11) | 20) & 0xFu; }
#define XB_SPIN(cond, bar) do { unsigned _sp = 0; while (cond) { __builtin_amdgcn_s_sleep(1); \
    if ((++_sp & 255u) == 0u) { if (xb_ld(&(bar)[XB_TMO])) break; if (_sp > XB_SPIN_CAP) { atomicAdd(&(bar)[XB_TMO], 1u); break; } } } } while (0)
struct XcdBarrier { unsigned* bar; unsigned x; volatile LAS unsigned* st; };
DI XcdBarrier xcd_barrier_post(unsigned* bar, volatile LAS unsigned* st) {
  XcdBarrier b; b.bar = bar; b.x = xb_xcc_id(); b.st = st;
  if (threadIdx.x == 0) (void)xb_add(&bar[XB_XCNT(b.x)], 1u);
  return b;
}
DI void xcd_barrier_complete(unsigned* bar, unsigned x, unsigned& nloc, unsigned& nx) {
  const unsigned G = gridDim.x * gridDim.y * gridDim.z;
  unsigned sum, cnt, mine, sp = 0u;
  for (;;) {
    sum = 0u; cnt = 0u; mine = 0u;
#pragma unroll
    for (unsigned j = 0; j < 16; ++j) { const unsigned c = xb_ld(&bar[XB_XCNT(j)]); sum += c; cnt += (c > 0u) ? 1u : 0u; mine = (j == x) ? c : mine; }
    if (sum == G) break;
    __builtin_amdgcn_s_sleep(1);
    if ((++sp & 255u) == 0u) { if (xb_ld(&bar[XB_TMO])) break; if (sp > XB_SPIN_CAP) { atomicAdd(&bar[XB_TMO], 1u); break; } }
  }
  nloc = mine > 0u ? mine : 1u; nx = cnt > 0u ? cnt : 1u;
}
DI void xcd_barrier(const XcdBarrier& b) {
  asm volatile("s_waitcnt vmcnt(0)" ::: "memory");
  __syncthreads();
  if (threadIdx.x == 0) {
    unsigned* bar = b.bar;
    __builtin_amdgcn_s_waitcnt(0);
    unsigned nloc = b.st[0], nx = b.st[1];
    if (nloc == 0u) { xcd_barrier_complete(bar, b.x, nloc, nx); b.st[0] = nloc; b.st[1] = nx; }
    const unsigned old = xb_add(&bar[XB_XSUB(b.x)], 1u);
    const unsigned gen = old / nloc;
    if (old + 1u == (gen + 1u) * nloc) {
      __builtin_amdgcn_fence(__ATOMIC_RELEASE, "agent");
      asm volatile("s_waitcnt vmcnt(0)" ::: "memory");
      const unsigned og = xb_add(&bar[XB_TOP], 1u);
      const unsigned tg = og / nx;
      if (og + 1u == (tg + 1u) * nx) xb_add(&bar[XB_TOPGEN], 1u);
      else XB_SPIN(xb_ld(&bar[XB_TOPGEN]) == tg, bar);
      __builtin_amdgcn_fence(__ATOMIC_ACQUIRE, "agent");
      xb_add(&bar[XB_XGEN(b.x)], 1u);
      asm volatile("s_waitcnt vmcnt(0)" ::: "memory");
    } else {
      XB_SPIN(xb_ld(&bar[XB_XGEN(b.x)]) == gen, bar);
      __builtin_amdgcn_fence(__ATOMIC_ACQUIRE, "agent");
      asm volatile("s_waitcnt vmcnt(0)" ::: "memory");
    }
  }
  __syncthreads();
}

__global__ void __launch_bounds__(256, 2) k_prep(Params p) {
  __shared__ __attribute__((aligned(16))) char smem[SMEM_BYTES];
  phase_prep(p, blockIdx.x * 256 + threadIdx.x, gridDim.x * 256, smem);
}
__global__ void __launch_bounds__(256, 2) k_inproj(Params p) {
  __shared__ __attribute__((aligned(16))) char smem[SMEM_BYTES];
  for (int tile = blockIdx.x; tile < 128 * 37; tile += gridDim.x) inproj_tile(p, tile, smem);
}
__global__ void __launch_bounds__(256, 2) k_dnprep(Params p) {
  __shared__ __attribute__((aligned(16))) char smem[SMEM_BYTES];
  for (int task = blockIdx.x; task < 1024; task += gridDim.x) dn_prep_task(p, task, smem);
}
__global__ void __launch_bounds__(256, 2) k_scan(Params p) {
  __shared__ __attribute__((aligned(16))) char smem[SMEM_BYTES];
  dn_scan(p, blockIdx.x, smem);
}
__global__ void __launch_bounds__(256, 2) k_attn(Params p) {
  __shared__ __attribute__((aligned(16))) char smem[SMEM_BYTES];
  for (int task = blockIdx.x; task < 1024; task += gridDim.x) attn_task(p, task, smem);
}
__global__ void __launch_bounds__(256, 2) k_dnnorm(Params p) {
  dn_norm(p, (blockIdx.x * 256 + threadIdx.x) >> 6, (gridDim.x * 256) >> 6, threadIdx.x & 63);
}
__global__ void __launch_bounds__(256, 2) k_outproj(Params p) {
  __shared__ __attribute__((aligned(16))) char smem[SMEM_BYTES];
  for (int tile = blockIdx.x; tile < 1024; tile += gridDim.x) outproj_tile(p, tile, smem);
}

__global__ void __launch_bounds__(256, 2) k_mega(Params p) {
  __shared__ __attribute__((aligned(16))) char smem[SMEM_BYTES];
  __shared__ uint4 xb_words;
  __shared__ int s_task;
  cg::grid_group grid = cg::this_grid();
  if (threadIdx.x == 0) xb_words = make_uint4(0u, 0u, 0u, 0u);
  __syncthreads();
  XcdBarrier xb = xcd_barrier_post(p.counters + 64, (volatile LAS unsigned*)&xb_words);
  const int gtid = blockIdx.x * 256 + threadIdx.x, gsize = gridDim.x * 256;
  phase_prep(p, gtid, gsize, smem);
  if (p.use_cg_sync) grid.sync();
  xcd_barrier(xb);
  for (int tile = blockIdx.x; tile < 128 * 19; tile += gridDim.x) inproj_tile256(p, tile, smem);
  xcd_barrier(xb);
  for (int task = blockIdx.x; task < 1024; task += gridDim.x) dn_prep_task(p, task, smem);
  xcd_barrier(xb);
  if (blockIdx.x < 32) {
    __builtin_amdgcn_s_setprio(3);
    dn_scan(p, blockIdx.x, smem);
    __builtin_amdgcn_s_setprio(0);
    asm volatile("s_waitcnt vmcnt(0)" ::: "memory");
    __syncthreads();
    if (threadIdx.x == 0) {
      __builtin_amdgcn_fence(__ATOMIC_RELEASE, "agent");
      asm volatile("s_waitcnt vmcnt(0)" ::: "memory");
      atomicAdd(&p.counters[32], 1u);
    }
    __syncthreads();
  }
  {
    int pb = (int)((xb.x >> 2) & 1u);
    int tries = 0;
    while (tries < 2) {
      if (threadIdx.x == 0) s_task = (int)atomicAdd(&p.counters[pb], 1u);
      __syncthreads();
      const int tk = s_task;
      __syncthreads();
      if (tk >= 512 + QSPLIT) { pb ^= 1; ++tries; continue; }
      if (tk < 512 - QSPLIT) attn_task(p, tk * 2 + pb, smem, 0);
      else { const int j = tk - (512 - QSPLIT); attn_task(p, ((512 - QSPLIT) + (j >> 1)) * 2 + pb, smem, 1 + (j & 1)); }
    }
  }
  {
    if (threadIdx.x == 0) {
      unsigned sp = 0;
      while (__hip_atomic_load(&p.counters[32], __ATOMIC_RELAXED, __HIP_MEMORY_SCOPE_AGENT) < 32u) {
        __builtin_amdgcn_s_sleep(4);
        if (++sp > (1u << 22)) break;
      }
      __builtin_amdgcn_fence(__ATOMIC_ACQUIRE, "agent");
      asm volatile("s_waitcnt vmcnt(0)" ::: "memory");
    }
    __syncthreads();
    while (true) {
      if (threadIdx.x == 0) s_task = (int)atomicAdd(&p.counters[33], 1u);
      __syncthreads();
      const int ck = s_task;
      __syncthreads();
      if (ck >= 256) break;
      int tn_ = threadIdx.x;
      asm volatile("" : "+v"(tn_));
      dn_norm_rows(p, ck * 64 + (tn_ >> 6) * 16, tn_ & 63);
    }
  }
  xcd_barrier(xb);
  for (int tile = blockIdx.x; tile < 1024; tile += gridDim.x) outproj_tile(p, tile, smem);
}

extern "C" void kernel_launch(void* const* d_in, const int* in_sizes, int n_in, void* d_out, int out_size, void* d_ws,
                              size_t ws_size, hipStream_t stream) {
  Params p{};
  p.x = (const float*)d_in[0]; p.ln_w = (const float*)d_in[1]; p.w_in = (const float*)d_in[2];
  p.aqw = (const float*)d_in[3]; p.akw = (const float*)d_in[4]; p.ikw = (const float*)d_in[5];
  p.ikb = (const float*)d_in[6]; p.convw = (const float*)d_in[7]; p.alog = (const float*)d_in[8];
  p.dtb = (const float*)d_in[9]; p.dnw = (const float*)d_in[10]; p.w_out = (const float*)d_in[11];
  p.out = (float*)d_out;
  char* ws = (char*)d_ws;
  const size_t MB = 1u << 20;
  p.Wt = (ush*)(ws + 0);
  p.Wo = (ush*)(ws + 10 * MB);
  p.XB = (ush*)(ws + 12 * MB);
  p.MIX = (ush*)(ws + 12 * MB);
  p.QA = (ush*)(ws + 45 * MB); p.KA = (ush*)(ws + 61 * MB); p.VA = (ush*)(ws + 77 * MB);
  p.GA = (ush*)(ws + 93 * MB); p.IQ = (ush*)(ws + 109 * MB); p.DQ = (ush*)(ws + 125 * MB);
  p.DK = (ush*)(ws + 141 * MB); p.DV = (ush*)(ws + 157 * MB); p.SZ = (ush*)(ws + 173 * MB);
  p.IK = (ush*)(ws + 189 * MB);
  p.IW = (float*)(ws + 191 * MB);
  p.BETA = (float*)(ws + 191 * MB + 512 * 1024);
  p.G = (float*)(ws + 191 * MB + 768 * 1024);
  p.INTRA = (ush*)(ws + 192 * MB);
  p.GL = (float*)(ws + 200 * MB);
  p.OD = (float*)(ws + 201 * MB);
  p.counters = (unsigned*)(ws + 233 * MB);
  p.K8 = (unsigned char*)(ws + 61 * MB);
  p.V8 = (unsigned char*)(ws + 77 * MB);
  char* o8 = (char*)d_out;
  p.UT = (ush*)(o8); p.WG = (ush*)(o8 + 16 * MB); p.QG = (ush*)(o8 + 32 * MB); p.KDT = (ush*)(o8 + 48 * MB);

#if MEGA
  static int grid_blocks = 0;
  if (!grid_blocks) {
    int dev = 0, cus = 0, per_cu = 0;
    hipGetDevice(&dev);
    hipDeviceGetAttribute(&cus, hipDeviceAttributeMultiprocessorCount, dev);
    hipOccupancyMaxActiveBlocksPerMultiprocessor(&per_cu, k_mega, 256, 0);
    if (per_cu > 2) per_cu = 2;
    grid_blocks = cus * per_cu;
  }
  hipMemsetAsync(p.counters, 0, (64 + XCD_BAR_WORDS) * sizeof(unsigned), stream);
  void* args[] = {&p};
  hipError_t e = hipLaunchCooperativeKernel((void*)k_mega, dim3(grid_blocks), dim3(256), args, 0, stream);
  if (e != hipSuccess) fprintf(stderr, "cooperative launch failed: %s (grid %d)\n", hipGetErrorString(e), grid_blocks);
#else
  k_prep<<<1024, 256, 0, stream>>>(p);
  k_inproj<<<128 * 37, 256, 0, stream>>>(p);
  k_dnprep<<<1024, 256, 0, stream>>>(p);
  k_scan<<<32, 256, 0, stream>>>(p);
  k_attn<<<1024, 256, 0, stream>>>(p);
  k_dnnorm<<<1024, 256, 0, stream>>>(p);
  k_outproj<<<1024, 256, 0, stream>>>(p);
#endif
}
```

```cpp
#include <hip/hip_runtime.h>
#include <hip/hip_cooperative_groups.h>
#include <cstdio>
#include <cstdint>
namespace cg = cooperative_groups;

#ifndef MEGA
#define MEGA 1
#endif

#define DI __device__ __forceinline__
typedef __attribute__((ext_vector_type(8))) short bf16x8;
typedef __attribute__((ext_vector_type(16))) float f32x16;
typedef __attribute__((ext_vector_type(4))) unsigned u32x4;
typedef __attribute__((ext_vector_type(2))) unsigned u32x2;
typedef __attribute__((ext_vector_type(2))) __bf16 bf2_t;
typedef unsigned short ush;
#define MFMA32(a, b, c) __builtin_amdgcn_mfma_f32_32x32x16_bf16((a), (b), (c), 0, 0, 0)

constexpr int NTOK = 16384;
constexpr int SEQL = 8192;
constexpr int NP = 4736;
constexpr int DIN = 4688;
constexpr int SMEM_BYTES = 74752;
constexpr int QSPLIT = 48;

struct Params {
  const float *x, *ln_w, *w_in, *aqw, *akw, *ikw, *ikb, *convw, *alog, *dtb, *dnw, *w_out;
  float* out;
  ush *Wt, *Wo, *XB, *MIX, *QA, *KA, *VA, *GA, *IQ, *DQ, *DK, *DV, *SZ, *IK, *INTRA;
  ush *UT, *WG, *QG, *KDT;
  float *IW, *BETA, *G, *GL, *OD;
  unsigned* counters;
  unsigned char *K8, *V8;
  int use_cg_sync, pad0;
};

DI ush f2bf(float x) { return __builtin_bit_cast(ush, (__bf16)x); }
DI float bf2f(ush b) { return __uint_as_float(((unsigned)b) << 16); }
DI unsigned pack2(float a, float b) { bf2_t v = {(__bf16)a, (__bf16)b}; return __builtin_bit_cast(unsigned, v); }
DI float bflo(unsigned u) { return __uint_as_float(u << 16); }
DI float bfhi(unsigned u) { return __uint_as_float(u & 0xffff0000u); }
DI int crow(int reg, int h) { return (reg & 3) + 8 * (reg >> 2) + 4 * h; }
DI float silu_f(float v) { return v / (1.f + __expf(-v)); }
DI f32x16 zero16() { f32x16 z; for (int i = 0; i < 16; ++i) z[i] = 0.f; return z; }

template <int CTRL> DI float dppmov(float x) {
  return __int_as_float(__builtin_amdgcn_update_dpp(0, __float_as_int(x), CTRL, 0xF, 0xF, true));
}
DI float red8(float d) {
  d += dppmov<0xB1>(d);
  d += dppmov<0x4E>(d);
  d += dppmov<0x141>(d);
  return d;
}
DI unsigned mbcnt64(unsigned long long m) {
  return __builtin_amdgcn_mbcnt_hi((unsigned)(m >> 32), __builtin_amdgcn_mbcnt_lo((unsigned)m, 0u));
}
DI int mapcol(int n) {
  if (n < 2560) return n;
  if (n < 4608) return n + 72;
  if (n < 4680) return n - 2048;
  if (n < 4688) return n;
  return -1;
}

DI void phase_prep(const Params& p, int gtid, int gsize, char* smem) {
  {
    unsigned* Ts = (unsigned*)smem;
    ush* Th = (ush*)smem;
    int t_ = threadIdx.x;
    asm volatile("" : "+v"(t_));
    const int t = t_;
    for (int tt = blockIdx.x; tt < 1472; tt += gridDim.x) {
      const bool is_in = tt < 1216;
      const int id = is_in ? tt : tt - 1216;
      const int nt = is_in ? id % 76 : (id & 15), kt = is_in ? id / 76 : (id >> 4);
      const float* src = is_in ? p.w_in : p.w_out;
      const int ld = is_in ? DIN : 1024;
      ush* dst = is_in ? p.Wt : p.Wo;
      {
        const int n = t & 63, ks = t >> 6;
        const int oc = is_in ? mapcol(nt * 64 + n) : nt * 64 + n;
#pragma unroll
        for (int it = 0; it < 16; ++it) {
          int k = it * 4 + ks;
          float v = oc >= 0 ? src[(size_t)(kt * 64 + k) * ld + oc] : 0.f;
          Th[n * 66 + k] = f2bf(v);
        }
      }
      __syncthreads();
      {
        const int n = t >> 2, kq = t & 3;
        u32x4 a, b;
#pragma unroll
        for (int i = 0; i < 4; ++i) { a[i] = Ts[n * 33 + kq * 8 + i]; b[i] = Ts[n * 33 + kq * 8 + 4 + i]; }
        u32x4* dp = (u32x4*)(dst + (size_t)(nt * 64 + n) * 1024 + kt * 64 + kq * 16);
        dp[0] = a; dp[1] = b;
      }
      __syncthreads();
    }
  }
  int wave = gtid >> 6, lane = gtid & 63, nw = gsize >> 6;
  for (int row = wave; row < NTOK; row += nw) {
    const float4* xr = (const float4*)(p.x + (size_t)row * 1024);
    float4 a[4];
    float ss = 0.f;
#pragma unroll
    for (int i = 0; i < 4; ++i) {
      a[i] = xr[lane + 64 * i];
      ss += a[i].x * a[i].x + a[i].y * a[i].y + a[i].z * a[i].z + a[i].w * a[i].w;
    }
#pragma unroll
    for (int o = 1; o < 64; o <<= 1) ss += __shfl_xor(ss, o);
    float rs = rsqrtf(ss * (1.f / 1024.f) + 1e-6f);
#pragma unroll
    for (int i = 0; i < 4; ++i) {
      float4 lw = ((const float4*)p.ln_w)[lane + 64 * i];
      u32x2 o;
      o[0] = pack2(a[i].x * rs * lw.x, a[i].y * rs * lw.y);
      o[1] = pack2(a[i].z * rs * lw.z, a[i].w * rs * lw.w);
      *(u32x2*)(p.XB + (size_t)row * 1024 + (lane + 64 * i) * 4) = o;
    }
  }
}

DI void gemm_tile(const ush* __restrict__ A, const ush* __restrict__ B, int m0, int n0, int K, char* smem,
                  f32x16 (&acc)[2][2]) {
  ush* As = (ush*)smem;
  ush* Bs = As + 128 * 72;
  int t_ = threadIdx.x;
  asm volatile("" : "+v"(t_));
  const int t = t_, lane = t & 63, w = t >> 6, wm = w >> 1, wn = w & 1, r = lane & 31, h = lane >> 5;
  u32x4 ra[4], rb[4];
#pragma unroll
  for (int i = 0; i < 2; ++i)
#pragma unroll
    for (int j = 0; j < 2; ++j) acc[i][j] = zero16();
#pragma unroll
  for (int i = 0; i < 4; ++i) {
    int c = t + 256 * i, row = c >> 3, kc = c & 7;
    ra[i] = *(const u32x4*)(A + (size_t)(m0 + row) * K + kc * 8);
    rb[i] = *(const u32x4*)(B + (size_t)(n0 + row) * K + kc * 8);
  }
  for (int k0 = 0; k0 < K; k0 += 64) {
    __syncthreads();
#pragma unroll
    for (int i = 0; i < 4; ++i) {
      int c = t + 256 * i, row = c >> 3, kc = c & 7;
      *(u32x4*)(As + row * 72 + kc * 8) = ra[i];
      *(u32x4*)(Bs + row * 72 + kc * 8) = rb[i];
    }
    __syncthreads();
    if (k0 + 64 < K) {
#pragma unroll
      for (int i = 0; i < 4; ++i) {
        int c = t + 256 * i, row = c >> 3, kc = c & 7;
        ra[i] = *(const u32x4*)(A + (size_t)(m0 + row) * K + k0 + 64 + kc * 8);
        rb[i] = *(const u32x4*)(B + (size_t)(n0 + row) * K + k0 + 64 + kc * 8);
      }
    }
#pragma unroll
    for (int s = 0; s < 4; ++s) {
      bf16x8 af[2], bfr[2];
#pragma unroll
      for (int i = 0; i < 2; ++i) af[i] = *(const bf16x8*)(As + (wm * 64 + i * 32 + r) * 72 + s * 16 + h * 8);
#pragma unroll
      for (int j = 0; j < 2; ++j) bfr[j] = *(const bf16x8*)(Bs + (wn * 64 + j * 32 + r) * 72 + s * 16 + h * 8);
#pragma unroll
      for (int i = 0; i < 2; ++i)
#pragma unroll
        for (int j = 0; j < 2; ++j) acc[i][j] = MFMA32(af[i], bfr[j], acc[i][j]);
    }
  }
  __syncthreads();
}

DI const float* stage_rows(f32x16 (&acc)[2][2], char* smem) {
  float* Cs = (float*)smem;
  int t_ = threadIdx.x;
  asm volatile("" : "+v"(t_));
  const int t = t_, lane = t & 63, w = t >> 6, wm = w >> 1, wn = w & 1, r = lane & 31, h = lane >> 5;
#pragma unroll
  for (int i = 0; i < 2; ++i)
#pragma unroll
    for (int j = 0; j < 2; ++j)
#pragma unroll
      for (int reg = 0; reg < 16; ++reg)
        Cs[(wm * 64 + i * 32 + crow(reg, h)) * 132 + wn * 64 + j * 32 + r] = acc[i][j][reg];
  __syncthreads();
  return Cs + (t & 127) * 132 + (t >> 7) * 64;
}
DI u32x4 pack8(float4 a, float4 b) {
  u32x4 o;
  o[0] = pack2(a.x, a.y); o[1] = pack2(a.z, a.w); o[2] = pack2(b.x, b.y); o[3] = pack2(b.z, b.w);
  return o;
}
DI float4 mul4(float4 a, float4 b) { return make_float4(a.x * b.x, a.y * b.y, a.z * b.z, a.w * b.w); }
DI float4 scl4(float4 a, float s) { return make_float4(a.x * s, a.y * s, a.z * s, a.w * s); }
DI unsigned cvt4_fp8(float a, float b, float c, float d) {
  int r = 0;
  r = __builtin_amdgcn_cvt_pk_fp8_f32(a, b, r, false);
  r = __builtin_amdgcn_cvt_pk_fp8_f32(c, d, r, true);
  return (unsigned)r;
}
DI float4 silu4(float4 a) { return make_float4(silu_f(a.x), silu_f(a.y), silu_f(a.z), silu_f(a.w)); }

DI void inproj_epilogue(const Params& p, int row, int nt, int half, const float4* cv) {
  if (nt < 36) {
    const int grp = nt >> 2;
    const int col = (nt & 3) * 128 + half * 64;
    ush* dst = (ush*)((char*)p.QA + (size_t)grp * (16u << 20));
    u32x4* dp = (u32x4*)(dst + (size_t)row * 512 + col);
    if (grp == 0) {
      float ss = 0.f;
#pragma unroll
      for (int q = 0; q < 16; ++q) { float4 f = cv[q]; ss += f.x * f.x + f.y * f.y + f.z * f.z + f.w * f.w; }
      const float rs = rsqrtf(ss * (1.f / 64.f) + 1e-6f);
      const float4* nw = (const float4*)p.aqw;
#pragma unroll
      for (int q = 0; q < 8; ++q)
        dp[q] = pack8(scl4(mul4(cv[2 * q], nw[2 * q]), rs), scl4(mul4(cv[2 * q + 1], nw[2 * q + 1]), rs));
    } else if (grp == 1) {
      float ss = 0.f;
#pragma unroll
      for (int q = 0; q < 16; ++q) { float4 f = cv[q]; ss += f.x * f.x + f.y * f.y + f.z * f.z + f.w * f.w; }
      const float rs = rsqrtf(ss * (1.f / 64.f) + 1e-6f);
      const float4* nw = (const float4*)p.akw;
      u32x4* d8 = (u32x4*)(p.K8 + (size_t)row * 512 + col);
#pragma unroll
      for (int q = 0; q < 4; ++q) {
        u32x4 o;
#pragma unroll
        for (int k = 0; k < 4; ++k) { float4 f = scl4(mul4(cv[4 * q + k], nw[4 * q + k]), rs); o[k] = cvt4_fp8(f.x, f.y, f.z, f.w); }
        d8[q] = o;
      }
    } else if (grp == 2) {
      u32x4* d8 = (u32x4*)(p.V8 + (size_t)row * 512 + col);
#pragma unroll
      for (int q = 0; q < 4; ++q) {
        u32x4 o;
#pragma unroll
        for (int k = 0; k < 4; ++k) { float4 f = cv[4 * q + k]; o[k] = cvt4_fp8(f.x, f.y, f.z, f.w); }
        d8[q] = o;
      }
    } else if (grp == 3 || grp == 8) {
#pragma unroll
      for (int q = 0; q < 8; ++q) dp[q] = pack8(silu4(cv[2 * q]), silu4(cv[2 * q + 1]));
    } else {
#pragma unroll
      for (int q = 0; q < 8; ++q) dp[q] = pack8(cv[2 * q], cv[2 * q + 1]);
    }
  } else {
    if (half == 0) {
      float mu = 0.f;
#pragma unroll
      for (int q = 0; q < 16; ++q) { float4 f = cv[q]; mu += f.x + f.y + f.z + f.w; }
      mu *= (1.f / 64.f);
      float var = 0.f;
#pragma unroll
      for (int q = 0; q < 16; ++q) {
        float4 f = cv[q];
        var += (f.x - mu) * (f.x - mu) + (f.y - mu) * (f.y - mu) + (f.z - mu) * (f.z - mu) + (f.w - mu) * (f.w - mu);
      }
      float rs = rsqrtf(var * (1.f / 64.f) + 1e-6f);
      const float4* kw = (const float4*)p.ikw;
      const float4* kb = (const float4*)p.ikb;
      u32x4* dp = (u32x4*)(p.IK + (size_t)row * 64);
#pragma unroll
      for (int q = 0; q < 8; ++q) {
        float4 a = cv[2 * q], c = cv[2 * q + 1], wa = kw[2 * q], wc = kw[2 * q + 1], ba = kb[2 * q], bc = kb[2 * q + 1];
        a = make_float4((a.x - mu) * rs * wa.x + ba.x, (a.y - mu) * rs * wa.y + ba.y, (a.z - mu) * rs * wa.z + ba.z, (a.w - mu) * rs * wa.w + ba.w);
        c = make_float4((c.x - mu) * rs * wc.x + bc.x, (c.y - mu) * rs * wc.y + bc.y, (c.z - mu) * rs * wc.z + bc.z, (c.w - mu) * rs * wc.w + bc.w);
        dp[q] = pack8(a, c);
      }
    } else {
      const float* v = (const float*)cv;
#pragma unroll
      for (int c = 0; c < 8; ++c) p.IW[(size_t)row * 8 + c] = v[c] * 0.044194173824159216f;
#pragma unroll
      for (int c = 0; c < 4; ++c) {
        p.BETA[(size_t)row * 4 + c] = 1.f / (1.f + expf(-v[8 + c]));
        float xx = v[12 + c] + p.dtb[c];
        float sp = xx > 20.f ? xx : log1pf(expf(xx));
        p.G[(size_t)row * 4 + c] = -expf(p.alog[c]) * sp;
      }
    }
  }
}

DI void inproj_tile(const Params& p, int tile, char* smem) {
  const int mt = tile / 37, nt = tile % 37;
  const int m0 = mt * 128, n0 = nt * 128;
  f32x16 acc[2][2];
  gemm_tile(p.XB, p.Wt, m0, n0, 1024, smem, acc);
  const float4* cv = (const float4*)stage_rows(acc, smem);
  const int t = threadIdx.x;
  inproj_epilogue(p, m0 + (t & 127), nt, t >> 7, cv);
}

DI void inproj_tile256(const Params& p, int tile, char* smem) {
  const int mt = tile / 19, n2 = tile % 19;
  const int m0 = mt * 128, n0 = n2 * 256;
  ush* As = (ush*)smem;
  ush* Bs = As + 128 * 72;
  int t_ = threadIdx.x;
  asm volatile("" : "+v"(t_));
  const int t = t_, lane = t & 63, w = t >> 6, wm = w >> 1, wn = w & 1, r = lane & 31, h = lane >> 5;
  f32x16 acc[2][4];
#pragma unroll
  for (int i = 0; i < 2; ++i)
#pragma unroll
    for (int j = 0; j < 4; ++j) acc[i][j] = zero16();
  u32x4 ra[4], rb[8];
  const int lrow = t >> 3, lkc = t & 7;
  const unsigned voff = (unsigned)(lrow * 1024 + lkc * 8) * 2u;
  const char* abase = (const char*)(p.XB + (size_t)m0 * 1024);
  const char* bbase = (const char*)(p.Wt + (size_t)n0 * 1024);
#pragma unroll
  for (int i = 0; i < 4; ++i) ra[i] = *(const u32x4*)(abase + (size_t)i * 65536 + voff);
#pragma unroll
  for (int i = 0; i < 8; ++i) rb[i] = *(const u32x4*)(bbase + (size_t)i * 65536 + voff);
  for (int k0 = 0; k0 < 1024; k0 += 64) {
    __syncthreads();
#pragma unroll
    for (int i = 0; i < 4; ++i) *(u32x4*)(As + (lrow + 32 * i) * 72 + lkc * 8) = ra[i];
#pragma unroll
    for (int i = 0; i < 8; ++i) *(u32x4*)(Bs + (lrow + 32 * i) * 72 + lkc * 8) = rb[i];
    __syncthreads();
    {
      const int kn = k0 + 64 < 1024 ? k0 + 64 : k0;
#pragma unroll
      for (int i = 0; i < 4; ++i) ra[i] = *(const u32x4*)(abase + ((size_t)i * 65536 + (size_t)kn * 2) + voff);
#pragma unroll
      for (int i = 0; i < 8; ++i) rb[i] = *(const u32x4*)(bbase + ((size_t)i * 65536 + (size_t)kn * 2) + voff);
    }
#pragma unroll
    for (int s = 0; s < 4; ++s) {
      bf16x8 af[2], bfr[4];
#pragma unroll
      for (int i = 0; i < 2; ++i) af[i] = *(const bf16x8*)(As + (wm * 64 + i * 32 + r) * 72 + s * 16 + h * 8);
#pragma unroll
      for (int j = 0; j < 4; ++j) bfr[j] = *(const bf16x8*)(Bs + (wn * 128 + j * 32 + r) * 72 + s * 16 + h * 8);
#pragma unroll
      for (int i = 0; i < 2; ++i)
#pragma unroll
        for (int j = 0; j < 4; ++j) acc[i][j] = MFMA32(af[i], bfr[j], acc[i][j]);
    }
  }
  __syncthreads();
  const int nt = __builtin_amdgcn_readfirstlane(2 * n2 + wn);
  if (nt < 37) {
    float* Cw = (float*)smem + w * 4384;
#pragma unroll
    for (int jp = 0; jp < 2; ++jp) {
#pragma unroll
      for (int i = 0; i < 2; ++i)
#pragma unroll
        for (int jj = 0; jj < 2; ++jj)
#pragma unroll
          for (int reg = 0; reg < 16; ++reg)
            Cw[(i * 32 + crow(reg, h)) * 68 + jj * 32 + r] = acc[i][2 * jp + jj][reg];
      inproj_epilogue(p, m0 + wm * 64 + lane, nt, jp, (const float4*)(Cw + lane * 68));
    }
  }
  __syncthreads();
}

DI void dn_prep_task(const Params& p, int task, char* smem) {
  int t_ = threadIdx.x;
  asm volatile("" : "+v"(t_));
  const int t = t_, lane = t & 63, w = t >> 6;
  const int h = task & 3, c = (task >> 2) & 127, b = task >> 9;
  const size_t ch = (size_t)(b * 4 + h) * 128 + c;
  const size_t row0 = (size_t)b * SEQL + c * 64;
  ush* Qs = (ush*)smem;
  ush* Ks = Qs + 64 * 136;
  ush* Vs = Ks + 64 * 136;
  float* As = (float*)(smem + 52224);
  float* gcs = (float*)(smem + 68608);
  float* bts = gcs + 64;
  float* ebg = bts + 64;
  float* ekd = ebg + 64;
  float* egc = ekd + 64;
  if (w == 0) {
    float g = p.G[(row0 + lane) * 4 + h];
#pragma unroll
    for (int o = 1; o < 64; o <<= 1) { float y = __shfl_up(g, o); if (lane >= o) g += y; }
    float bt = p.BETA[(row0 + lane) * 4 + h];
    float gl = __shfl(g, 63);
    gcs[lane] = g; bts[lane] = bt; ebg[lane] = bt * expf(g); ekd[lane] = expf(gl - g); egc[lane] = expf(g);
    if (lane == 63) p.GL[ch] = expf(g);
  }
  {
    float* cws = As;
    for (int e = t; e < 1536; e += 256) {
      int j = e / 384, rem = e - j * 384, X = rem >> 7, col = rem & 127;
      cws[e] = p.convw[(size_t)j * 1536 + X * 512 + h * 128 + col];
    }
  }
  __syncthreads();
  {
    const int i = t >> 2, cg = t & 3;
#pragma unroll 1
    for (int X = 0; X < 3; ++X) {
      const ush* src = X == 0 ? p.DQ : (X == 1 ? p.DK : p.DV);
      ush* dstS = X == 0 ? Qs : (X == 1 ? Ks : Vs);
      float y[32];
#pragma unroll
      for (int e = 0; e < 32; ++e) y[e] = 0.f;
#pragma unroll
      for (int j = 0; j < 4; ++j) {
        const int pos = c * 64 + i - 3 + j;
        const float vz = pos >= 0 ? 1.f : 0.f;
        const int posc = pos >= 0 ? pos : 0;
        {
          const u32x4* rp = (const u32x4*)(src + ((size_t)b * SEQL + posc) * 512 + h * 128 + cg * 32);
          const float4* wp = (const float4*)(As + (j * 3 + X) * 128 + cg * 32);
#pragma unroll
          for (int q = 0; q < 4; ++q) {
            u32x4 d = rp[q];
            float4 wa = wp[q * 2], wb = wp[q * 2 + 1];
            wa = scl4(wa, vz); wb = scl4(wb, vz);
            y[q * 8 + 0] += wa.x * bflo(d[0]); y[q * 8 + 1] += wa.y * bfhi(d[0]);
            y[q * 8 + 2] += wa.z * bflo(d[1]); y[q * 8 + 3] += wa.w * bfhi(d[1]);
            y[q * 8 + 4] += wb.x * bflo(d[2]); y[q * 8 + 5] += wb.y * bfhi(d[2]);
            y[q * 8 + 6] += wb.z * bflo(d[3]); y[q * 8 + 7] += wb.w * bfhi(d[3]);
          }
        }
      }
      float ss = 0.f;
#pragma unroll
      for (int e = 0; e < 32; ++e) { y[e] = silu_f(y[e]); ss += y[e] * y[e]; }
      float rs = 1.f;
      if (X < 2) {
        ss += __shfl_xor(ss, 1);
        ss += __shfl_xor(ss, 2);
        rs = rsqrtf(ss + 1e-6f);
        if (X == 0) rs *= 0.08838834764831845f;
      }
#pragma unroll
      for (int q = 0; q < 4; ++q) {
        u32x4 o;
        o[0] = pack2(y[q * 8 + 0] * rs, y[q * 8 + 1] * rs); o[1] = pack2(y[q * 8 + 2] * rs, y[q * 8 + 3] * rs);
        o[2] = pack2(y[q * 8 + 4] * rs, y[q * 8 + 5] * rs); o[3] = pack2(y[q * 8 + 6] * rs, y[q * 8 + 7] * rs);
        *(u32x4*)(dstS + i * 136 + cg * 32 + q * 8) = o;
      }
    }
  }
  __syncthreads();
  {
    const int ti = w >> 1, tj = w & 1, r = lane & 31, hh = lane >> 5;
    f32x16 skk = zero16(), sqk = zero16();
#pragma unroll
    for (int s = 0; s < 8; ++s) {
      bf16x8 ak = *(const bf16x8*)(Ks + (ti * 32 + r) * 136 + s * 16 + hh * 8);
      bf16x8 aq = *(const bf16x8*)(Qs + (ti * 32 + r) * 136 + s * 16 + hh * 8);
      bf16x8 bk = *(const bf16x8*)(Ks + (tj * 32 + r) * 136 + s * 16 + hh * 8);
      skk = MFMA32(ak, bk, skk);
      sqk = MFMA32(aq, bk, sqk);
    }
#pragma unroll
    for (int reg = 0; reg < 16; ++reg) {
      int ii = ti * 32 + crow(reg, hh), jj = tj * 32 + r;
      float dec = (jj <= ii) ? expf(gcs[ii] - gcs[jj]) : 0.f;
      As[ii * 64 + jj] = (jj < ii) ? bts[ii] * skk[reg] * dec : 0.f;
      p.INTRA[ch * 4096 + ii * 64 + jj] = f2bf(sqk[reg] * dec);
    }
  }
  __syncthreads();
  {
    float xs[64];
#pragma unroll
    for (int i = 0; i < 64; ++i) xs[i] = 0.f;
    const int col = t & 127;
    const bool isw = t >= 128;
#pragma unroll
    for (int i = 0; i < 64; ++i) {
      float a = isw ? ebg[i] * bf2f(Ks[i * 136 + col]) : bts[i] * bf2f(Vs[i * 136 + col]);
#pragma unroll
      for (int j4 = 0; j4 < (i + 3) / 4; ++j4) {
        float4 av = *(const float4*)(As + i * 64 + j4 * 4);
        a -= av.x * xs[j4 * 4 + 0];
        a -= av.y * xs[j4 * 4 + 1];
        a -= av.z * xs[j4 * 4 + 2];
        a -= av.w * xs[j4 * 4 + 3];
      }
      xs[i] = a;
    }
    if (!isw) {
#pragma unroll
      for (int q = 0; q < 8; ++q) {
        u32x4 o;
        o[0] = pack2(xs[q * 8 + 0], xs[q * 8 + 1]); o[1] = pack2(xs[q * 8 + 2], xs[q * 8 + 3]);
        o[2] = pack2(xs[q * 8 + 4], xs[q * 8 + 5]); o[3] = pack2(xs[q * 8 + 6], xs[q * 8 + 7]);
        *(u32x4*)(p.UT + ch * 8192 + col * 64 + q * 8) = o;
      }
    } else {
#pragma unroll
      for (int i = 0; i < 64; ++i) p.WG[ch * 8192 + i * 128 + col] = f2bf(xs[i]);
    }
  }
  {
    const int i = t >> 2, cg = t & 3;
    const float e = egc[i];
#pragma unroll
    for (int q = 0; q < 4; ++q) {
      u32x4 d = *(const u32x4*)(Qs + i * 136 + cg * 32 + q * 8);
      u32x4 o;
#pragma unroll
      for (int k = 0; k < 4; ++k) o[k] = pack2(bflo(d[k]) * e, bfhi(d[k]) * e);
      *(u32x4*)(p.QG + ch * 8192 + i * 128 + cg * 32 + q * 8) = o;
    }
    const int d_ = t & 127, ih = t >> 7;
#pragma unroll
    for (int q = 0; q < 4; ++q) {
      float vv[8];
#pragma unroll
      for (int k = 0; k < 8; ++k) { int ii = ih * 32 + q * 8 + k; vv[k] = bf2f(Ks[ii * 136 + d_]) * ekd[ii]; }
      u32x4 o;
      o[0] = pack2(vv[0], vv[1]); o[1] = pack2(vv[2], vv[3]); o[2] = pack2(vv[4], vv[5]); o[3] = pack2(vv[6], vv[7]);
      *(u32x4*)(p.KDT + ch * 8192 + d_ * 64 + ih * 32 + q * 8) = o;
    }
  }
  __syncthreads();
}

DI void dn_scan(const Params& p, int sw, char* smem) {
  int t_ = threadIdx.x;
  asm volatile("" : "+v"(t_));
  const int t = t_, lane = t & 63, w = t >> 6, r = lane & 31, hh = lane >> 5;
  const int bh = sw & 7, slice = sw >> 3;
  const int b = bh >> 2, h = bh & 3;
  ush* ST = (ush*)smem;
  ush* VNT = ST + 32 * 136;
  for (int i = t; i < 32 * 136 / 2; i += 256) ((unsigned*)ST)[i] = 0u;
  f32x16 S = zero16();
  const int wv = w & 1;
  const bool isP = w < 2;
  const ush* Abase = isP ? p.WG : p.QG;
  bf16x8 a32[8], kd[4], in4[4];
  u32x2 u4[4];
  bf16x8 na32[8], nkd[4], nin4[4];
  u32x2 nu4[4];
#pragma unroll
  for (int s = 0; s < 4; ++s) { in4[s] = (bf16x8){0,0,0,0,0,0,0,0}; nin4[s] = in4[s]; u4[s] = (u32x2){0u, 0u}; nu4[s] = u4[s]; }
  {
    const size_t ch = (size_t)bh * 128;
#pragma unroll
    for (int s = 0; s < 8; ++s) a32[s] = *(const bf16x8*)(Abase + ch * 8192 + (32 * wv + r) * 128 + s * 16 + hh * 8);
#pragma unroll
    for (int s = 0; s < 4; ++s) kd[s] = *(const bf16x8*)(p.KDT + ch * 8192 + (32 * w + r) * 64 + s * 16 + hh * 8);
    if (!isP) {
#pragma unroll
      for (int s = 0; s < 4; ++s) in4[s] = *(const bf16x8*)(p.INTRA + ch * 4096 + (32 * wv + r) * 64 + s * 16 + hh * 8);
    } else {
#pragma unroll
      for (int g = 0; g < 4; ++g) u4[g] = *(const u32x2*)(p.UT + ch * 8192 + (slice * 32 + r) * 64 + 32 * wv + 8 * g + 4 * hh);
    }
  }
  __syncthreads();
  for (int c = 0; c < 128; ++c) {
    {
      const size_t ch = (size_t)bh * 128 + (c + 1 < 128 ? c + 1 : 127);
#pragma unroll
      for (int s = 0; s < 8; ++s) na32[s] = *(const bf16x8*)(Abase + ch * 8192 + (32 * wv + r) * 128 + s * 16 + hh * 8);
#pragma unroll
      for (int s = 0; s < 4; ++s) nkd[s] = *(const bf16x8*)(p.KDT + ch * 8192 + (32 * w + r) * 64 + s * 16 + hh * 8);
      if (!isP) {
#pragma unroll
        for (int s = 0; s < 4; ++s) nin4[s] = *(const bf16x8*)(p.INTRA + ch * 4096 + (32 * wv + r) * 64 + s * 16 + hh * 8);
      } else {
#pragma unroll
        for (int g = 0; g < 4; ++g) nu4[g] = *(const u32x2*)(p.UT + ch * 8192 + (slice * 32 + r) * 64 + 32 * wv + 8 * g + 4 * hh);
      }
    }
    const float gl = p.GL[bh * 128 + c];
    f32x16 acc = zero16();
#pragma unroll
    for (int s = 0; s < 8; ++s) {
      bf16x8 bS = *(const bf16x8*)(ST + r * 136 + s * 16 + hh * 8);
      acc = MFMA32(a32[s], bS, acc);
    }
    if (isP) {
#pragma unroll
      for (int g = 0; g < 4; ++g) {
        float v0 = bflo(u4[g][0]) - acc[4 * g + 0], v1 = bfhi(u4[g][0]) - acc[4 * g + 1];
        float v2 = bflo(u4[g][1]) - acc[4 * g + 2], v3 = bfhi(u4[g][1]) - acc[4 * g + 3];
        u32x2 o; o[0] = pack2(v0, v1); o[1] = pack2(v2, v3);
        *(u32x2*)(VNT + r * 72 + 32 * wv + 8 * g + 4 * hh) = o;
      }
    }
    __syncthreads();
    bf16x8 bV[4];
#pragma unroll
    for (int s = 0; s < 4; ++s) bV[s] = *(const bf16x8*)(VNT + r * 72 + s * 16 + hh * 8);
    if (!isP) {
#pragma unroll
      for (int s = 0; s < 4; ++s) acc = MFMA32(in4[s], bV[s], acc);
      float* od = p.OD + ((size_t)b * SEQL + c * 64 + 32 * wv) * 512 + h * 128 + slice * 32 + r;
#pragma unroll
      for (int reg = 0; reg < 16; ++reg) od[(size_t)crow(reg, hh) * 512] = acc[reg];
    }
#pragma unroll
    for (int i = 0; i < 16; ++i) S[i] *= gl;
#pragma unroll
    for (int s = 0; s < 4; ++s) S = MFMA32(kd[s], bV[s], S);
#pragma unroll
    for (int g = 0; g < 4; ++g) {
      u32x2 o; o[0] = pack2(S[4 * g + 0], S[4 * g + 1]); o[1] = pack2(S[4 * g + 2], S[4 * g + 3]);
      *(u32x2*)(ST + r * 136 + 32 * w + 8 * g + 4 * hh) = o;
    }
    __syncthreads();
#pragma unroll
    for (int s = 0; s < 8; ++s) a32[s] = na32[s];
#pragma unroll
    for (int s = 0; s < 4; ++s) { kd[s] = nkd[s]; in4[s] = nin4[s]; u4[s] = nu4[s]; }
  }
}

DI float relu_i(float x) { int v = __float_as_int(x); return __int_as_float(v > 0 ? v : 0); }
DI unsigned ukey(float f) { unsigned u = __float_as_uint(f); return (u & 0x80000000u) ? ~u : (u | 0x80000000u); }

template <int CTRL> DI unsigned dppmov_u(unsigned x) {
  return (unsigned)__builtin_amdgcn_update_dpp(0, (int)x, CTRL, 0xF, 0xF, true);
}
DI unsigned wave_max_u32(unsigned v) {
  unsigned y;
  y = dppmov_u<0xB1>(v); v = v > y ? v : y;
  y = dppmov_u<0x4E>(v); v = v > y ? v : y;
  y = dppmov_u<0x141>(v); v = v > y ? v : y;
  y = dppmov_u<0x140>(v); v = v > y ? v : y;
  const unsigned a = (unsigned)__builtin_amdgcn_readlane((int)v, 0), b = (unsigned)__builtin_amdgcn_readlane((int)v, 16);
  const unsigned c = (unsigned)__builtin_amdgcn_readlane((int)v, 32), d = (unsigned)__builtin_amdgcn_readlane((int)v, 48);
  const unsigned ab = a > b ? a : b, cd = c > d ? c : d;
  return ab > cd ? ab : cd;
}
DI unsigned wave_min_u32(unsigned v) {
  unsigned y;
  y = dppmov_u<0xB1>(v); v = v < y ? v : y;
  y = dppmov_u<0x4E>(v); v = v < y ? v : y;
  y = dppmov_u<0x141>(v); v = v < y ? v : y;
  y = dppmov_u<0x140>(v); v = v < y ? v : y;
  const unsigned a = (unsigned)__builtin_amdgcn_readlane((int)v, 0), b = (unsigned)__builtin_amdgcn_readlane((int)v, 16);
  const unsigned c = (unsigned)__builtin_amdgcn_readlane((int)v, 32), d = (unsigned)__builtin_amdgcn_readlane((int)v, 48);
  const unsigned ab = a < b ? a : b, cd = c < d ? c : d;
  return ab < cd ? ab : cd;
}
DI unsigned inv_ukey(unsigned k) { return (k & 0x80000000u) ? (k & 0x7fffffffu) : ~k; }
DI void compact16(unsigned* bk, unsigned* bi, int& cnt, float& th_out, int lane) {
  const int n = cnt;
  unsigned k[8], ix[8], raw[8];
  unsigned kmx = 0u, kmn = 0xffffffffu;
#pragma unroll
  for (int q = 0; q < 8; ++q) {
    int e = lane + 64 * q; raw[q] = bk[e]; ix[q] = bi[e];
    const unsigned kk = ukey(__uint_as_float(raw[q]));
    const bool v = e < n;
    k[q] = v ? kk : 0u;
    kmx = (v && kk > kmx) ? kk : kmx;
    kmn = (v && kk < kmn) ? kk : kmn;
  }
  kmx = wave_max_u32(kmx); kmn = wave_min_u32(kmn);
  const unsigned diff = kmx ^ kmn;
  unsigned P = kmn;
  if (diff) {
    const int top = 31 - __builtin_clz(diff);
    P = kmx & ~((2u << top) - 1u);
#pragma unroll 1
    for (int bit = top; bit >= 0; --bit) {
      const unsigned tk = P | (1u << bit);
      int c = 0;
#pragma unroll
      for (int q = 0; q < 8; ++q) c += __popcll(__builtin_amdgcn_ballot_w64(k[q] >= tk));
      if (c >= 256) { P = tk; if (c <= 320) break; }
    }
  }
  int base = 0;
#pragma unroll
  for (int q = 0; q < 8; ++q) {
    const bool keep = k[q] >= P && k[q] != 0u;
    unsigned long long m = __builtin_amdgcn_ballot_w64(keep);
    int pre = base + (int)mbcnt64(m);
    if (keep) { bk[pre] = raw[q]; bi[pre] = ix[q]; }
    base += __popcll(m);
  }
  cnt = base;
  th_out = __uint_as_float(inv_ukey(P));
}

DI int final_select(unsigned* bk, unsigned* bi, int cnt, int lane) {
  if (cnt <= 256) return cnt;
  unsigned k[8], ix[8];
  unsigned kmx = 0u, kmn = 0xffffffffu;
#pragma unroll
  for (int q = 0; q < 8; ++q) {
    int e = lane + 64 * q; unsigned kk = ukey(__uint_as_float(bk[e])); ix[q] = bi[e];
    const bool v = e < cnt;
    k[q] = v ? kk : 0u;
    kmx = (v && kk > kmx) ? kk : kmx;
    kmn = (v && kk < kmn) ? kk : kmn;
  }
  kmx = wave_max_u32(kmx); kmn = wave_min_u32(kmn);
  const unsigned diff = kmx ^ kmn;
  unsigned P = kmn;
  if (diff) {
    const int top = 31 - __builtin_clz(diff);
    P = kmx & ~((2u << top) - 1u);
#pragma unroll 1
    for (int bit = top; bit >= 0; --bit) {
      const unsigned tk = P | (1u << bit);
      int c = 0;
#pragma unroll
      for (int q = 0; q < 8; ++q) c += __popcll(__ballot(k[q] >= tk));
      if (c >= 256) { P = tk; if (c == 256) break; }
    }
  }
  int cge = 0, cgt = 0;
#pragma unroll
  for (int q = 0; q < 8; ++q) { cge += __popcll(__ballot(k[q] >= P)); cgt += __popcll(__ballot(k[q] > P)); }
  const bool cut = (cge == 256);
  const int need = 256 - cgt;
  int base = 0, eqseen = 0;
#pragma unroll
  for (int q = 0; q < 8; ++q) {
    bool gt = k[q] > P, eq = k[q] == P, ge = k[q] >= P;
    unsigned long long me = __ballot(eq);
    int epre = eqseen + (int)mbcnt64(me);
    bool keep = cut ? ge : (gt || (eq && epre < need));
    unsigned long long m = __ballot(keep);
    int pre = base + (int)mbcnt64(m);
    if (keep) bi[pre] = ix[q];
    base += __popcll(m);
    eqseen += __popcll(me);
  }
  return base;
}

#define MFMA8(a, b, c) __builtin_amdgcn_mfma_f32_16x16x32_fp8_fp8((a), (b), (c), 0, 0, 0)
typedef __attribute__((ext_vector_type(4))) float f32x4v;
typedef __attribute__((ext_vector_type(2))) float f32x2v;
DI int pidx(int h, int key) { return h * 256 + (key ^ ((h & 1) << 5)); }
DI long mk64(unsigned lo, unsigned hi) { return (long)(((unsigned long long)hi << 32) | lo); }

DI void sparse_attn_query(const Params& p, size_t rowb, size_t row, const unsigned* sel, int nsel, float* pbuf, int lane) {
  const int m16 = lane & 15, kg = lane >> 4;
  long afr[16];
  {
    unsigned alo0, alo1, ahi0, ahi1;
    {
      const u32x4 qa = *(const u32x4*)(p.QA + row * 512 + (m16 & 7) * 64 + kg * 16);
      const u32x4 qb = *(const u32x4*)(p.QA + row * 512 + (m16 & 7) * 64 + kg * 16 + 8);
      alo0 = cvt4_fp8(bflo(qa[0]), bfhi(qa[0]), bflo(qa[1]), bfhi(qa[1]));
      alo1 = cvt4_fp8(bflo(qa[2]), bfhi(qa[2]), bflo(qa[3]), bfhi(qa[3]));
      ahi0 = cvt4_fp8(bflo(qb[0]), bfhi(qb[0]), bflo(qb[1]), bfhi(qb[1]));
      ahi1 = cvt4_fp8(bflo(qb[2]), bfhi(qb[2]), bflo(qb[3]), bfhi(qb[3]));
    }
#pragma unroll
    for (int s = 0; s < 16; ++s) {
      const bool on = (m16 == (s >> 1));
      afr[s] = mk64(on ? ((s & 1) ? ahi0 : alo0) : 0u, on ? ((s & 1) ? ahi1 : alo1) : 0u);
    }
  }
  const int ntile = (nsel + 15) >> 4;
  u32x4 bc[8], bn[8], bnn[8];
  {
    const int j = m16 < nsel ? m16 : nsel - 1;
    const unsigned char* kb = p.K8 + (rowb + sel[j]) * 512 + kg * 16;
#pragma unroll
    for (int h = 0; h < 8; ++h) { bc[h] = *(const u32x4*)(kb + h * 64); bn[h] = bc[h]; bnn[h] = bc[h]; }
    {
      const int kn = 16 + m16;
      const int j1 = kn < nsel ? kn : nsel - 1;
      const unsigned char* kb1 = p.K8 + (rowb + sel[j1]) * 512 + kg * 16;
#pragma unroll
      for (int h = 0; h < 8; ++h) bn[h] = *(const u32x4*)(kb1 + h * 64);
    }
  }
#pragma unroll 1
  for (int T = 0; T < ntile; ++T) {
    {
      const int kn = (T + 2) * 16 + m16;
      const int j = kn < nsel ? kn : nsel - 1;
      const unsigned char* kb = p.K8 + (rowb + sel[j]) * 512 + kg * 16;
#pragma unroll
      for (int h = 0; h < 8; ++h) bnn[h] = *(const u32x4*)(kb + h * 64);
    }
    f32x4v acc0 = {0.f, 0.f, 0.f, 0.f}, acc1 = {0.f, 0.f, 0.f, 0.f};
#pragma unroll
    for (int h = 0; h < 8; ++h) {
      acc0 = MFMA8(afr[2 * h], mk64(bc[h][0], bc[h][1]), acc0);
      acc1 = MFMA8(afr[2 * h + 1], mk64(bc[h][2], bc[h][3]), acc1);
    }
    const int key = T * 16 + m16;
    if (kg < 2) {
      const bool ok = key < nsel;
#pragma unroll
      for (int i = 0; i < 4; ++i) pbuf[pidx(4 * kg + i, key)] = ok ? (acc0[i] + acc1[i]) * 0.125f : -1e30f;
    }
#pragma unroll
    for (int h = 0; h < 8; ++h) { bc[h] = bn[h]; bn[h] = bnn[h]; }
  }
  for (int T = ntile; T < 16; ++T) {
    if (kg < 2) {
#pragma unroll
      for (int i = 0; i < 4; ++i) pbuf[pidx(4 * kg + i, T * 16 + m16)] = -1e30f;
    }
  }
  const int hl = lane >> 3, l8 = lane & 7;
  float inv;
  {
    float4 lg[8];
    float mx = -1e30f;
#pragma unroll
    for (int j = 0; j < 8; ++j) {
      lg[j] = *(const float4*)(pbuf + pidx(hl, 32 * j + 4 * l8));
      mx = fmaxf(mx, fmaxf(fmaxf(lg[j].x, lg[j].y), fmaxf(lg[j].z, lg[j].w)));
    }
    mx = fmaxf(mx, dppmov<0xB1>(mx));
    mx = fmaxf(mx, dppmov<0x4E>(mx));
    mx = fmaxf(mx, dppmov<0x141>(mx));
    float sum = 0.f;
#pragma unroll
    for (int j = 0; j < 8; ++j) {
      lg[j].x = __expf(lg[j].x - mx); lg[j].y = __expf(lg[j].y - mx); lg[j].z = __expf(lg[j].z - mx); lg[j].w = __expf(lg[j].w - mx);
      sum += (lg[j].x + lg[j].y) + (lg[j].z + lg[j].w);
      *(float4*)(pbuf + pidx(hl, 32 * j + 4 * l8)) = lg[j];
    }
    sum = red8(sum);
    inv = 1.f / sum;
  }
  const int kpar = lane >> 5, l5 = lane & 31, h16 = l5 >> 2;
  f32x2v o2[8];
#pragma unroll
  for (int e = 0; e < 8; ++e) o2[e] = (f32x2v){0.f, 0.f};
  const int nstep = (nsel + 15) >> 4;
  const unsigned char* vbase = p.V8 + rowb * 512 + l5 * 16;
  u32x4 vc[8], vn[8], vnn[8];
#define LOADV16(dst, J0)                                                            \
  {                                                                                 \
    _Pragma("unroll") for (int g = 0; g < 4; ++g) {                                 \
      const uint4 i4 = *(const uint4*)(sel + (J0) + 4 * g);                         \
      const unsigned ia = kpar ? i4.y : i4.x, ib = kpar ? i4.w : i4.z;              \
      const unsigned ida = ((J0) + 4 * g + kpar < nsel) ? ia : sel[0];              \
      const unsigned idb = ((J0) + 4 * g + 2 + kpar < nsel) ? ib : sel[0];          \
      dst[2 * g] = *(const u32x4*)(vbase + (size_t)ida * 512);                      \
      dst[2 * g + 1] = *(const u32x4*)(vbase + (size_t)idb * 512);                  \
    }                                                                               \
  }
  LOADV16(vc, 0);
#pragma unroll
  for (int e = 0; e < 8; ++e) { vn[e] = vc[e]; vnn[e] = vc[e]; }
  LOADV16(vn, 16);
#pragma unroll 1
  for (int st = 0; st < nstep; ++st) {
    { const int j0 = (st + 2) * 16; LOADV16(vnn, j0); }
#pragma unroll
    for (int e = 0; e < 8; ++e) {
      const float pj = pbuf[pidx(h16, st * 16 + 2 * e + kpar)];
      const f32x2v pp = {pj, pj};
      const u32x4 v = vc[e];
#pragma unroll
      for (int k = 0; k < 4; ++k) {
        o2[2 * k] = __builtin_elementwise_fma(__builtin_amdgcn_cvt_pk_f32_fp8((int)v[k], false), pp, o2[2 * k]);
        o2[2 * k + 1] = __builtin_elementwise_fma(__builtin_amdgcn_cvt_pk_f32_fp8((int)v[k], true), pp, o2[2 * k + 1]);
      }
    }
#pragma unroll
    for (int e = 0; e < 8; ++e) { vc[e] = vn[e]; vn[e] = vnn[e]; }
  }
#undef LOADV16
  float o[16];
#pragma unroll
  for (int e = 0; e < 8; ++e) { o[2 * e] = o2[e].x; o[2 * e + 1] = o2[e].y; }
#pragma unroll
  for (int e = 0; e < 16; ++e) o[e] += __shfl_xor(o[e], 32);
  const float invh = __shfl(inv, h16 * 8);
  if (kpar == 0) {
    const u32x4 ga0 = *(const u32x4*)(p.GA + row * 512 + l5 * 16);
    const u32x4 ga1 = *(const u32x4*)(p.GA + row * 512 + l5 * 16 + 8);
    u32x4 ov0, ov1;
#pragma unroll
    for (int k = 0; k < 4; ++k) {
      ov0[k] = pack2(o[2 * k] * invh * bflo(ga0[k]), o[2 * k + 1] * invh * bfhi(ga0[k]));
      ov1[k] = pack2(o[8 + 2 * k] * invh * bflo(ga1[k]), o[8 + 2 * k + 1] * invh * bfhi(ga1[k]));
    }
    *(u32x4*)(p.MIX + row * 1024 + l5 * 16) = ov0;
    *(u32x4*)(p.MIX + row * 1024 + l5 * 16 + 8) = ov1;
  }
}

DI void attn_task(const Params& p, int task, char* smem, int qsel = 0) {
  int t_ = threadIdx.x;
  asm volatile("" : "+v"(t_));
  const int t = t_, lane = t & 63, w = t >> 6, r = lane & 31, hh = lane >> 5;
  const int b = task & 1, s16 = 511 - (task >> 1);
  const int tq0 = s16 * 16 + 4 * w;
  const size_t rowb = (size_t)b * SEQL;
  unsigned* bkey = (unsigned*)smem + w * 4096;
  unsigned* bidx = bkey + 2048;
  const int ql = 2 * ((r >> 2) & 1) + (r >> 4), hd = (r & 3) + 4 * ((r >> 3) & 1);
  bf16x8 aq[4];
#pragma unroll
  for (int s = 0; s < 4; ++s) aq[s] = *(const bf16x8*)(p.IQ + (rowb + tq0 + ql) * 512 + hd * 64 + s * 16 + hh * 8);
  float w0[8], w1[8];
#pragma unroll
  for (int i = 0; i < 8; ++i) {
    w0[i] = p.IW[(rowb + tq0 + 2 * hh) * 8 + i];
    w1[i] = p.IW[(rowb + tq0 + 2 * hh + 1) * 8 + i];
  }
  const int tqa = tq0 + 2 * hh, tqb = tqa + 1;
  float tha = -__builtin_inff(), thb = -__builtin_inff();
  int cnt0 = 0, cnt1 = 0, cnt2 = 0, cnt3 = 0;
  const int ntile = ((s16 * 16 + 15) >> 5) + 1;
  const int offa = hh ? 1024 : 0, offb = hh ? 1536 : 512;
  auto tile_body = [&](const f32x16& acc, int kt) -> bool {
    float sa = 0.f, sb = 0.f;
#pragma unroll
    for (int i = 0; i < 8; ++i) {
      sa = fmaf(w0[i], relu_i(acc[i]), sa);
      sb = fmaf(w1[i], relu_i(acc[8 + i]), sb);
    }
    const int key = kt * 32 + r;
    const bool pa = (key <= tqa) & (sa >= tha);
    const bool pb = (key <= tqb) & (sb >= thb);
    {
      const unsigned long long m = __builtin_amdgcn_ballot_w64(pa);
      const int nlo = __popc((unsigned)m), nhi = __popc((unsigned)(m >> 32));
      const int pos = (int)mbcnt64(m) + (hh ? cnt2 - nlo : cnt0);
      if (pa && pos < 512) { bkey[offa + pos] = __float_as_uint(sa); bidx[offa + pos] = (unsigned)key; }
      cnt0 += nlo; cnt2 += nhi;
    }
    {
      const unsigned long long m = __builtin_amdgcn_ballot_w64(pb);
      const int nlo = __popc((unsigned)m), nhi = __popc((unsigned)(m >> 32));
      const int pos = (int)mbcnt64(m) + (hh ? cnt3 - nlo : cnt1);
      if (pb && pos < 512) { bkey[offb + pos] = __float_as_uint(sb); bidx[offb + pos] = (unsigned)key; }
      cnt1 += nlo; cnt3 += nhi;
    }
    return (cnt0 > 448) | (cnt1 > 448) | (cnt2 > 448) | (cnt3 > 448);
  };
  {
    ush* tile = (ush*)(smem + 65536);
    __shared__ int s_need[2];
    const int lkey = t >> 3, lch = t & 7;
    const ush* gsrc = p.IK + (rowb + lkey) * 64 + lch * 8;
    const int npair = (ntile + 1) >> 1;
    const int lp = npair - 1;
    u32x4 g0 = *(const u32x4*)(gsrc), g1 = *(const u32x4*)(gsrc + 2048);
    if (t < 2) s_need[t] = 0;
    for (int kp = 0; kp < npair; ++kp) {
      __syncthreads();
      const int need = kp > 0 ? s_need[(kp - 1) & 1] : 0;
      *(u32x4*)(tile + lkey * 72 + lch * 8) = g0;
      *(u32x4*)(tile + (lkey + 32) * 72 + lch * 8) = g1;
      __syncthreads();
      if (t == 0 && kp > 0) s_need[(kp - 1) & 1] = 0;
      {
        const int pn = kp + 1 < lp ? kp + 1 : lp;
        g0 = *(const u32x4*)(gsrc + (size_t)pn * 4096);
        g1 = *(const u32x4*)(gsrc + (size_t)pn * 4096 + 2048);
      }
      if (need) {
        if (cnt0 > 320) { float th; compact16(bkey, bidx, cnt0, th, lane); if (hh == 0) tha = th; }
        if (cnt1 > 320) { float th; compact16(bkey + 512, bidx + 512, cnt1, th, lane); if (hh == 0) thb = th; }
        if (cnt2 > 320) { float th; compact16(bkey + 1024, bidx + 1024, cnt2, th, lane); if (hh == 1) tha = th; }
        if (cnt3 > 320) { float th; compact16(bkey + 1536, bidx + 1536, cnt3, th, lane); if (hh == 1) thb = th; }
      }
      bf16x8 bta[4], btb[4];
#pragma unroll
      for (int s = 0; s < 4; ++s) {
        bta[s] = *(const bf16x8*)(tile + r * 72 + s * 16 + hh * 8);
        btb[s] = *(const bf16x8*)(tile + (32 + r) * 72 + s * 16 + hh * 8);
      }
      f32x16 acca = zero16(), accb = zero16();
#pragma unroll
      for (int s = 0; s < 4; ++s) { acca = MFMA32(aq[s], bta[s], acca); accb = MFMA32(aq[s], btb[s], accb); }
      bool nd = tile_body(acca, 2 * kp);
      if (2 * kp + 1 < ntile) nd |= tile_body(accb, 2 * kp + 1);
      if (nd && lane == 0) s_need[kp & 1] = 1;
    }
    __syncthreads();
  }
  const bool lo = qsel != 2, hi = qsel != 1;
  int nsel_q[4] = {0, 0, 0, 0};
  {
    int c0 = cnt0 > 512 ? 512 : cnt0, c1 = cnt1 > 512 ? 512 : cnt1, c2 = cnt2 > 512 ? 512 : cnt2, c3 = cnt3 > 512 ? 512 : cnt3;
    if (lo) {
      nsel_q[0] = final_select(bkey, bidx, c0, lane);
      nsel_q[1] = final_select(bkey + 512, bidx + 512, c1, lane);
    }
    if (hi) {
      nsel_q[2] = final_select(bkey + 1024, bidx + 1024, c2, lane);
      nsel_q[3] = final_select(bkey + 1536, bidx + 1536, c3, lane);
    }
  }
  float* pbuf = (float*)bkey;
#pragma unroll
  for (int q = 0; q < 4; ++q) {
    if (q < 2 ? lo : hi) sparse_attn_query(p, rowb, rowb + tq0 + q, bidx + q * 512, nsel_q[q], pbuf, lane);
  }
}

DI void dn_norm(const Params& p, int wave, int nw, int lane) {
  const float4* nwp = (const float4*)(p.dnw + (lane & 15) * 8);
  const float4 n0 = nwp[0], n1 = nwp[1];
  for (int row0 = wave; row0 < NTOK; row0 += 4 * nw) {
    float4 a[4], c[4];
    u32x4 z[4];
#pragma unroll
    for (int j = 0; j < 4; ++j) {
      const int row = row0 + j * nw;
      const float4* op = (const float4*)(p.OD + (size_t)row * 512 + lane * 8);
      a[j] = op[0]; c[j] = op[1];
      z[j] = *(const u32x4*)(p.SZ + (size_t)row * 512 + lane * 8);
    }
#pragma unroll
    for (int j = 0; j < 4; ++j) {
      const int row = row0 + j * nw;
      float ss = a[j].x * a[j].x + a[j].y * a[j].y + a[j].z * a[j].z + a[j].w * a[j].w + c[j].x * c[j].x + c[j].y * c[j].y + c[j].z * c[j].z + c[j].w * c[j].w;
      ss += __shfl_xor(ss, 1); ss += __shfl_xor(ss, 2); ss += __shfl_xor(ss, 4); ss += __shfl_xor(ss, 8);
      const float rs = rsqrtf(ss * (1.f / 128.f) + 1e-6f);
      u32x4 o;
      o[0] = pack2(a[j].x * rs * n0.x * bflo(z[j][0]), a[j].y * rs * n0.y * bfhi(z[j][0]));
      o[1] = pack2(a[j].z * rs * n0.z * bflo(z[j][1]), a[j].w * rs * n0.w * bfhi(z[j][1]));
      o[2] = pack2(c[j].x * rs * n1.x * bflo(z[j][2]), c[j].y * rs * n1.y * bfhi(z[j][2]));
      o[3] = pack2(c[j].z * rs * n1.z * bflo(z[j][3]), c[j].w * rs * n1.w * bfhi(z[j][3]));
      *(u32x4*)(p.MIX + (size_t)row * 1024 + 512 + lane * 8) = o;
    }
  }
}

DI void dn_norm_rows(const Params& p, int row_base, int lane) {
  const float4* nwp = (const float4*)(p.dnw + (lane & 15) * 8);
  const float4 n0 = nwp[0], n1 = nwp[1];
#pragma unroll 1
  for (int r4 = 0; r4 < 16; r4 += 4) {
    float4 a[4], c[4];
    u32x4 z[4];
#pragma unroll
    for (int j = 0; j < 4; ++j) {
      const int row = row_base + r4 + j;
      const float4* op = (const float4*)(p.OD + (size_t)row * 512 + lane * 8);
      a[j] = op[0]; c[j] = op[1];
      z[j] = *(const u32x4*)(p.SZ + (size_t)row * 512 + lane * 8);
    }
#pragma unroll
    for (int j = 0; j < 4; ++j) {
      const int row = row_base + r4 + j;
      float ss = a[j].x * a[j].x + a[j].y * a[j].y + a[j].z * a[j].z + a[j].w * a[j].w + c[j].x * c[j].x + c[j].y * c[j].y + c[j].z * c[j].z + c[j].w * c[j].w;
      ss += __shfl_xor(ss, 1); ss += __shfl_xor(ss, 2); ss += __shfl_xor(ss, 4); ss += __shfl_xor(ss, 8);
      const float rs = rsqrtf(ss * (1.f / 128.f) + 1e-6f);
      u32x4 o;
      o[0] = pack2(a[j].x * rs * n0.x * bflo(z[j][0]), a[j].y * rs * n0.y * bfhi(z[j][0]));
      o[1] = pack2(a[j].z * rs * n0.z * bflo(z[j][1]), a[j].w * rs * n0.w * bfhi(z[j][1]));
      o[2] = pack2(c[j].x * rs * n1.x * bflo(z[j][2]), c[j].y * rs * n1.y * bfhi(z[j][2]));
      o[3] = pack2(c[j].z * rs * n1.z * bflo(z[j][3]), c[j].w * rs * n1.w * bfhi(z[j][3]));
      *(u32x4*)(p.MIX + (size_t)row * 1024 + 512 + lane * 8) = o;
    }
  }
}

DI void outproj_tile(const Params& p, int tile, char* smem) {
  const int mt = tile >> 3, nt = tile & 7;
  const int m0 = mt * 128, n0 = nt * 128;
  f32x16 acc[2][2];
  gemm_tile(p.MIX, p.Wo, m0, n0, 1024, smem, acc);
  (void)stage_rows(acc, smem);
  int t_ = threadIdx.x;
  asm volatile("" : "+v"(t_));
  const int t = t_, c4 = t & 31, r0 = t >> 5;
  const float* Cs = (const float*)smem;
#pragma unroll 4
  for (int ps = 0; ps < 16; ++ps) {
    const int rr = ps * 8 + r0;
    const float4 f = *(const float4*)(Cs + rr * 132 + c4 * 4);
    const size_t off = (size_t)(m0 + rr) * 1024 + n0 + c4 * 4;
    const float4 xv = *(const float4*)(p.x + off);
    *(float4*)(p.out + off) = make_float4(xv.x + f.x, xv.y + f.y, xv.z + f.z, xv.w + f.w);
  }
}

#define XB_TMO      128
#define XB_XCNT(j)  (256  + 64 * (j))
#define XB_XSUB(j)  (1280 + 64 * (j))
#define XB_XGEN(j)  (2304 + 64 * (j))
#define XB_TOP      3328
#define XB_TOPGEN   3392
#define XCD_BAR_WORDS 3456
#define XB_SPIN_CAP (1u << 20)
#define LAS __attribute__((address_space(3)))
DI unsigned xb_ld(unsigned* p) { return __hip_atomic_load(p, __ATOMIC_RELAXED, __HIP_MEMORY_SCOPE_AGENT); }
DI unsigned xb_add(unsigned* p, unsigned v) { return __hip_atomic_fetch_add(p, v, __ATOMIC_RELAXED, __HIP_MEMORY_SCOPE_AGENT); }
DI unsigned xb_xcc_id() { return (unsigned)__builtin_amdgcn_s_getreg((3 << 11) | 20) & 0xFu; }
#define XB_SPIN(cond, bar) do { unsigned _sp = 0; while (cond) { __builtin_amdgcn_s_sleep(1); \
    if ((++_sp & 255u) == 0u) { if (xb_ld(&(bar)[XB_TMO])) break; if (_sp > XB_SPIN_CAP) { atomicAdd(&(bar)[XB_TMO], 1u); break; } } } } while (0)
struct XcdBarrier { unsigned* bar; unsigned x; volatile LAS unsigned* st; };
DI XcdBarrier xcd_barrier_post(unsigned* bar, volatile LAS unsigned* st) {
  XcdBarrier b; b.bar = bar; b.x = xb_xcc_id(); b.st = st;
  if (threadIdx.x == 0) (void)xb_add(&bar[XB_XCNT(b.x)], 1u);
  return b;
}
DI void xcd_barrier_complete(unsigned* bar, unsigned x, unsigned& nloc, unsigned& nx) {
  const unsigned G = gridDim.x * gridDim.y * gridDim.z;
  unsigned sum, cnt, mine, sp = 0u;
  for (;;) {
    sum = 0u; cnt = 0u; mine = 0u;
#pragma unroll
    for (unsigned j = 0; j < 16; ++j) { const unsigned c = xb_ld(&bar[XB_XCNT(j)]); sum += c; cnt += (c > 0u) ? 1u : 0u; mine = (j == x) ? c : mine; }
    if (sum == G) break;
    __builtin_amdgcn_s_sleep(1);
    if ((++sp & 255u) == 0u) { if (xb_ld(&bar[XB_TMO])) break; if (sp > XB_SPIN_CAP) { atomicAdd(&bar[XB_TMO], 1u); break; } }
  }
  nloc = mine > 0u ? mine : 1u; nx = cnt > 0u ? cnt : 1u;
}
DI void xcd_barrier(const XcdBarrier& b) {
  asm volatile("s_waitcnt vmcnt(0)" ::: "memory");
  __syncthreads();
  if (threadIdx.x == 0) {
    unsigned* bar = b.bar;
    __builtin_amdgcn_s_waitcnt(0);
    unsigned nloc = b.st[0], nx = b.st[1];
    if (nloc == 0u) { xcd_barrier_complete(bar, b.x, nloc, nx); b.st[0] = nloc; b.st[1] = nx; }
    const unsigned old = xb_add(&bar[XB_XSUB(b.x)], 1u);
    const unsigned gen = old / nloc;
    if (old + 1u == (gen + 1u) * nloc) {
      __builtin_amdgcn_fence(__ATOMIC_RELEASE, "agent");
      asm volatile("s_waitcnt vmcnt(0)" ::: "memory");
      const unsigned og = xb_add(&bar[XB_TOP], 1u);
      const unsigned tg = og / nx;
      if (og + 1u == (tg + 1u) * nx) xb_add(&bar[XB_TOPGEN], 1u);
      else XB_SPIN(xb_ld(&bar[XB_TOPGEN]) == tg, bar);
      __builtin_amdgcn_fence(__ATOMIC_ACQUIRE, "agent");
      xb_add(&bar[XB_XGEN(b.x)], 1u);
      asm volatile("s_waitcnt vmcnt(0)" ::: "memory");
    } else {
      XB_SPIN(xb_ld(&bar[XB_XGEN(b.x)]) == gen, bar);
      __builtin_amdgcn_fence(__ATOMIC_ACQUIRE, "agent");
      asm volatile("s_waitcnt vmcnt(0)" ::: "memory");
    }
  }
  __syncthreads();
}

__global__ void __launch_bounds__(256, 2) k_prep(Params p) {
  __shared__ __attribute__((aligned(16))) char smem[SMEM_BYTES];
  phase_prep(p, blockIdx.x * 256 + threadIdx.x, gridDim.x * 256, smem);
}
__global__ void __launch_bounds__(256, 2) k_inproj(Params p) {
  __shared__ __attribute__((aligned(16))) char smem[SMEM_BYTES];
  for (int tile = blockIdx.x; tile < 128 * 37; tile += gridDim.x) inproj_tile(p, tile, smem);
}
__global__ void __launch_bounds__(256, 2) k_dnprep(Params p) {
  __shared__ __attribute__((aligned(16))) char smem[SMEM_BYTES];
  for (int task = blockIdx.x; task < 1024; task += gridDim.x) dn_prep_task(p, task, smem);
}
__global__ void __launch_bounds__(256, 2) k_scan(Params p) {
  __shared__ __attribute__((aligned(16))) char smem[SMEM_BYTES];
  dn_scan(p, blockIdx.x, smem);
}
__global__ void __launch_bounds__(256, 2) k_attn(Params p) {
  __shared__ __attribute__((aligned(16))) char smem[SMEM_BYTES];
  for (int task = blockIdx.x; task < 1024; task += gridDim.x) attn_task(p, task, smem);
}
__global__ void __launch_bounds__(256, 2) k_dnnorm(Params p) {
  dn_norm(p, (blockIdx.x * 256 + threadIdx.x) >> 6, (gridDim.x * 256) >> 6, threadIdx.x & 63);
}
__global__ void __launch_bounds__(256, 2) k_outproj(Params p) {
  __shared__ __attribute__((aligned(16))) char smem[SMEM_BYTES];
  for (int tile = blockIdx.x; tile < 1024; tile += gridDim.x) outproj_tile(p, tile, smem);
}

__global__ void __launch_bounds__(256, 2) k_mega(Params p) {
  __shared__ __attribute__((aligned(16))) char smem[SMEM_BYTES];
  __shared__ uint4 xb_words;
  __shared__ int s_task;
  cg::grid_group grid = cg::this_grid();
  if (threadIdx.x == 0) xb_words = make_uint4(0u, 0u, 0u, 0u);
  __syncthreads();
  XcdBarrier xb = xcd_barrier_post(p.counters + 64, (volatile LAS unsigned*)&xb_words);
  const int gtid = blockIdx.x * 256 + threadIdx.x, gsize = gridDim.x * 256;
  phase_prep(p, gtid, gsize, smem);
  if (p.use_cg_sync) grid.sync();
  xcd_barrier(xb);
  for (int tile = blockIdx.x; tile < 128 * 19; tile += gridDim.x) inproj_tile256(p, tile, smem);
  xcd_barrier(xb);
  for (int task = blockIdx.x; task < 1024; task += gridDim.x) dn_prep_task(p, task, smem);
  xcd_barrier(xb);
  if (blockIdx.x < 32) {
    __builtin_amdgcn_s_setprio(3);
    dn_scan(p, blockIdx.x, smem);
    __builtin_amdgcn_s_setprio(0);
    asm volatile("s_waitcnt vmcnt(0)" ::: "memory");
    __syncthreads();
    if (threadIdx.x == 0) {
      __builtin_amdgcn_fence(__ATOMIC_RELEASE, "agent");
      asm volatile("s_waitcnt vmcnt(0)" ::: "memory");
      atomicAdd(&p.counters[32], 1u);
    }
    __syncthreads();
  }
  {
    int pb = (int)((xb.x >> 2) & 1u);
    int tries = 0;
    while (tries < 2) {
      if (threadIdx.x == 0) s_task = (int)atomicAdd(&p.counters[pb], 1u);
      __syncthreads();
      const int tk = s_task;
      __syncthreads();
      if (tk >= 512 + QSPLIT) { pb ^= 1; ++tries; continue; }
      if (tk < 512 - QSPLIT) attn_task(p, tk * 2 + pb, smem, 0);
      else { const int j = tk - (512 - QSPLIT); attn_task(p, ((512 - QSPLIT) + (j >> 1)) * 2 + pb, smem, 1 + (j & 1)); }
    }
  }
  {
    if (threadIdx.x == 0) {
      unsigned sp = 0;
      while (__hip_atomic_load(&p.counters[32], __ATOMIC_RELAXED, __HIP_MEMORY_SCOPE_AGENT) < 32u) {
        __builtin_amdgcn_s_sleep(4);
        if (++sp > (1u << 22)) break;
      }
      __builtin_amdgcn_fence(__ATOMIC_ACQUIRE, "agent");
      asm volatile("s_waitcnt vmcnt(0)" ::: "memory");
    }
    __syncthreads();
    while (true) {
      if (threadIdx.x == 0) s_task = (int)atomicAdd(&p.counters[33], 1u);
      __syncthreads();
      const int ck = s_task;
      __syncthreads();
      if (ck >= 256) break;
      int tn_ = threadIdx.x;
      asm volatile("" : "+v"(tn_));
      dn_norm_rows(p, ck * 64 + (tn_ >> 6) * 16, tn_ & 63);
    }
  }
  xcd_barrier(xb);
  for (int tile = blockIdx.x; tile < 1024; tile += gridDim.x) outproj_tile(p, tile, smem);
}

extern "C" void kernel_launch(void* const* d_in, const int* in_sizes, int n_in, void* d_out, int out_size, void* d_ws,
                              size_t ws_size, hipStream_t stream) {
  Params p{};
  p.x = (const float*)d_in[0]; p.ln_w = (const float*)d_in[1]; p.w_in = (const float*)d_in[2];
  p.aqw = (const float*)d_in[3]; p.akw = (const float*)d_in[4]; p.ikw = (const float*)d_in[5];
  p.ikb = (const float*)d_in[6]; p.convw = (const float*)d_in[7]; p.alog = (const float*)d_in[8];
  p.dtb = (const float*)d_in[9]; p.dnw = (const float*)d_in[10]; p.w_out = (const float*)d_in[11];
  p.out = (float*)d_out;
  char* ws = (char*)d_ws;
  const size_t MB = 1u << 20;
  p.Wt = (ush*)(ws + 0);
  p.Wo = (ush*)(ws + 10 * MB);
  p.XB = (ush*)(ws + 12 * MB);
  p.MIX = (ush*)(ws + 12 * MB);
  p.QA = (ush*)(ws + 45 * MB); p.KA = (ush*)(ws + 61 * MB); p.VA = (ush*)(ws + 77 * MB);
  p.GA = (ush*)(ws + 93 * MB); p.IQ = (ush*)(ws + 109 * MB); p.DQ = (ush*)(ws + 125 * MB);
  p.DK = (ush*)(ws + 141 * MB); p.DV = (ush*)(ws + 157 * MB); p.SZ = (ush*)(ws + 173 * MB);
  p.IK = (ush*)(ws + 189 * MB);
  p.IW = (float*)(ws + 191 * MB);
  p.BETA = (float*)(ws + 191 * MB + 512 * 1024);
  p.G = (float*)(ws + 191 * MB + 768 * 1024);
  p.INTRA = (ush*)(ws + 192 * MB);
  p.GL = (float*)(ws + 200 * MB);
  p.OD = (float*)(ws + 201 * MB);
  p.counters = (unsigned*)(ws + 233 * MB);
  p.K8 = (unsigned char*)(ws + 61 * MB);
  p.V8 = (unsigned char*)(ws + 77 * MB);
  char* o8 = (char*)d_out;
  p.UT = (ush*)(o8); p.WG = (ush*)(o8 + 16 * MB); p.QG = (ush*)(o8 + 32 * MB); p.KDT = (ush*)(o8 + 48 * MB);

#if MEGA
  static int grid_blocks = 0;
  if (!grid_blocks) {
    int dev = 0, cus = 0, per_cu = 0;
    hipGetDevice(&dev);
    hipDeviceGetAttribute(&cus, hipDeviceAttributeMultiprocessorCount, dev);
    hipOccupancyMaxActiveBlocksPerMultiprocessor(&per_cu, k_mega, 256, 0);
    if (per_cu > 2) per_cu = 2;
    grid_blocks = cus * per_cu;
  }
  hipMemsetAsync(p.counters, 0, (64 + XCD_BAR_WORDS) * sizeof(unsigned), stream);
  void* args[] = {&p};
  hipError_t e = hipLaunchCooperativeKernel((void*)k_mega, dim3(grid_blocks), dim3(256), args, 0, stream);
  if (e != hipSuccess) fprintf(stderr, "cooperative launch failed: %s (grid %d)\n", hipGetErrorString(e), grid_blocks);
#else
  k_prep<<<1024, 256, 0, stream>>>(p);
  k_inproj<<<128 * 37, 256, 0, stream>>>(p);
  k_dnprep<<<1024, 256, 0, stream>>>(p);
  k_scan<<<32, 256, 0, stream>>>(p);
  k_attn<<<1024, 256, 0, stream>>>(p);
  k_dnnorm<<<1024, 256, 0, stream>>>(p);
  k_outproj<<<1024, 256, 0, stream>>>(p);
#endif
}
```

```cpp
#include <hip/hip_runtime.h>
#include <hip/hip_cooperative_groups.h>
#include <cstdio>
#include <cstdint>
namespace cg = cooperative_groups;

#ifndef MEGA
#define MEGA 1
#endif

#define DI __device__ __forceinline__
typedef __attribute__((ext_vector_type(8))) short bf16x8;
typedef __attribute__((ext_vector_type(16))) float f32x16;
typedef __attribute__((ext_vector_type(4))) unsigned u32x4;
typedef __attribute__((ext_vector_type(2))) unsigned u32x2;
typedef __attribute__((ext_vector_type(2))) __bf16 bf2_t;
typedef unsigned short ush;
#define MFMA32(a, b, c) __builtin_amdgcn_mfma_f32_32x32x16_bf16((a), (b), (c), 0, 0, 0)

constexpr int NTOK = 16384;
constexpr int SEQL = 8192;
constexpr int NP = 4736;
constexpr int DIN = 4688;
constexpr int SMEM_BYTES = 74752;
constexpr int QSPLIT = 48;

struct Params {
  const float *x, *ln_w, *w_in, *aqw, *akw, *ikw, *ikb, *convw, *alog, *dtb, *dnw, *w_out;
  float* out;
  ush *Wt, *Wo, *XB, *MIX, *QA, *KA, *VA, *GA, *IQ, *DQ, *DK, *DV, *SZ, *IK, *INTRA;
  ush *UT, *WG, *QG, *KDT;
  float *IW, *BETA, *G, *GL, *OD;
  unsigned* counters;
  unsigned char *K8, *V8;
  int use_cg_sync, pad0;
};

DI ush f2bf(float x) { return __builtin_bit_cast(ush, (__bf16)x); }
DI float bf2f(ush b) { return __uint_as_float(((unsigned)b) << 16); }
DI unsigned pack2(float a, float b) { bf2_t v = {(__bf16)a, (__bf16)b}; return __builtin_bit_cast(unsigned, v); }
DI float bflo(unsigned u) { return __uint_as_float(u << 16); }
DI float bfhi(unsigned u) { return __uint_as_float(u & 0xffff0000u); }
DI int crow(int reg, int h) { return (reg & 3) + 8 * (reg >> 2) + 4 * h; }
DI float silu_f(float v) { return v / (1.f + __expf(-v)); }
DI f32x16 zero16() { f32x16 z; for (int i = 0; i < 16; ++i) z[i] = 0.f; return z; }

template <int CTRL> DI float dppmov(float x) {
  return __int_as_float(__builtin_amdgcn_update_dpp(0, __float_as_int(x), CTRL, 0xF, 0xF, true));
}
DI float red8(float d) {
  d += dppmov<0xB1>(d);
  d += dppmov<0x4E>(d);
  d += dppmov<0x141>(d);
  return d;
}
DI unsigned mbcnt64(unsigned long long m) {
  return __builtin_amdgcn_mbcnt_hi((unsigned)(m >> 32), __builtin_amdgcn_mbcnt_lo((unsigned)m, 0u));
}
DI int mapcol(int n) {
  if (n < 2560) return n;
  if (n < 4608) return n + 72;
  if (n < 4680) return n - 2048;
  if (n < 4688) return n;
  return -1;
}

DI void phase_prep(const Params& p, int gtid, int gsize, char* smem) {
  {
    unsigned* Ts = (unsigned*)smem;
    ush* Th = (ush*)smem;
    int t_ = threadIdx.x;
    asm volatile("" : "+v"(t_));
    const int t = t_;
    for (int tt = blockIdx.x; tt < 1472; tt += gridDim.x) {
      const bool is_in = tt < 1216;
      const int id = is_in ? tt : tt - 1216;
      const int nt = is_in ? id % 76 : (id & 15), kt = is_in ? id / 76 : (id >> 4);
      const float* src = is_in ? p.w_in : p.w_out;
      const int ld = is_in ? DIN : 1024;
      ush* dst = is_in ? p.Wt : p.Wo;
      {
        const int n = t & 63, ks = t >> 6;
        const int oc = is_in ? mapcol(nt * 64 + n) : nt * 64 + n;
#pragma unroll
        for (int it = 0; it < 16; ++it) {
          int k = it * 4 + ks;
          float v = oc >= 0 ? src[(size_t)(kt * 64 + k) * ld + oc] : 0.f;
          Th[n * 66 + k] = f2bf(v);
        }
      }
      __syncthreads();
      {
        const int n = t >> 2, kq = t & 3;
        u32x4 a, b;
#pragma unroll
        for (int i = 0; i < 4; ++i) { a[i] = Ts[n * 33 + kq * 8 + i]; b[i] = Ts[n * 33 + kq * 8 + 4 + i]; }
        u32x4* dp = (u32x4*)(dst + (size_t)(nt * 64 + n) * 1024 + kt * 64 + kq * 16);
        dp[0] = a; dp[1] = b;
      }
      __syncthreads();
    }
  }
  int wave = gtid >> 6, lane = gtid & 63, nw = gsize >> 6;
  for (int row = wave; row < NTOK; row += nw) {
    const float4* xr = (const float4*)(p.x + (size_t)row * 1024);
    float4 a[4];
    float ss = 0.f;
#pragma unroll
    for (int i = 0; i < 4; ++i) {
      a[i] = xr[lane + 64 * i];
      ss += a[i].x * a[i].x + a[i].y * a[i].y + a[i].z * a[i].z + a[i].w * a[i].w;
    }
#pragma unroll
    for (int o = 1; o < 64; o <<= 1) ss += __shfl_xor(ss, o);
    float rs = rsqrtf(ss * (1.f / 1024.f) + 1e-6f);
#pragma unroll
    for (int i = 0; i < 4; ++i) {
      float4 lw = ((const float4*)p.ln_w)[lane + 64 * i];
      u32x2 o;
      o[0] = pack2(a[i].x * rs * lw.x, a[i].y * rs * lw.y);
      o[1] = pack2(a[i].z * rs * lw.z, a[i].w * rs * lw.w);
      *(u32x2*)(p.XB + (size_t)row * 1024 + (lane + 64 * i) * 4) = o;
    }
  }
}

DI void gemm_tile(const ush* __restrict__ A, const ush* __restrict__ B, int m0, int n0, int K, char* smem,
                  f32x16 (&acc)[2][2]) {
  ush* As = (ush*)smem;
  ush* Bs = As + 128 * 72;
  int t_ = threadIdx.x;
  asm volatile("" : "+v"(t_));
  const int t = t_, lane = t & 63, w = t >> 6, wm = w >> 1, wn = w & 1, r = lane & 31, h = lane >> 5;
  u32x4 ra[4], rb[4];
#pragma unroll
  for (int i = 0; i < 2; ++i)
#pragma unroll
    for (int j = 0; j < 2; ++j) acc[i][j] = zero16();
#pragma unroll
  for (int i = 0; i < 4; ++i) {
    int c = t + 256 * i, row = c >> 3, kc = c & 7;
    ra[i] = *(const u32x4*)(A + (size_t)(m0 + row) * K + kc * 8);
    rb[i] = *(const u32x4*)(B + (size_t)(n0 + row) * K + kc * 8);
  }
  for (int k0 = 0; k0 < K; k0 += 64) {
    __syncthreads();
#pragma unroll
    for (int i = 0; i < 4; ++i) {
      int c = t + 256 * i, row = c >> 3, kc = c & 7;
      *(u32x4*)(As + row * 72 + kc * 8) = ra[i];
      *(u32x4*)(Bs + row * 72 + kc * 8) = rb[i];
    }
    __syncthreads();
    if (k0 + 64 < K) {
#pragma unroll
      for (int i = 0; i < 4; ++i) {
        int c = t + 256 * i, row = c >> 3, kc = c & 7;
        ra[i] = *(const u32x4*)(A + (size_t)(m0 + row) * K + k0 + 64 + kc * 8);
        rb[i] = *(const u32x4*)(B + (size_t)(n0 + row) * K + k0 + 64 + kc * 8);
      }
    }
#pragma unroll
    for (int s = 0; s < 4; ++s) {
      bf16x8 af[2], bfr[2];
#pragma unroll
      for (int i = 0; i < 2; ++i) af[i] = *(const bf16x8*)(As + (wm * 64 + i * 32 + r) * 72 + s * 16 + h * 8);
#pragma unroll
      for (int j = 0; j < 2; ++j) bfr[j] = *(const bf16x8*)(Bs + (wn * 64 + j * 32 + r) * 72 + s * 16 + h * 8);
#pragma unroll
      for (int i = 0; i < 2; ++i)
#pragma unroll
        for (int j = 0; j < 2; ++j) acc[i][j] = MFMA32(af[i], bfr[j], acc[i][j]);
    }
  }
  __syncthreads();
}

DI const float* stage_rows(f32x16 (&acc)[2][2], char* smem) {
  float* Cs = (float*)smem;
  int t_ = threadIdx.x;
  asm volatile("" : "+v"(t_));
  const int t = t_, lane = t & 63, w = t >> 6, wm = w >> 1, wn = w & 1, r = lane & 31, h = lane >> 5;
#pragma unroll
  for (int i = 0; i < 2; ++i)
#pragma unroll
    for (int j = 0; j < 2; ++j)
#pragma unroll
      for (int reg = 0; reg < 16; ++reg)
        Cs[(wm * 64 + i * 32 + crow(reg, h)) * 132 + wn * 64 + j * 32 + r] = acc[i][j][reg];
  __syncthreads();
  return Cs + (t & 127) * 132 + (t >> 7) * 64;
}
DI u32x4 pack8(float4 a, float4 b) {
  u32x4 o;
  o[0] = pack2(a.x, a.y); o[1] = pack2(a.z, a.w); o[2] = pack2(b.x, b.y); o[3] = pack2(b.z, b.w);
  return o;
}
DI float4 mul4(float4 a, float4 b) { return make_float4(a.x * b.x, a.y * b.y, a.z * b.z, a.w * b.w); }
DI float4 scl4(float4 a, float s) { return make_float4(a.x * s, a.y * s, a.z * s, a.w * s); }
DI unsigned cvt4_fp8(float a, float b, float c, float d) {
  int r = 0;
  r = __builtin_amdgcn_cvt_pk_fp8_f32(a, b, r, false);
  r = __builtin_amdgcn_cvt_pk_fp8_f32(c, d, r, true);
  return (unsigned)r;
}
DI float4 silu4(float4 a) { return make_float4(silu_f(a.x), silu_f(a.y), silu_f(a.z), silu_f(a.w)); }

DI void inproj_epilogue(const Params& p, int row, int nt, int half, const float4* cv) {
  if (nt < 36) {
    const int grp = nt >> 2;
    const int col = (nt & 3) * 128 + half * 64;
    ush* dst = (ush*)((char*)p.QA + (size_t)grp * (16u << 20));
    u32x4* dp = (u32x4*)(dst + (size_t)row * 512 + col);
    if (grp == 0) {
      float ss = 0.f;
#pragma unroll
      for (int q = 0; q < 16; ++q) { float4 f = cv[q]; ss += f.x * f.x + f.y * f.y + f.z * f.z + f.w * f.w; }
      const float rs = rsqrtf(ss * (1.f / 64.f) + 1e-6f);
      const float4* nw = (const float4*)p.aqw;
#pragma unroll
      for (int q = 0; q < 8; ++q)
        dp[q] = pack8(scl4(mul4(cv[2 * q], nw[2 * q]), rs), scl4(mul4(cv[2 * q + 1], nw[2 * q + 1]), rs));
    } else if (grp == 1) {
      float ss = 0.f;
#pragma unroll
      for (int q = 0; q < 16; ++q) { float4 f = cv[q]; ss += f.x * f.x + f.y * f.y + f.z * f.z + f.w * f.w; }
      const float rs = rsqrtf(ss * (1.f / 64.f) + 1e-6f);
      const float4* nw = (const float4*)p.akw;
      u32x4* d8 = (u32x4*)(p.K8 + (size_t)row * 512 + col);
#pragma unroll
      for (int q = 0; q < 4; ++q) {
        u32x4 o;
#pragma unroll
        for (int k = 0; k < 4; ++k) { float4 f = scl4(mul4(cv[4 * q + k], nw[4 * q + k]), rs); o[k] = cvt4_fp8(f.x, f.y, f.z, f.w); }
        d8[q] = o;
      }
    } else if (grp == 2) {
      u32x4* d8 = (u32x4*)(p.V8 + (size_t)row * 512 + col);
#pragma unroll
      for (int q = 0; q < 4; ++q) {
        u32x4 o;
#pragma unroll
        for (int k = 0; k < 4; ++k) { float4 f = cv[4 * q + k]; o[k] = cvt4_fp8(f.x, f.y, f.z, f.w); }
        d8[q] = o;
      }
    } else if (grp == 3 || grp == 8) {
#pragma unroll
      for (int q = 0; q < 8; ++q) dp[q] = pack8(silu4(cv[2 * q]), silu4(cv[2 * q + 1]));
    } else {
#pragma unroll
      for (int q = 0; q < 8; ++q) dp[q] = pack8(cv[2 * q], cv[2 * q + 1]);
    }
  } else {
    if (half == 0) {
      float mu = 0.f;
#pragma unroll
      for (int q = 0; q < 16; ++q) { float4 f = cv[q]; mu += f.x + f.y + f.z + f.w; }
      mu *= (1.f / 64.f);
      float var = 0.f;
#pragma unroll
      for (int q = 0; q < 16; ++q) {
        float4 f = cv[q];
        var += (f.x - mu) * (f.x - mu) + (f.y - mu) * (f.y - mu) + (f.z - mu) * (f.z - mu) + (f.w - mu) * (f.w - mu);
      }
      float rs = rsqrtf(var * (1.f / 64.f) + 1e-6f);
      const float4* kw = (const float4*)p.ikw;
      const float4* kb = (const float4*)p.ikb;
      u32x4* dp = (u32x4*)(p.IK + (size_t)row * 64);
#pragma unroll
      for (int q = 0; q < 8; ++q) {
        float4 a = cv[2 * q], c = cv[2 * q + 1], wa = kw[2 * q], wc = kw[2 * q + 1], ba = kb[2 * q], bc = kb[2 * q + 1];
        a = make_float4((a.x - mu) * rs * wa.x + ba.x, (a.y - mu) * rs * wa.y + ba.y, (a.z - mu) * rs * wa.z + ba.z, (a.w - mu) * rs * wa.w + ba.w);
        c = make_float4((c.x - mu) * rs * wc.x + bc.x, (c.y - mu) * rs * wc.y + bc.y, (c.z - mu) * rs * wc.z + bc.z, (c.w - mu) * rs * wc.w + bc.w);
        dp[q] = pack8(a, c);
      }
    } else {
      const float* v = (const float*)cv;
#pragma unroll
      for (int c = 0; c < 8; ++c) p.IW[(size_t)row * 8 + c] = v[c] * 0.044194173824159216f;
#pragma unroll
      for (int c = 0; c < 4; ++c) {
        p.BETA[(size_t)row * 4 + c] = 1.f / (1.f + expf(-v[8 + c]));
        float xx = v[12 + c] + p.dtb[c];
        float sp = xx > 20.f ? xx : log1pf(expf(xx));
        p.G[(size_t)row * 4 + c] = -expf(p.alog[c]) * sp;
      }
    }
  }
}

DI void inproj_tile(const Params& p, int tile, char* smem) {
  const int mt = tile / 37, nt = tile % 37;
  const int m0 = mt * 128, n0 = nt * 128;
  f32x16 acc[2][2];
  gemm_tile(p.XB, p.Wt, m0, n0, 1024, smem, acc);
  const float4* cv = (const float4*)stage_rows(acc, smem);
  const int t = threadIdx.x;
  inproj_epilogue(p, m0 + (t & 127), nt, t >> 7, cv);
}

template <int MODE> DI void gemm_tile256(const Params& p, int tile, char* smem) {
  const int mt = MODE == 0 ? tile / 19 : (tile >> 2), n2 = MODE == 0 ? tile % 19 : (tile & 3);
  const int m0 = mt * 128, n0 = n2 * 256;
  ush* As = (ush*)smem;
  ush* Bs = As + 128 * 72;
  int t_ = threadIdx.x;
  asm volatile("" : "+v"(t_));
  const int t = t_, lane = t & 63, w = t >> 6, wm = w >> 1, wn = w & 1, r = lane & 31, h = lane >> 5;
  f32x16 acc[2][4];
#pragma unroll
  for (int i = 0; i < 2; ++i)
#pragma unroll
    for (int j = 0; j < 4; ++j) acc[i][j] = zero16();
  u32x4 ra[4], rb[8];
  const int lrow = t >> 3, lkc = t & 7;
  const unsigned voff = (unsigned)(lrow * 1024 + lkc * 8) * 2u;
  const char* abase = (const char*)((MODE == 0 ? p.XB : p.MIX) + (size_t)m0 * 1024);
  const char* bbase = (const char*)((MODE == 0 ? p.Wt : p.Wo) + (size_t)n0 * 1024);
#pragma unroll
  for (int i = 0; i < 4; ++i) ra[i] = *(const u32x4*)(abase + (size_t)i * 65536 + voff);
#pragma unroll
  for (int i = 0; i < 8; ++i) rb[i] = *(const u32x4*)(bbase + (size_t)i * 65536 + voff);
  for (int k0 = 0; k0 < 1024; k0 += 64) {
    __syncthreads();
#pragma unroll
    for (int i = 0; i < 4; ++i) *(u32x4*)(As + (lrow + 32 * i) * 72 + lkc * 8) = ra[i];
#pragma unroll
    for (int i = 0; i < 8; ++i) *(u32x4*)(Bs + (lrow + 32 * i) * 72 + lkc * 8) = rb[i];
    __syncthreads();
    {
      const int kn = k0 + 64 < 1024 ? k0 + 64 : k0;
#pragma unroll
      for (int i = 0; i < 4; ++i) ra[i] = *(const u32x4*)(abase + ((size_t)i * 65536 + (size_t)kn * 2) + voff);
#pragma unroll
      for (int i = 0; i < 8; ++i) rb[i] = *(const u32x4*)(bbase + ((size_t)i * 65536 + (size_t)kn * 2) + voff);
    }
#pragma unroll
    for (int s = 0; s < 4; ++s) {
      bf16x8 af[2], bfr[4];
#pragma unroll
      for (int i = 0; i < 2; ++i) af[i] = *(const bf16x8*)(As + (wm * 64 + i * 32 + r) * 72 + s * 16 + h * 8);
#pragma unroll
      for (int j = 0; j < 4; ++j) bfr[j] = *(const bf16x8*)(Bs + (wn * 128 + j * 32 + r) * 72 + s * 16 + h * 8);
#pragma unroll
      for (int i = 0; i < 2; ++i)
#pragma unroll
        for (int j = 0; j < 4; ++j) acc[i][j] = MFMA32(af[i], bfr[j], acc[i][j]);
    }
  }
  __syncthreads();
  const int nt = __builtin_amdgcn_readfirstlane(2 * n2 + wn);
  if (MODE == 1 || nt < 37) {
    float* Cw = (float*)smem + w * 4384;
#pragma unroll
    for (int jp = 0; jp < 2; ++jp) {
#pragma unroll
      for (int i = 0; i < 2; ++i)
#pragma unroll
        for (int jj = 0; jj < 2; ++jj)
#pragma unroll
          for (int reg = 0; reg < 16; ++reg)
            Cw[(i * 32 + crow(reg, h)) * 68 + jj * 32 + r] = acc[i][2 * jp + jj][reg];
      if (MODE == 0) {
        inproj_epilogue(p, m0 + wm * 64 + lane, nt, jp, (const float4*)(Cw + lane * 68));
      } else {
        const int c4 = lane & 15, r4 = lane >> 4;
#pragma unroll 4
        for (int ps = 0; ps < 16; ++ps) {
          const int lr = ps * 4 + r4;
          const float4 f = *(const float4*)(Cw + lr * 68 + c4 * 4);
          const size_t off = (size_t)(m0 + wm * 64 + lr) * 1024 + n0 + wn * 128 + jp * 64 + c4 * 4;
          const float4 xv = *(const float4*)(p.x + off);
          *(float4*)(p.out + off) = make_float4(xv.x + f.x, xv.y + f.y, xv.z + f.z, xv.w + f.w);
        }
      }
    }
  }
  __syncthreads();
}

DI void dn_prep_task(const Params& p, int task, char* smem) {
  int t_ = threadIdx.x;
  asm volatile("" : "+v"(t_));
  const int t = t_, lane = t & 63, w = t >> 6;
  const int h = task & 3, c = (task >> 2) & 127, b = task >> 9;
  const size_t ch = (size_t)(b * 4 + h) * 128 + c;
  const size_t row0 = (size_t)b * SEQL + c * 64;
  ush* Qs = (ush*)smem;
  ush* Ks = Qs + 64 * 136;
  ush* Vs = Ks + 64 * 136;
  float* As = (float*)(smem + 52224);
  float* gcs = (float*)(smem + 68608);
  float* bts = gcs + 64;
  float* ebg = bts + 64;
  float* ekd = ebg + 64;
  float* egc = ekd + 64;
  if (w == 0) {
    float g = p.G[(row0 + lane) * 4 + h];
#pragma unroll
    for (int o = 1; o < 64; o <<= 1) { float y = __shfl_up(g, o); if (lane >= o) g += y; }
    float bt = p.BETA[(row0 + lane) * 4 + h];
    float gl = __shfl(g, 63);
    gcs[lane] = g; bts[lane] = bt; ebg[lane] = bt * expf(g); ekd[lane] = expf(gl - g); egc[lane] = expf(g);
    if (lane == 63) p.GL[ch] = expf(g);
  }
  {
    float* cws = As;
    for (int e = t; e < 1536; e += 256) {
      int j = e / 384, rem = e - j * 384, X = rem >> 7, col = rem & 127;
      cws[e] = p.convw[(size_t)j * 1536 + X * 512 + h * 128 + col];
    }
  }
  __syncthreads();
  {
    const int i = t >> 2, cg = t & 3;
#pragma unroll 1
    for (int X = 0; X < 3; ++X) {
      const ush* src = X == 0 ? p.DQ : (X == 1 ? p.DK : p.DV);
      ush* dstS = X == 0 ? Qs : (X == 1 ? Ks : Vs);
      float y[32];
#pragma unroll
      for (int e = 0; e < 32; ++e) y[e] = 0.f;
#pragma unroll
      for (int j = 0; j < 4; ++j) {
        const int pos = c * 64 + i - 3 + j;
        const float vz = pos >= 0 ? 1.f : 0.f;
        const int posc = pos >= 0 ? pos : 0;
        {
          const u32x4* rp = (const u32x4*)(src + ((size_t)b * SEQL + posc) * 512 + h * 128 + cg * 32);
          const float4* wp = (const float4*)(As + (j * 3 + X) * 128 + cg * 32);
#pragma unroll
          for (int q = 0; q < 4; ++q) {
            u32x4 d = rp[q];
            float4 wa = wp[q * 2], wb = wp[q * 2 + 1];
            wa = scl4(wa, vz); wb = scl4(wb, vz);
            y[q * 8 + 0] += wa.x * bflo(d[0]); y[q * 8 + 1] += wa.y * bfhi(d[0]);
            y[q * 8 + 2] += wa.z * bflo(d[1]); y[q * 8 + 3] += wa.w * bfhi(d[1]);
            y[q * 8 + 4] += wb.x * bflo(d[2]); y[q * 8 + 5] += wb.y * bfhi(d[2]);
            y[q * 8 + 6] += wb.z * bflo(d[3]); y[q * 8 + 7] += wb.w * bfhi(d[3]);
          }
        }
      }
      float ss = 0.f;
#pragma unroll
      for (int e = 0; e < 32; ++e) { y[e] = silu_f(y[e]); ss += y[e] * y[e]; }
      float rs = 1.f;
      if (X < 2) {
        ss += __shfl_xor(ss, 1);
        ss += __shfl_xor(ss, 2);
        rs = rsqrtf(ss + 1e-6f);
        if (X == 0) rs *= 0.08838834764831845f;
      }
#pragma unroll
      for (int q = 0; q < 4; ++q) {
        u32x4 o;
        o[0] = pack2(y[q * 8 + 0] * rs, y[q * 8 + 1] * rs); o[1] = pack2(y[q * 8 + 2] * rs, y[q * 8 + 3] * rs);
        o[2] = pack2(y[q * 8 + 4] * rs, y[q * 8 + 5] * rs); o[3] = pack2(y[q * 8 + 6] * rs, y[q * 8 + 7] * rs);
        *(u32x4*)(dstS + i * 136 + cg * 32 + q * 8) = o;
      }
    }
  }
  __syncthreads();
  {
    const int ti = w >> 1, tj = w & 1, r = lane & 31, hh = lane >> 5;
    f32x16 skk = zero16(), sqk = zero16();
#pragma unroll
    for (int s = 0; s < 8; ++s) {
      bf16x8 ak = *(const bf16x8*)(Ks + (ti * 32 + r) * 136 + s * 16 + hh * 8);
      bf16x8 aq = *(const bf16x8*)(Qs + (ti * 32 + r) * 136 + s * 16 + hh * 8);
      bf16x8 bk = *(const bf16x8*)(Ks + (tj * 32 + r) * 136 + s * 16 + hh * 8);
      skk = MFMA32(ak, bk, skk);
      sqk = MFMA32(aq, bk, sqk);
    }
#pragma unroll
    for (int reg = 0; reg < 16; ++reg) {
      int ii = ti * 32 + crow(reg, hh), jj = tj * 32 + r;
      float dec = (jj <= ii) ? expf(gcs[ii] - gcs[jj]) : 0.f;
      As[ii * 64 + jj] = (jj < ii) ? bts[ii] * skk[reg] * dec : 0.f;
      p.INTRA[ch * 4096 + ii * 64 + jj] = f2bf(sqk[reg] * dec);
    }
  }
  __syncthreads();
  {
    float xs[64];
#pragma unroll
    for (int i = 0; i < 64; ++i) xs[i] = 0.f;
    const int col = t & 127;
    const bool isw = t >= 128;
#pragma unroll
    for (int i = 0; i < 64; ++i) {
      float a = isw ? ebg[i] * bf2f(Ks[i * 136 + col]) : bts[i] * bf2f(Vs[i * 136 + col]);
#pragma unroll
      for (int j4 = 0; j4 < (i + 3) / 4; ++j4) {
        float4 av = *(const float4*)(As + i * 64 + j4 * 4);
        a -= av.x * xs[j4 * 4 + 0];
        a -= av.y * xs[j4 * 4 + 1];
        a -= av.z * xs[j4 * 4 + 2];
        a -= av.w * xs[j4 * 4 + 3];
      }
      xs[i] = a;
    }
    if (!isw) {
#pragma unroll
      for (int q = 0; q < 8; ++q) {
        u32x4 o;
        o[0] = pack2(xs[q * 8 + 0], xs[q * 8 + 1]); o[1] = pack2(xs[q * 8 + 2], xs[q * 8 + 3]);
        o[2] = pack2(xs[q * 8 + 4], xs[q * 8 + 5]); o[3] = pack2(xs[q * 8 + 6], xs[q * 8 + 7]);
        *(u32x4*)(p.UT + ch * 8192 + col * 64 + q * 8) = o;
      }
    } else {
#pragma unroll
      for (int i = 0; i < 64; ++i) p.WG[ch * 8192 + i * 128 + col] = f2bf(xs[i]);
    }
  }
  {
    const int i = t >> 2, cg = t & 3;
    const float e = egc[i];
#pragma unroll
    for (int q = 0; q < 4; ++q) {
      u32x4 d = *(const u32x4*)(Qs + i * 136 + cg * 32 + q * 8);
      u32x4 o;
#pragma unroll
      for (int k = 0; k < 4; ++k) o[k] = pack2(bflo(d[k]) * e, bfhi(d[k]) * e);
      *(u32x4*)(p.QG + ch * 8192 + i * 128 + cg * 32 + q * 8) = o;
    }
    const int d_ = t & 127, ih = t >> 7;
#pragma unroll
    for (int q = 0; q < 4; ++q) {
      float vv[8];
#pragma unroll
      for (int k = 0; k < 8; ++k) { int ii = ih * 32 + q * 8 + k; vv[k] = bf2f(Ks[ii * 136 + d_]) * ekd[ii]; }
      u32x4 o;
      o[0] = pack2(vv[0], vv[1]); o[1] = pack2(vv[2], vv[3]); o[2] = pack2(vv[4], vv[5]); o[3] = pack2(vv[6], vv[7]);
      *(u32x4*)(p.KDT + ch * 8192 + d_ * 64 + ih * 32 + q * 8) = o;
    }
  }
  __syncthreads();
}

DI void dn_scan(const Params& p, int sw, char* smem) {
  int t_ = threadIdx.x;
  asm volatile("" : "+v"(t_));
  const int t = t_, lane = t & 63, w = t >> 6, r = lane & 31, hh = lane >> 5;
  const int bh = sw & 7, slice = sw >> 3;
  const int b = bh >> 2, h = bh & 3;
  ush* ST = (ush*)smem;
  ush* VNT = ST + 32 * 136;
  for (int i = t; i < 32 * 136 / 2; i += 256) ((unsigned*)ST)[i] = 0u;
  f32x16 S = zero16();
  const int wv = w & 1;
  const bool isP = w < 2;
  const ush* Abase = isP ? p.WG : p.QG;
  bf16x8 a32[8], kd[4], in4[4];
  u32x2 u4[4];
  bf16x8 na32[8], nkd[4], nin4[4];
  u32x2 nu4[4];
#pragma unroll
  for (int s = 0; s < 4; ++s) { in4[s] = (bf16x8){0,0,0,0,0,0,0,0}; nin4[s] = in4[s]; u4[s] = (u32x2){0u, 0u}; nu4[s] = u4[s]; }
  {
    const size_t ch = (size_t)bh * 128;
#pragma unroll
    for (int s = 0; s < 8; ++s) a32[s] = *(const bf16x8*)(Abase + ch * 8192 + (32 * wv + r) * 128 + s * 16 + hh * 8);
#pragma unroll
    for (int s = 0; s < 4; ++s) kd[s] = *(const bf16x8*)(p.KDT + ch * 8192 + (32 * w + r) * 64 + s * 16 + hh * 8);
    if (!isP) {
#pragma unroll
      for (int s = 0; s < 4; ++s) in4[s] = *(const bf16x8*)(p.INTRA + ch * 4096 + (32 * wv + r) * 64 + s * 16 + hh * 8);
    } else {
#pragma unroll
      for (int g = 0; g < 4; ++g) u4[g] = *(const u32x2*)(p.UT + ch * 8192 + (slice * 32 + r) * 64 + 32 * wv + 8 * g + 4 * hh);
    }
  }
  __syncthreads();
  for (int c = 0; c < 128; ++c) {
    {
      const size_t ch = (size_t)bh * 128 + (c + 1 < 128 ? c + 1 : 127);
#pragma unroll
      for (int s = 0; s < 8; ++s) na32[s] = *(const bf16x8*)(Abase + ch * 8192 + (32 * wv + r) * 128 + s * 16 + hh * 8);
#pragma unroll
      for (int s = 0; s < 4; ++s) nkd[s] = *(const bf16x8*)(p.KDT + ch * 8192 + (32 * w + r) * 64 + s * 16 + hh * 8);
      if (!isP) {
#pragma unroll
        for (int s = 0; s < 4; ++s) nin4[s] = *(const bf16x8*)(p.INTRA + ch * 4096 + (32 * wv + r) * 64 + s * 16 + hh * 8);
      } else {
#pragma unroll
        for (int g = 0; g < 4; ++g) nu4[g] = *(const u32x2*)(p.UT + ch * 8192 + (slice * 32 + r) * 64 + 32 * wv + 8 * g + 4 * hh);
      }
    }
    const float gl = p.GL[bh * 128 + c];
    f32x16 acc = zero16();
#pragma unroll
    for (int s = 0; s < 8; ++s) {
      bf16x8 bS = *(const bf16x8*)(ST + r * 136 + s * 16 + hh * 8);
      acc = MFMA32(a32[s], bS, acc);
    }
    if (isP) {
#pragma unroll
      for (int g = 0; g < 4; ++g) {
        float v0 = bflo(u4[g][0]) - acc[4 * g + 0], v1 = bfhi(u4[g][0]) - acc[4 * g + 1];
        float v2 = bflo(u4[g][1]) - acc[4 * g + 2], v3 = bfhi(u4[g][1]) - acc[4 * g + 3];
        u32x2 o; o[0] = pack2(v0, v1); o[1] = pack2(v2, v3);
        *(u32x2*)(VNT + r * 72 + 32 * wv + 8 * g + 4 * hh) = o;
      }
    }
    __syncthreads();
    bf16x8 bV[4];
#pragma unroll
    for (int s = 0; s < 4; ++s) bV[s] = *(const bf16x8*)(VNT + r * 72 + s * 16 + hh * 8);
    if (!isP) {
#pragma unroll
      for (int s = 0; s < 4; ++s) acc = MFMA32(in4[s], bV[s], acc);
      float* od = p.OD + ((size_t)b * SEQL + c * 64 + 32 * wv) * 512 + h * 128 + slice * 32 + r;
#pragma unroll
      for (int reg = 0; reg < 16; ++reg) od[(size_t)crow(reg, hh) * 512] = acc[reg];
    }
#pragma unroll
    for (int i = 0; i < 16; ++i) S[i] *= gl;
#pragma unroll
    for (int s = 0; s < 4; ++s) S = MFMA32(kd[s], bV[s], S);
#pragma unroll
    for (int g = 0; g < 4; ++g) {
      u32x2 o; o[0] = pack2(S[4 * g + 0], S[4 * g + 1]); o[1] = pack2(S[4 * g + 2], S[4 * g + 3]);
      *(u32x2*)(ST + r * 136 + 32 * w + 8 * g + 4 * hh) = o;
    }
    __syncthreads();
#pragma unroll
    for (int s = 0; s < 8; ++s) a32[s] = na32[s];
#pragma unroll
    for (int s = 0; s < 4; ++s) { kd[s] = nkd[s]; in4[s] = nin4[s]; u4[s] = nu4[s]; }
  }
}

DI float relu_i(float x) { int v = __float_as_int(x); return __int_as_float(v > 0 ? v : 0); }
DI unsigned ukey(float f) { unsigned u = __float_as_uint(f); return (u & 0x80000000u) ? ~u : (u | 0x80000000u); }

template <int CTRL> DI unsigned dppmov_u(unsigned x) {
  return (unsigned)__builtin_amdgcn_update_dpp(0, (int)x, CTRL, 0xF, 0xF, true);
}
DI unsigned wave_max_u32(unsigned v) {
  unsigned y;
  y = dppmov_u<0xB1>(v); v = v > y ? v : y;
  y = dppmov_u<0x4E>(v); v = v > y ? v : y;
  y = dppmov_u<0x141>(v); v = v > y ? v : y;
  y = dppmov_u<0x140>(v); v = v > y ? v : y;
  const unsigned a = (unsigned)__builtin_amdgcn_readlane((int)v, 0), b = (unsigned)__builtin_amdgcn_readlane((int)v, 16);
  const unsigned c = (unsigned)__builtin_amdgcn_readlane((int)v, 32), d = (unsigned)__builtin_amdgcn_readlane((int)v, 48);
  const unsigned ab = a > b ? a : b, cd = c > d ? c : d;
  return ab > cd ? ab : cd;
}
DI unsigned wave_min_u32(unsigned v) {
  unsigned y;
  y = dppmov_u<0xB1>(v); v = v < y ? v : y;
  y = dppmov_u<0x4E>(v); v = v < y ? v : y;
  y = dppmov_u<0x141>(v); v = v < y ? v : y;
  y = dppmov_u<0x140>(v); v = v < y ? v : y;
  const unsigned a = (unsigned)__builtin_amdgcn_readlane((int)v, 0), b = (unsigned)__builtin_amdgcn_readlane((int)v, 16);
  const unsigned c = (unsigned)__builtin_amdgcn_readlane((int)v, 32), d = (unsigned)__builtin_amdgcn_readlane((int)v, 48);
  const unsigned ab = a < b ? a : b, cd = c < d ? c : d;
  return ab < cd ? ab : cd;
}
DI unsigned inv_ukey(unsigned k) { return (k & 0x80000000u) ? (k & 0x7fffffffu) : ~k; }
DI void compact16(unsigned* bk, unsigned* bi, int& cnt, float& th_out, int lane) {
  const int n = cnt;
  unsigned k[8], ix[8], raw[8];
  unsigned kmx = 0u, kmn = 0xffffffffu;
#pragma unroll
  for (int q = 0; q < 8; ++q) {
    int e = lane + 64 * q; raw[q] = bk[e]; ix[q] = bi[e];
    const unsigned kk = ukey(__uint_as_float(raw[q]));
    const bool v = e < n;
    k[q] = v ? kk : 0u;
    kmx = (v && kk > kmx) ? kk : kmx;
    kmn = (v && kk < kmn) ? kk : kmn;
  }
  kmx = wave_max_u32(kmx); kmn = wave_min_u32(kmn);
  const unsigned diff = kmx ^ kmn;
  unsigned P = kmn;
  if (diff) {
    const int top = 31 - __builtin_clz(diff);
    P = kmx & ~((2u << top) - 1u);
#pragma unroll 1
    for (int bit = top; bit >= 0; --bit) {
      const unsigned tk = P | (1u << bit);
      int c = 0;
#pragma unroll
      for (int q = 0; q < 8; ++q) c += __popcll(__builtin_amdgcn_ballot_w64(k[q] >= tk));
      if (c >= 256) { P = tk; if (c <= 320) break; }
    }
  }
  int base = 0;
#pragma unroll
  for (int q = 0; q < 8; ++q) {
    const bool keep = k[q] >= P && k[q] != 0u;
    unsigned long long m = __builtin_amdgcn_ballot_w64(keep);
    int pre = base + (int)mbcnt64(m);
    if (keep) { bk[pre] = raw[q]; bi[pre] = ix[q]; }
    base += __popcll(m);
  }
  cnt = base;
  th_out = __uint_as_float(inv_ukey(P));
}

DI int final_select(unsigned* bk, unsigned* bi, int cnt, int lane) {
  if (cnt <= 256) return cnt;
  unsigned k[8], ix[8];
  unsigned kmx = 0u, kmn = 0xffffffffu;
#pragma unroll
  for (int q = 0; q < 8; ++q) {
    int e = lane + 64 * q; unsigned kk = ukey(__uint_as_float(bk[e])); ix[q] = bi[e];
    const bool v = e < cnt;
    k[q] = v ? kk : 0u;
    kmx = (v && kk > kmx) ? kk : kmx;
    kmn = (v && kk < kmn) ? kk : kmn;
  }
  kmx = wave_max_u32(kmx); kmn = wave_min_u32(kmn);
  const unsigned diff = kmx ^ kmn;
  unsigned P = kmn;
  if (diff) {
    const int top = 31 - __builtin_clz(diff);
    P = kmx & ~((2u << top) - 1u);
#pragma unroll 1
    for (int bit = top; bit >= 0; --bit) {
      const unsigned tk = P | (1u << bit);
      int c = 0;
#pragma unroll
      for (int q = 0; q < 8; ++q) c += __popcll(__ballot(k[q] >= tk));
      if (c >= 256) { P = tk; if (c == 256) break; }
    }
  }
  int cge = 0, cgt = 0;
#pragma unroll
  for (int q = 0; q < 8; ++q) { cge += __popcll(__ballot(k[q] >= P)); cgt += __popcll(__ballot(k[q] > P)); }
  const bool cut = (cge == 256);
  const int need = 256 - cgt;
  int base = 0, eqseen = 0;
#pragma unroll
  for (int q = 0; q < 8; ++q) {
    bool gt = k[q] > P, eq = k[q] == P, ge = k[q] >= P;
    unsigned long long me = __ballot(eq);
    int epre = eqseen + (int)mbcnt64(me);
    bool keep = cut ? ge : (gt || (eq && epre < need));
    unsigned long long m = __ballot(keep);
    int pre = base + (int)mbcnt64(m);
    if (keep) bi[pre] = ix[q];
    base += __popcll(m);
    eqseen += __popcll(me);
  }
  return base;
}

#define MFMA8(a, b, c) __builtin_amdgcn_mfma_f32_16x16x32_fp8_fp8((a), (b), (c), 0, 0, 0)
typedef __attribute__((ext_vector_type(4))) float f32x4v;
typedef __attribute__((ext_vector_type(2))) float f32x2v;
DI int pidx(int h, int key) { return h * 256 + (key ^ ((h & 1) << 5)); }
DI long mk64(unsigned lo, unsigned hi) { return (long)(((unsigned long long)hi << 32) | lo); }

DI void sparse_attn_query(const Params& p, size_t rowb, size_t row, const unsigned* sel, int nsel, float* pbuf, int lane) {
  const int m16 = lane & 15, kg = lane >> 4;
  long afr[16];
  {
    unsigned alo0, alo1, ahi0, ahi1;
    {
      const u32x4 qa = *(const u32x4*)(p.QA + row * 512 + (m16 & 7) * 64 + kg * 16);
      const u32x4 qb = *(const u32x4*)(p.QA + row * 512 + (m16 & 7) * 64 + kg * 16 + 8);
      alo0 = cvt4_fp8(bflo(qa[0]), bfhi(qa[0]), bflo(qa[1]), bfhi(qa[1]));
      alo1 = cvt4_fp8(bflo(qa[2]), bfhi(qa[2]), bflo(qa[3]), bfhi(qa[3]));
      ahi0 = cvt4_fp8(bflo(qb[0]), bfhi(qb[0]), bflo(qb[1]), bfhi(qb[1]));
      ahi1 = cvt4_fp8(bflo(qb[2]), bfhi(qb[2]), bflo(qb[3]), bfhi(qb[3]));
    }
#pragma unroll
    for (int s = 0; s < 16; ++s) {
      const bool on = (m16 == (s >> 1));
      afr[s] = mk64(on ? ((s & 1) ? ahi0 : alo0) : 0u, on ? ((s & 1) ? ahi1 : alo1) : 0u);
    }
  }
  const int ntile = (nsel + 15) >> 4;
  u32x4 bc[8], bn[8], bnn[8];
  {
    const int j = m16 < nsel ? m16 : nsel - 1;
    const unsigned char* kb = p.K8 + (rowb + sel[j]) * 512 + kg * 16;
#pragma unroll
    for (int h = 0; h < 8; ++h) { bc[h] = *(const u32x4*)(kb + h * 64); bn[h] = bc[h]; bnn[h] = bc[h]; }
    {
      const int kn = 16 + m16;
      const int j1 = kn < nsel ? kn : nsel - 1;
      const unsigned char* kb1 = p.K8 + (rowb + sel[j1]) * 512 + kg * 16;
#pragma unroll
      for (int h = 0; h < 8; ++h) bn[h] = *(const u32x4*)(kb1 + h * 64);
    }
  }
#pragma unroll 1
  for (int T = 0; T < ntile; ++T) {
    {
      const int kn = (T + 2) * 16 + m16;
      const int j = kn < nsel ? kn : nsel - 1;
      const unsigned char* kb = p.K8 + (rowb + sel[j]) * 512 + kg * 16;
#pragma unroll
      for (int h = 0; h < 8; ++h) bnn[h] = *(const u32x4*)(kb + h * 64);
    }
    f32x4v acc0 = {0.f, 0.f, 0.f, 0.f}, acc1 = {0.f, 0.f, 0.f, 0.f};
#pragma unroll
    for (int h = 0; h < 8; ++h) {
      acc0 = MFMA8(afr[2 * h], mk64(bc[h][0], bc[h][1]), acc0);
      acc1 = MFMA8(afr[2 * h + 1], mk64(bc[h][2], bc[h][3]), acc1);
    }
    const int key = T * 16 + m16;
    if (kg < 2) {
      const bool ok = key < nsel;
#pragma unroll
      for (int i = 0; i < 4; ++i) pbuf[pidx(4 * kg + i, key)] = ok ? (acc0[i] + acc1[i]) * 0.125f : -1e30f;
    }
#pragma unroll
    for (int h = 0; h < 8; ++h) { bc[h] = bn[h]; bn[h] = bnn[h]; }
  }
  for (int T = ntile; T < 16; ++T) {
    if (kg < 2) {
#pragma unroll
      for (int i = 0; i < 4; ++i) pbuf[pidx(4 * kg + i, T * 16 + m16)] = -1e30f;
    }
  }
  const int hl = lane >> 3, l8 = lane & 7;
  float inv;
  {
    float4 lg[8];
    float mx = -1e30f;
#pragma unroll
    for (int j = 0; j < 8; ++j) {
      lg[j] = *(const float4*)(pbuf + pidx(hl, 32 * j + 4 * l8));
      mx = fmaxf(mx, fmaxf(fmaxf(lg[j].x, lg[j].y), fmaxf(lg[j].z, lg[j].w)));
    }
    mx = fmaxf(mx, dppmov<0xB1>(mx));
    mx = fmaxf(mx, dppmov<0x4E>(mx));
    mx = fmaxf(mx, dppmov<0x141>(mx));
    float sum = 0.f;
#pragma unroll
    for (int j = 0; j < 8; ++j) {
      lg[j].x = __expf(lg[j].x - mx); lg[j].y = __expf(lg[j].y - mx); lg[j].z = __expf(lg[j].z - mx); lg[j].w = __expf(lg[j].w - mx);
      sum += (lg[j].x + lg[j].y) + (lg[j].z + lg[j].w);
      *(float4*)(pbuf + pidx(hl, 32 * j + 4 * l8)) = lg[j];
    }
    sum = red8(sum);
    inv = 1.f / sum;
  }
  const int kpar = lane >> 5, l5 = lane & 31, h16 = l5 >> 2;
  f32x2v o2[8];
#pragma unroll
  for (int e = 0; e < 8; ++e) o2[e] = (f32x2v){0.f, 0.f};
  const int nstep = (nsel + 15) >> 4;
  const unsigned char* vbase = p.V8 + rowb * 512 + l5 * 16;
  u32x4 vc[8], vn[8], vnn[8];
#define LOADV16(dst, J0)                                                            \
  {                                                                                 \
    _Pragma("unroll") for (int g = 0; g < 4; ++g) {                                 \
      const uint4 i4 = *(const uint4*)(sel + (J0) + 4 * g);                         \
      const unsigned ia = kpar ? i4.y : i4.x, ib = kpar ? i4.w : i4.z;              \
      const unsigned ida = ((J0) + 4 * g + kpar < nsel) ? ia : sel[0];              \
      const unsigned idb = ((J0) + 4 * g + 2 + kpar < nsel) ? ib : sel[0];          \
      dst[2 * g] = *(const u32x4*)(vbase + (size_t)ida * 512);                      \
      dst[2 * g + 1] = *(const u32x4*)(vbase + (size_t)idb * 512);                  \
    }                                                                               \
  }
  LOADV16(vc, 0);
#pragma unroll
  for (int e = 0; e < 8; ++e) { vn[e] = vc[e]; vnn[e] = vc[e]; }
  LOADV16(vn, 16);
#pragma unroll 1
  for (int st = 0; st < nstep; ++st) {
    { const int j0 = (st + 2) * 16; LOADV16(vnn, j0); }
#pragma unroll
    for (int e = 0; e < 8; ++e) {
      const float pj = pbuf[pidx(h16, st * 16 + 2 * e + kpar)];
      const f32x2v pp = {pj, pj};
      const u32x4 v = vc[e];
#pragma unroll
      for (int k = 0; k < 4; ++k) {
        o2[2 * k] = __builtin_elementwise_fma(__builtin_amdgcn_cvt_pk_f32_fp8((int)v[k], false), pp, o2[2 * k]);
        o2[2 * k + 1] = __builtin_elementwise_fma(__builtin_amdgcn_cvt_pk_f32_fp8((int)v[k], true), pp, o2[2 * k + 1]);
      }
    }
#pragma unroll
    for (int e = 0; e < 8; ++e) { vc[e] = vn[e]; vn[e] = vnn[e]; }
  }
#undef LOADV16
  float o[16];
#pragma unroll
  for (int e = 0; e < 8; ++e) { o[2 * e] = o2[e].x; o[2 * e + 1] = o2[e].y; }
#pragma unroll
  for (int e = 0; e < 16; ++e) o[e] += __shfl_xor(o[e], 32);
  const float invh = __shfl(inv, h16 * 8);
  if (kpar == 0) {
    const u32x4 ga0 = *(const u32x4*)(p.GA + row * 512 + l5 * 16);
    const u32x4 ga1 = *(const u32x4*)(p.GA + row * 512 + l5 * 16 + 8);
    u32x4 ov0, ov1;
#pragma unroll
    for (int k = 0; k < 4; ++k) {
      ov0[k] = pack2(o[2 * k] * invh * bflo(ga0[k]), o[2 * k + 1] * invh * bfhi(ga0[k]));
      ov1[k] = pack2(o[8 + 2 * k] * invh * bflo(ga1[k]), o[8 + 2 * k + 1] * invh * bfhi(ga1[k]));
    }
    *(u32x4*)(p.MIX + row * 1024 + l5 * 16) = ov0;
    *(u32x4*)(p.MIX + row * 1024 + l5 * 16 + 8) = ov1;
  }
}

DI void attn_task(const Params& p, int task, char* smem, int qsel = 0) {
  int t_ = threadIdx.x;
  asm volatile("" : "+v"(t_));
  const int t = t_, lane = t & 63, w = t >> 6, r = lane & 31, hh = lane >> 5;
  const int b = task & 1, s16 = 511 - (task >> 1);
  const int tq0 = s16 * 16 + 4 * w;
  const size_t rowb = (size_t)b * SEQL;
  unsigned* bkey = (unsigned*)smem + w * 4096;
  unsigned* bidx = bkey + 2048;
  const int ql = 2 * ((r >> 2) & 1) + (r >> 4), hd = (r & 3) + 4 * ((r >> 3) & 1);
  bf16x8 aq[4];
#pragma unroll
  for (int s = 0; s < 4; ++s) aq[s] = *(const bf16x8*)(p.IQ + (rowb + tq0 + ql) * 512 + hd * 64 + s * 16 + hh * 8);
  float w0[8], w1[8];
#pragma unroll
  for (int i = 0; i < 8; ++i) {
    w0[i] = p.IW[(rowb + tq0 + 2 * hh) * 8 + i];
    w1[i] = p.IW[(rowb + tq0 + 2 * hh + 1) * 8 + i];
  }
  const int tqa = tq0 + 2 * hh, tqb = tqa + 1;
  float tha = -__builtin_inff(), thb = -__builtin_inff();
  int cnt0 = 0, cnt1 = 0, cnt2 = 0, cnt3 = 0;
  const int ntile = ((s16 * 16 + 15) >> 5) + 1;
  const int offa = hh ? 1024 : 0, offb = hh ? 1536 : 512;
  auto tile_body = [&](const f32x16& acc, int kt) -> bool {
    float sa = 0.f, sb = 0.f;
#pragma unroll
    for (int i = 0; i < 8; ++i) {
      sa = fmaf(w0[i], relu_i(acc[i]), sa);
      sb = fmaf(w1[i], relu_i(acc[8 + i]), sb);
    }
    const int key = kt * 32 + r;
    const bool pa = (key <= tqa) & (sa >= tha);
    const bool pb = (key <= tqb) & (sb >= thb);
    {
      const unsigned long long m = __builtin_amdgcn_ballot_w64(pa);
      const int nlo = __popc((unsigned)m), nhi = __popc((unsigned)(m >> 32));
      const int pos = (int)mbcnt64(m) + (hh ? cnt2 - nlo : cnt0);
      if (pa && pos < 512) { bkey[offa + pos] = __float_as_uint(sa); bidx[offa + pos] = (unsigned)key; }
      cnt0 += nlo; cnt2 += nhi;
    }
    {
      const unsigned long long m = __builtin_amdgcn_ballot_w64(pb);
      const int nlo = __popc((unsigned)m), nhi = __popc((unsigned)(m >> 32));
      const int pos = (int)mbcnt64(m) + (hh ? cnt3 - nlo : cnt1);
      if (pb && pos < 512) { bkey[offb + pos] = __float_as_uint(sb); bidx[offb + pos] = (unsigned)key; }
      cnt1 += nlo; cnt3 += nhi;
    }
    return (cnt0 > 448) | (cnt1 > 448) | (cnt2 > 448) | (cnt3 > 448);
  };
  {
    ush* tile = (ush*)(smem + 65536);
    __shared__ int s_need[2];
    const int lkey = t >> 3, lch = t & 7;
    const ush* gsrc = p.IK + (rowb + lkey) * 64 + lch * 8;
    const int npair = (ntile + 1) >> 1;
    const int lp = npair - 1;
    u32x4 g0 = *(const u32x4*)(gsrc), g1 = *(const u32x4*)(gsrc + 2048);
    if (t < 2) s_need[t] = 0;
    for (int kp = 0; kp < npair; ++kp) {
      __syncthreads();
      const int need = kp > 0 ? s_need[(kp - 1) & 1] : 0;
      *(u32x4*)(tile + lkey * 72 + lch * 8) = g0;
      *(u32x4*)(tile + (lkey + 32) * 72 + lch * 8) = g1;
      __syncthreads();
      if (t == 0 && kp > 0) s_need[(kp - 1) & 1] = 0;
      {
        const int pn = kp + 1 < lp ? kp + 1 : lp;
        g0 = *(const u32x4*)(gsrc + (size_t)pn * 4096);
        g1 = *(const u32x4*)(gsrc + (size_t)pn * 4096 + 2048);
      }
      if (need) {
        if (cnt0 > 320) { float th; compact16(bkey, bidx, cnt0, th, lane); if (hh == 0) tha = th; }
        if (cnt1 > 320) { float th; compact16(bkey + 512, bidx + 512, cnt1, th, lane); if (hh == 0) thb = th; }
        if (cnt2 > 320) { float th; compact16(bkey + 1024, bidx + 1024, cnt2, th, lane); if (hh == 1) tha = th; }
        if (cnt3 > 320) { float th; compact16(bkey + 1536, bidx + 1536, cnt3, th, lane); if (hh == 1) thb = th; }
      }
      bf16x8 bta[4], btb[4];
#pragma unroll
      for (int s = 0; s < 4; ++s) {
        bta[s] = *(const bf16x8*)(tile + r * 72 + s * 16 + hh * 8);
        btb[s] = *(const bf16x8*)(tile + (32 + r) * 72 + s * 16 + hh * 8);
      }
      f32x16 acca = zero16(), accb = zero16();
#pragma unroll
      for (int s = 0; s < 4; ++s) { acca = MFMA32(aq[s], bta[s], acca); accb = MFMA32(aq[s], btb[s], accb); }
      bool nd = tile_body(acca, 2 * kp);
      if (2 * kp + 1 < ntile) nd |= tile_body(accb, 2 * kp + 1);
      if (nd && lane == 0) s_need[kp & 1] = 1;
    }
    __syncthreads();
  }
  const bool lo = qsel != 2, hi = qsel != 1;
  int nsel_q[4] = {0, 0, 0, 0};
  {
    int c0 = cnt0 > 512 ? 512 : cnt0, c1 = cnt1 > 512 ? 512 : cnt1, c2 = cnt2 > 512 ? 512 : cnt2, c3 = cnt3 > 512 ? 512 : cnt3;
    if (lo) {
      nsel_q[0] = final_select(bkey, bidx, c0, lane);
      nsel_q[1] = final_select(bkey + 512, bidx + 512, c1, lane);
    }
    if (hi) {
      nsel_q[2] = final_select(bkey + 1024, bidx + 1024, c2, lane);
      nsel_q[3] = final_select(bkey + 1536, bidx + 1536, c3, lane);
    }
  }
  float* pbuf = (float*)bkey;
#pragma unroll
  for (int q = 0; q < 4; ++q) {
    if (q < 2 ? lo : hi) sparse_attn_query(p, rowb, rowb + tq0 + q, bidx + q * 512, nsel_q[q], pbuf, lane);
  }
}

DI void dn_norm(const Params& p, int wave, int nw, int lane) {
  const float4* nwp = (const float4*)(p.dnw + (lane & 15) * 8);
  const float4 n0 = nwp[0], n1 = nwp[1];
  for (int row0 = wave; row0 < NTOK; row0 += 4 * nw) {
    float4 a[4], c[4];
    u32x4 z[4];
#pragma unroll
    for (int j = 0; j < 4; ++j) {
      const int row = row0 + j * nw;
      const float4* op = (const float4*)(p.OD + (size_t)row * 512 + lane * 8);
      a[j] = op[0]; c[j] = op[1];
      z[j] = *(const u32x4*)(p.SZ + (size_t)row * 512 + lane * 8);
    }
#pragma unroll
    for (int j = 0; j < 4; ++j) {
      const int row = row0 + j * nw;
      float ss = a[j].x * a[j].x + a[j].y * a[j].y + a[j].z * a[j].z + a[j].w * a[j].w + c[j].x * c[j].x + c[j].y * c[j].y + c[j].z * c[j].z + c[j].w * c[j].w;
      ss += __shfl_xor(ss, 1); ss += __shfl_xor(ss, 2); ss += __shfl_xor(ss, 4); ss += __shfl_xor(ss, 8);
      const float rs = rsqrtf(ss * (1.f / 128.f) + 1e-6f);
      u32x4 o;
      o[0] = pack2(a[j].x * rs * n0.x * bflo(z[j][0]), a[j].y * rs * n0.y * bfhi(z[j][0]));
      o[1] = pack2(a[j].z * rs * n0.z * bflo(z[j][1]), a[j].w * rs * n0.w * bfhi(z[j][1]));
      o[2] = pack2(c[j].x * rs * n1.x * bflo(z[j][2]), c[j].y * rs * n1.y * bfhi(z[j][2]));
      o[3] = pack2(c[j].z * rs * n1.z * bflo(z[j][3]), c[j].w * rs * n1.w * bfhi(z[j][3]));
      *(u32x4*)(p.MIX + (size_t)row * 1024 + 512 + lane * 8) = o;
    }
  }
}

DI void dn_norm_rows(const Params& p, int row_base, int lane) {
  const float4* nwp = (const float4*)(p.dnw + (lane & 15) * 8);
  const float4 n0 = nwp[0], n1 = nwp[1];
#pragma unroll 1
  for (int r4 = 0; r4 < 16; r4 += 4) {
    float4 a[4], c[4];
    u32x4 z[4];
#pragma unroll
    for (int j = 0; j < 4; ++j) {
      const int row = row_base + r4 + j;
      const float4* op = (const float4*)(p.OD + (size_t)row * 512 + lane * 8);
      a[j] = op[0]; c[j] = op[1];
      z[j] = *(const u32x4*)(p.SZ + (size_t)row * 512 + lane * 8);
    }
#pragma unroll
    for (int j = 0; j < 4; ++j) {
      const int row = row_base + r4 + j;
      float ss = a[j].x * a[j].x + a[j].y * a[j].y + a[j].z * a[j].z + a[j].w * a[j].w + c[j].x * c[j].x + c[j].y * c[j].y + c[j].z * c[j].z + c[j].w * c[j].w;
      ss += __shfl_xor(ss, 1); ss += __shfl_xor(ss, 2); ss += __shfl_xor(ss, 4); ss += __shfl_xor(ss, 8);
      const float rs = rsqrtf(ss * (1.f / 128.f) + 1e-6f);
      u32x4 o;
      o[0] = pack2(a[j].x * rs * n0.x * bflo(z[j][0]), a[j].y * rs * n0.y * bfhi(z[j][0]));
      o[1] = pack2(a[j].z * rs * n0.z * bflo(z[j][1]), a[j].w * rs * n0.w * bfhi(z[j][1]));
      o[2] = pack2(c[j].x * rs * n1.x * bflo(z[j][2]), c[j].y * rs * n1.y * bfhi(z[j][2]));
      o[3] = pack2(c[j].z * rs * n1.z * bflo(z[j][3]), c[j].w * rs * n1.w * bfhi(z[j][3]));
      *(u32x4*)(p.MIX + (size_t)row * 1024 + 512 + lane * 8) = o;
    }
  }
}

DI void outproj_tile(const Params& p, int tile, char* smem) {
  const int mt = tile >> 3, nt = tile & 7;
  const int m0 = mt * 128, n0 = nt * 128;
  f32x16 acc[2][2];
  gemm_tile(p.MIX, p.Wo, m0, n0, 1024, smem, acc);
  (void)stage_rows(acc, smem);
  int t_ = threadIdx.x;
  asm volatile("" : "+v"(t_));
  const int t = t_, c4 = t & 31, r0 = t >> 5;
  const float* Cs = (const float*)smem;
#pragma unroll 4
  for (int ps = 0; ps < 16; ++ps) {
    const int rr = ps * 8 + r0;
    const float4 f = *(const float4*)(Cs + rr * 132 + c4 * 4);
    const size_t off = (size_t)(m0 + rr) * 1024 + n0 + c4 * 4;
    const float4 xv = *(const float4*)(p.x + off);
    *(float4*)(p.out + off) = make_float4(xv.x + f.x, xv.y + f.y, xv.z + f.z, xv.w + f.w);
  }
}

#define XB_TMO      128
#define XB_XCNT(j)  (256  + 64 * (j))
#define XB_XSUB(j)  (1280 + 64 * (j))
#define XB_XGEN(j)  (2304 + 64 * (j))
#define XB_TOP      3328
#define XB_TOPGEN   3392
#define XCD_BAR_WORDS 3456
#define XB_SPIN_CAP (1u << 20)
#define LAS __attribute__((address_space(3)))
DI unsigned xb_ld(unsigned* p) { return __hip_atomic_load(p, __ATOMIC_RELAXED, __HIP_MEMORY_SCOPE_AGENT); }
DI unsigned xb_add(unsigned* p, unsigned v) { return __hip_atomic_fetch_add(p, v, __ATOMIC_RELAXED, __HIP_MEMORY_SCOPE_AGENT); }
DI unsigned xb_xcc_id() { return (unsigned)__builtin_amdgcn_s_getreg((3 << 11) | 20) & 0xFu; }
#define XB_SPIN(cond, bar) do { unsigned _sp = 0; while (cond) { __builtin_amdgcn_s_sleep(1); \
    if ((++_sp & 255u) == 0u) { if (xb_ld(&(bar)[XB_TMO])) break; if (_sp > XB_SPIN_CAP) { atomicAdd(&(bar)[XB_TMO], 1u); break; } } } } while (0)
struct XcdBarrier { unsigned* bar; unsigned x; volatile LAS unsigned* st; };
DI XcdBarrier xcd_barrier_post(unsigned* bar, volatile LAS unsigned* st) {
  XcdBarrier b; b.bar = bar; b.x = xb_xcc_id(); b.st = st;
  if (threadIdx.x == 0) (void)xb_add(&bar[XB_XCNT(b.x)], 1u);
  return b;
}
DI void xcd_barrier_complete(unsigned* bar, unsigned x, unsigned& nloc, unsigned& nx) {
  const unsigned G = gridDim.x * gridDim.y * gridDim.z;
  unsigned sum, cnt, mine, sp = 0u;
  for (;;) {
    sum = 0u; cnt = 0u; mine = 0u;
#pragma unroll
    for (unsigned j = 0; j < 16; ++j) { const unsigned c = xb_ld(&bar[XB_XCNT(j)]); sum += c; cnt += (c > 0u) ? 1u : 0u; mine = (j == x) ? c : mine; }
    if (sum == G) break;
    __builtin_amdgcn_s_sleep(1);
    if ((++sp & 255u) == 0u) { if (xb_ld(&bar[XB_TMO])) break; if (sp > XB_SPIN_CAP) { atomicAdd(&bar[XB_TMO], 1u); break; } }
  }
  nloc = mine > 0u ? mine : 1u; nx = cnt > 0u ? cnt : 1u;
}
DI void xcd_barrier(const XcdBarrier& b) {
  asm volatile("s_waitcnt vmcnt(0)" ::: "memory");
  __syncthreads();
  if (threadIdx.x == 0) {
    unsigned* bar = b.bar;
    __builtin_amdgcn_s_waitcnt(0);
    unsigned nloc = b.st[0], nx = b.st[1];
    if (nloc == 0u) { xcd_barrier_complete(bar, b.x, nloc, nx); b.st[0] = nloc; b.st[1] = nx; }
    const unsigned old = xb_add(&bar[XB_XSUB(b.x)], 1u);
    const unsigned gen = old / nloc;
    if (old + 1u == (gen + 1u) * nloc) {
      __builtin_amdgcn_fence(__ATOMIC_RELEASE, "agent");
      asm volatile("s_waitcnt vmcnt(0)" ::: "memory");
      const unsigned og = xb_add(&bar[XB_TOP], 1u);
      const unsigned tg = og / nx;
      if (og + 1u == (tg + 1u) * nx) xb_add(&bar[XB_TOPGEN], 1u);
      else XB_SPIN(xb_ld(&bar[XB_TOPGEN]) == tg, bar);
      __builtin_amdgcn_fence(__ATOMIC_ACQUIRE, "agent");
      xb_add(&bar[XB_XGEN(b.x)], 1u);
      asm volatile("s_waitcnt vmcnt(0)" ::: "memory");
    } else {
      XB_SPIN(xb_ld(&bar[XB_XGEN(b.x)]) == gen, bar);
      __builtin_amdgcn_fence(__ATOMIC_ACQUIRE, "agent");
      asm volatile("s_waitcnt vmcnt(0)" ::: "memory");
    }
  }
  __syncthreads();
}

__global__ void __launch_bounds__(256, 2) k_prep(Params p) {
  __shared__ __attribute__((aligned(16))) char smem[SMEM_BYTES];
  phase_prep(p, blockIdx.x * 256 + threadIdx.x, gridDim.x * 256, smem);
}
__global__ void __launch_bounds__(256, 2) k_inproj(Params p) {
  __shared__ __attribute__((aligned(16))) char smem[SMEM_BYTES];
  for (int tile = blockIdx.x; tile < 128 * 37; tile += gridDim.x) inproj_tile(p, tile, smem);
}
__global__ void __launch_bounds__(256, 2) k_dnprep(Params p) {
  __shared__ __attribute__((aligned(16))) char smem[SMEM_BYTES];
  for (int task = blockIdx.x; task < 1024; task += gridDim.x) dn_prep_task(p, task, smem);
}
__global__ void __launch_bounds__(256, 2) k_scan(Params p) {
  __shared__ __attribute__((aligned(16))) char smem[SMEM_BYTES];
  dn_scan(p, blockIdx.x, smem);
}
__global__ void __launch_bounds__(256, 2) k_attn(Params p) {
  __shared__ __attribute__((aligned(16))) char smem[SMEM_BYTES];
  for (int task = blockIdx.x; task < 1024; task += gridDim.x) attn_task(p, task, smem);
}
__global__ void __launch_bounds__(256, 2) k_dnnorm(Params p) {
  dn_norm(p, (blockIdx.x * 256 + threadIdx.x) >> 6, (gridDim.x * 256) >> 6, threadIdx.x & 63);
}
__global__ void __launch_bounds__(256, 2) k_outproj(Params p) {
  __shared__ __attribute__((aligned(16))) char smem[SMEM_BYTES];
  for (int tile = blockIdx.x; tile < 1024; tile += gridDim.x) outproj_tile(p, tile, smem);
}

__global__ void __launch_bounds__(256, 2) k_mega(Params p) {
  __shared__ __attribute__((aligned(16))) char smem[SMEM_BYTES];
  __shared__ uint4 xb_words;
  __shared__ int s_task;
  cg::grid_group grid = cg::this_grid();
  if (threadIdx.x == 0) xb_words = make_uint4(0u, 0u, 0u, 0u);
  __syncthreads();
  XcdBarrier xb = xcd_barrier_post(p.counters + 64, (volatile LAS unsigned*)&xb_words);
  const int gtid = blockIdx.x * 256 + threadIdx.x, gsize = gridDim.x * 256;
  phase_prep(p, gtid, gsize, smem);
  if (p.use_cg_sync) grid.sync();
  xcd_barrier(xb);
  for (int tile = blockIdx.x; tile < 128 * 19; tile += gridDim.x) gemm_tile256<0>(p, tile, smem);
  xcd_barrier(xb);
  for (int task = blockIdx.x; task < 1024; task += gridDim.x) dn_prep_task(p, task, smem);
  xcd_barrier(xb);
  if (blockIdx.x < 32) {
    __builtin_amdgcn_s_setprio(3);
    dn_scan(p, blockIdx.x, smem);
    __builtin_amdgcn_s_setprio(0);
    asm volatile("s_waitcnt vmcnt(0)" ::: "memory");
    __syncthreads();
    if (threadIdx.x == 0) {
      __builtin_amdgcn_fence(__ATOMIC_RELEASE, "agent");
      asm volatile("s_waitcnt vmcnt(0)" ::: "memory");
      atomicAdd(&p.counters[32], 1u);
    }
    __syncthreads();
  }
  {
    int pb = (int)((xb.x >> 2) & 1u);
    int tries = 0;
    while (tries < 2) {
      if (threadIdx.x == 0) s_task = (int)atomicAdd(&p.counters[pb], 1u);
      __syncthreads();
      const int tk = s_task;
      __syncthreads();
      if (tk >= 512 + QSPLIT) { pb ^= 1; ++tries; continue; }
      if (tk < 512 - QSPLIT) attn_task(p, tk * 2 + pb, smem, 0);
      else { const int j = tk - (512 - QSPLIT); attn_task(p, ((512 - QSPLIT) + (j >> 1)) * 2 + pb, smem, 1 + (j & 1)); }
    }
  }
  {
    if (threadIdx.x == 0) {
      unsigned sp = 0;
      while (__hip_atomic_load(&p.counters[32], __ATOMIC_RELAXED, __HIP_MEMORY_SCOPE_AGENT) < 32u) {
        __builtin_amdgcn_s_sleep(4);
        if (++sp > (1u << 22)) break;
      }
      __builtin_amdgcn_fence(__ATOMIC_ACQUIRE, "agent");
      asm volatile("s_waitcnt vmcnt(0)" ::: "memory");
    }
    __syncthreads();
    while (true) {
      if (threadIdx.x == 0) s_task = (int)atomicAdd(&p.counters[33], 1u);
      __syncthreads();
      const int ck = s_task;
      __syncthreads();
      if (ck >= 256) break;
      int tn_ = threadIdx.x;
      asm volatile("" : "+v"(tn_));
      dn_norm_rows(p, ck * 64 + (tn_ >> 6) * 16, tn_ & 63);
    }
  }
  xcd_barrier(xb);
  for (int tile = blockIdx.x; tile < 512; tile += gridDim.x) gemm_tile256<1>(p, tile, smem);
}

extern "C" void kernel_launch(void* const* d_in, const int* in_sizes, int n_in, void* d_out, int out_size, void* d_ws,
                              size_t ws_size, hipStream_t stream) {
  Params p{};
  p.x = (const float*)d_in[0]; p.ln_w = (const float*)d_in[1]; p.w_in = (const float*)d_in[2];
  p.aqw = (const float*)d_in[3]; p.akw = (const float*)d_in[4]; p.ikw = (const float*)d_in[5];
  p.ikb = (const float*)d_in[6]; p.convw = (const float*)d_in[7]; p.alog = (const float*)d_in[8];
  p.dtb = (const float*)d_in[9]; p.dnw = (const float*)d_in[10]; p.w_out = (const float*)d_in[11];
  p.out = (float*)d_out;
  char* ws = (char*)d_ws;
  const size_t MB = 1u << 20;
  p.Wt = (ush*)(ws + 0);
  p.Wo = (ush*)(ws + 10 * MB);
  p.XB = (ush*)(ws + 12 * MB);
  p.MIX = (ush*)(ws + 12 * MB);
  p.QA = (ush*)(ws + 45 * MB); p.KA = (ush*)(ws + 61 * MB); p.VA = (ush*)(ws + 77 * MB);
  p.GA = (ush*)(ws + 93 * MB); p.IQ = (ush*)(ws + 109 * MB); p.DQ = (ush*)(ws + 125 * MB);
  p.DK = (ush*)(ws + 141 * MB); p.DV = (ush*)(ws + 157 * MB); p.SZ = (ush*)(ws + 173 * MB);
  p.IK = (ush*)(ws + 189 * MB);
  p.IW = (float*)(ws + 191 * MB);
  p.BETA = (float*)(ws + 191 * MB + 512 * 1024);
  p.G = (float*)(ws + 191 * MB + 768 * 1024);
  p.INTRA = (ush*)(ws + 192 * MB);
  p.GL = (float*)(ws + 200 * MB);
  p.OD = (float*)(ws + 201 * MB);
  p.counters = (unsigned*)(ws + 233 * MB);
  p.K8 = (unsigned char*)(ws + 61 * MB);
  p.V8 = (unsigned char*)(ws + 77 * MB);
  char* o8 = (char*)d_out;
  p.UT = (ush*)(o8); p.WG = (ush*)(o8 + 16 * MB); p.QG = (ush*)(o8 + 32 * MB); p.KDT = (ush*)(o8 + 48 * MB);

#if MEGA
  static int grid_blocks = 0;
  if (!grid_blocks) {
    int dev = 0, cus = 0, per_cu = 0;
    hipGetDevice(&dev);
    hipDeviceGetAttribute(&cus, hipDeviceAttributeMultiprocessorCount, dev);
    hipOccupancyMaxActiveBlocksPerMultiprocessor(&per_cu, k_mega, 256, 0);
    if (per_cu > 2) per_cu = 2;
    grid_blocks = cus * per_cu;
  }
  hipMemsetAsync(p.counters, 0, (64 + XCD_BAR_WORDS) * sizeof(unsigned), stream);
  void* args[] = {&p};
  hipError_t e = hipLaunchCooperativeKernel((void*)k_mega, dim3(grid_blocks), dim3(256), args, 0, stream);
  if (e != hipSuccess) fprintf(stderr, "cooperative launch failed: %s (grid %d)\n", hipGetErrorString(e), grid_blocks);
#else
  k_prep<<<1024, 256, 0, stream>>>(p);
  k_inproj<<<128 * 37, 256, 0, stream>>>(p);
  k_dnprep<<<1024, 256, 0, stream>>>(p);
  k_scan<<<32, 256, 0, stream>>>(p);
  k_attn<<<1024, 256, 0, stream>>>(p);
  k_dnnorm<<<1024, 256, 0, stream>>>(p);
  k_outproj<<<1024, 256, 0, stream>>>(p);
#endif
}
```

```cpp
#include <hip/hip_runtime.h>
#include <hip/hip_cooperative_groups.h>
#include <cstdio>
#include <cstdint>
namespace cg = cooperative_groups;

#ifndef MEGA
#define MEGA 1
#endif

#define DI __device__ __forceinline__
typedef __attribute__((ext_vector_type(8))) short bf16x8;
typedef __attribute__((ext_vector_type(16))) float f32x16;
typedef __attribute__((ext_vector_type(4))) unsigned u32x4;
typedef __attribute__((ext_vector_type(2))) unsigned u32x2;
typedef __attribute__((ext_vector_type(2))) __bf16 bf2_t;
typedef unsigned short ush;
#define MFMA32(a, b, c) __builtin_amdgcn_mfma_f32_32x32x16_bf16((a), (b), (c), 0, 0, 0)

constexpr int NTOK = 16384;
constexpr int SEQL = 8192;
constexpr int NP = 4736;
constexpr int DIN = 4688;
constexpr int SMEM_BYTES = 74752;
constexpr int QSPLIT = 48;

struct Params {
  const float *x, *ln_w, *w_in, *aqw, *akw, *ikw, *ikb, *convw, *alog, *dtb, *dnw, *w_out;
  float* out;
  ush *Wt, *Wo, *XB, *MIX, *QA, *KA, *VA, *GA, *IQ, *DQ, *DK, *DV, *SZ, *IK, *INTRA;
  ush *UT, *WG, *QG, *KDT;
  float *IW, *BETA, *G, *GL, *OD;
  unsigned* counters;
  unsigned char *K8, *V8;
  int use_cg_sync, pad0;
};

DI ush f2bf(float x) { return __builtin_bit_cast(ush, (__bf16)x); }
DI float bf2f(ush b) { return __uint_as_float(((unsigned)b) << 16); }
DI unsigned pack2(float a, float b) { bf2_t v = {(__bf16)a, (__bf16)b}; return __builtin_bit_cast(unsigned, v); }
DI float bflo(unsigned u) { return __uint_as_float(u << 16); }
DI float bfhi(unsigned u) { return __uint_as_float(u & 0xffff0000u); }
DI int crow(int reg, int h) { return (reg & 3) + 8 * (reg >> 2) + 4 * h; }
DI float silu_f(float v) { return v / (1.f + __expf(-v)); }
DI f32x16 zero16() { f32x16 z; for (int i = 0; i < 16; ++i) z[i] = 0.f; return z; }

template <int CTRL> DI float dppmov(float x) {
  return __int_as_float(__builtin_amdgcn_update_dpp(0, __float_as_int(x), CTRL, 0xF, 0xF, true));
}
DI float red8(float d) {
  d += dppmov<0xB1>(d);
  d += dppmov<0x4E>(d);
  d += dppmov<0x141>(d);
  return d;
}
DI unsigned mbcnt64(unsigned long long m) {
  return __builtin_amdgcn_mbcnt_hi((unsigned)(m >> 32), __builtin_amdgcn_mbcnt_lo((unsigned)m, 0u));
}
DI int mapcol(int n) {
  if (n < 2560) return n;
  if (n < 4608) return n + 72;
  if (n < 4680) return n - 2048;
  if (n < 4688) return n;
  return -1;
}

DI void phase_prep(const Params& p, int gtid, int gsize, char* smem) {
  {
    unsigned* Ts = (unsigned*)smem;
    ush* Th = (ush*)smem;
    int t_ = threadIdx.x;
    asm volatile("" : "+v"(t_));
    const int t = t_;
    for (int tt = blockIdx.x; tt < 1472; tt += gridDim.x) {
      const bool is_in = tt < 1216;
      const int id = is_in ? tt : tt - 1216;
      const int nt = is_in ? id % 76 : (id & 15), kt = is_in ? id / 76 : (id >> 4);
      const float* src = is_in ? p.w_in : p.w_out;
      const int ld = is_in ? DIN : 1024;
      ush* dst = is_in ? p.Wt : p.Wo;
      {
        const int n = t & 63, ks = t >> 6;
        const int oc = is_in ? mapcol(nt * 64 + n) : nt * 64 + n;
#pragma unroll
        for (int it = 0; it < 16; ++it) {
          int k = it * 4 + ks;
          float v = oc >= 0 ? src[(size_t)(kt * 64 + k) * ld + oc] : 0.f;
          Th[n * 66 + k] = f2bf(v);
        }
      }
      __syncthreads();
      {
        const int n = t >> 2, kq = t & 3;
        u32x4 a, b;
#pragma unroll
        for (int i = 0; i < 4; ++i) { a[i] = Ts[n * 33 + kq * 8 + i]; b[i] = Ts[n * 33 + kq * 8 + 4 + i]; }
        u32x4* dp = (u32x4*)(dst + (size_t)(nt * 64 + n) * 1024 + kt * 64 + kq * 16);
        dp[0] = a; dp[1] = b;
      }
      __syncthreads();
    }
  }
  int wave = gtid >> 6, lane = gtid & 63, nw = gsize >> 6;
  for (int row = wave; row < NTOK; row += nw) {
    const float4* xr = (const float4*)(p.x + (size_t)row * 1024);
    float4 a[4];
    float ss = 0.f;
#pragma unroll
    for (int i = 0; i < 4; ++i) {
      a[i] = xr[lane + 64 * i];
      ss += a[i].x * a[i].x + a[i].y * a[i].y + a[i].z * a[i].z + a[i].w * a[i].w;
    }
#pragma unroll
    for (int o = 1; o < 64; o <<= 1) ss += __shfl_xor(ss, o);
    float rs = rsqrtf(ss * (1.f / 1024.f) + 1e-6f);
#pragma unroll
    for (int i = 0; i < 4; ++i) {
      float4 lw = ((const float4*)p.ln_w)[lane + 64 * i];
      u32x2 o;
      o[0] = pack2(a[i].x * rs * lw.x, a[i].y * rs * lw.y);
      o[1] = pack2(a[i].z * rs * lw.z, a[i].w * rs * lw.w);
      *(u32x2*)(p.XB + (size_t)row * 1024 + (lane + 64 * i) * 4) = o;
    }
  }
}

DI void gemm_tile(const ush* __restrict__ A, const ush* __restrict__ B, int m0, int n0, int K, char* smem,
                  f32x16 (&acc)[2][2]) {
  ush* As = (ush*)smem;
  ush* Bs = As + 128 * 72;
  int t_ = threadIdx.x;
  asm volatile("" : "+v"(t_));
  const int t = t_, lane = t & 63, w = t >> 6, wm = w >> 1, wn = w & 1, r = lane & 31, h = lane >> 5;
  u32x4 ra[4], rb[4];
#pragma unroll
  for (int i = 0; i < 2; ++i)
#pragma unroll
    for (int j = 0; j < 2; ++j) acc[i][j] = zero16();
#pragma unroll
  for (int i = 0; i < 4; ++i) {
    int c = t + 256 * i, row = c >> 3, kc = c & 7;
    ra[i] = *(const u32x4*)(A + (size_t)(m0 + row) * K + kc * 8);
    rb[i] = *(const u32x4*)(B + (size_t)(n0 + row) * K + kc * 8);
  }
  for (int k0 = 0; k0 < K; k0 += 64) {
    __syncthreads();
#pragma unroll
    for (int i = 0; i < 4; ++i) {
      int c = t + 256 * i, row = c >> 3, kc = c & 7;
      *(u32x4*)(As + row * 72 + kc * 8) = ra[i];
      *(u32x4*)(Bs + row * 72 + kc * 8) = rb[i];
    }
    __syncthreads();
    if (k0 + 64 < K) {
#pragma unroll
      for (int i = 0; i < 4; ++i) {
        int c = t + 256 * i, row = c >> 3, kc = c & 7;
        ra[i] = *(const u32x4*)(A + (size_t)(m0 + row) * K + k0 + 64 + kc * 8);
        rb[i] = *(const u32x4*)(B + (size_t)(n0 + row) * K + k0 + 64 + kc * 8);
      }
    }
#pragma unroll
    for (int s = 0; s < 4; ++s) {
      bf16x8 af[2], bfr[2];
#pragma unroll
      for (int i = 0; i < 2; ++i) af[i] = *(const bf16x8*)(As + (wm * 64 + i * 32 + r) * 72 + s * 16 + h * 8);
#pragma unroll
      for (int j = 0; j < 2; ++j) bfr[j] = *(const bf16x8*)(Bs + (wn * 64 + j * 32 + r) * 72 + s * 16 + h * 8);
#pragma unroll
      for (int i = 0; i < 2; ++i)
#pragma unroll
        for (int j = 0; j < 2; ++j) acc[i][j] = MFMA32(af[i], bfr[j], acc[i][j]);
    }
  }
  __syncthreads();
}

DI const float* stage_rows(f32x16 (&acc)[2][2], char* smem) {
  float* Cs = (float*)smem;
  int t_ = threadIdx.x;
  asm volatile("" : "+v"(t_));
  const int t = t_, lane = t & 63, w = t >> 6, wm = w >> 1, wn = w & 1, r = lane & 31, h = lane >> 5;
#pragma unroll
  for (int i = 0; i < 2; ++i)
#pragma unroll
    for (int j = 0; j < 2; ++j)
#pragma unroll
      for (int reg = 0; reg < 16; ++reg)
        Cs[(wm * 64 + i * 32 + crow(reg, h)) * 132 + wn * 64 + j * 32 + r] = acc[i][j][reg];
  __syncthreads();
  return Cs + (t & 127) * 132 + (t >> 7) * 64;
}
DI u32x4 pack8(float4 a, float4 b) {
  u32x4 o;
  o[0] = pack2(a.x, a.y); o[1] = pack2(a.z, a.w); o[2] = pack2(b.x, b.y); o[3] = pack2(b.z, b.w);
  return o;
}
DI float4 mul4(float4 a, float4 b) { return make_float4(a.x * b.x, a.y * b.y, a.z * b.z, a.w * b.w); }
DI float4 scl4(float4 a, float s) { return make_float4(a.x * s, a.y * s, a.z * s, a.w * s); }
DI unsigned cvt4_fp8(float a, float b, float c, float d) {
  int r = 0;
  r = __builtin_amdgcn_cvt_pk_fp8_f32(a, b, r, false);
  r = __builtin_amdgcn_cvt_pk_fp8_f32(c, d, r, true);
  return (unsigned)r;
}
DI float4 silu4(float4 a) { return make_float4(silu_f(a.x), silu_f(a.y), silu_f(a.z), silu_f(a.w)); }

DI void inproj_epilogue(const Params& p, int row, int nt, int half, const float4* cv) {
  if (nt < 36) {
    const int grp = nt >> 2;
    const int col = (nt & 3) * 128 + half * 64;
    ush* dst = (ush*)((char*)p.QA + (size_t)grp * (16u << 20));
    u32x4* dp = (u32x4*)(dst + (size_t)row * 512 + col);
    if (grp == 0) {
      float ss = 0.f;
#pragma unroll
      for (int q = 0; q < 16; ++q) { float4 f = cv[q]; ss += f.x * f.x + f.y * f.y + f.z * f.z + f.w * f.w; }
      const float rs = rsqrtf(ss * (1.f / 64.f) + 1e-6f);
      const float4* nw = (const float4*)p.aqw;
#pragma unroll
      for (int q = 0; q < 8; ++q)
        dp[q] = pack8(scl4(mul4(cv[2 * q], nw[2 * q]), rs), scl4(mul4(cv[2 * q + 1], nw[2 * q + 1]), rs));
    } else if (grp == 1) {
      float ss = 0.f;
#pragma unroll
      for (int q = 0; q < 16; ++q) { float4 f = cv[q]; ss += f.x * f.x + f.y * f.y + f.z * f.z + f.w * f.w; }
      const float rs = rsqrtf(ss * (1.f / 64.f) + 1e-6f);
      const float4* nw = (const float4*)p.akw;
      u32x4* d8 = (u32x4*)(p.K8 + (size_t)row * 512 + col);
#pragma unroll
      for (int q = 0; q < 4; ++q) {
        u32x4 o;
#pragma unroll
        for (int k = 0; k < 4; ++k) { float4 f = scl4(mul4(cv[4 * q + k], nw[4 * q + k]), rs); o[k] = cvt4_fp8(f.x, f.y, f.z, f.w); }
        d8[q] = o;
      }
    } else if (grp == 2) {
      u32x4* d8 = (u32x4*)(p.V8 + (size_t)row * 512 + col);
#pragma unroll
      for (int q = 0; q < 4; ++q) {
        u32x4 o;
#pragma unroll
        for (int k = 0; k < 4; ++k) { float4 f = cv[4 * q + k]; o[k] = cvt4_fp8(f.x, f.y, f.z, f.w); }
        d8[q] = o;
      }
    } else if (grp == 3 || grp == 8) {
#pragma unroll
      for (int q = 0; q < 8; ++q) dp[q] = pack8(silu4(cv[2 * q]), silu4(cv[2 * q + 1]));
    } else {
#pragma unroll
      for (int q = 0; q < 8; ++q) dp[q] = pack8(cv[2 * q], cv[2 * q + 1]);
    }
  } else {
    if (half == 0) {
      float mu = 0.f;
#pragma unroll
      for (int q = 0; q < 16; ++q) { float4 f = cv[q]; mu += f.x + f.y + f.z + f.w; }
      mu *= (1.f / 64.f);
      float var = 0.f;
#pragma unroll
      for (int q = 0; q < 16; ++q) {
        float4 f = cv[q];
        var += (f.x - mu) * (f.x - mu) + (f.y - mu) * (f.y - mu) + (f.z - mu) * (f.z - mu) + (f.w - mu) * (f.w - mu);
      }
      float rs = rsqrtf(var * (1.f / 64.f) + 1e-6f);
      const float4* kw = (const float4*)p.ikw;
      const float4* kb = (const float4*)p.ikb;
      u32x4* dp = (u32x4*)(p.IK + (size_t)row * 64);
#pragma unroll
      for (int q = 0; q < 8; ++q) {
        float4 a = cv[2 * q], c = cv[2 * q + 1], wa = kw[2 * q], wc = kw[2 * q + 1], ba = kb[2 * q], bc = kb[2 * q + 1];
        a = make_float4((a.x - mu) * rs * wa.x + ba.x, (a.y - mu) * rs * wa.y + ba.y, (a.z - mu) * rs * wa.z + ba.z, (a.w - mu) * rs * wa.w + ba.w);
        c = make_float4((c.x - mu) * rs * wc.x + bc.x, (c.y - mu) * rs * wc.y + bc.y, (c.z - mu) * rs * wc.z + bc.z, (c.w - mu) * rs * wc.w + bc.w);
        dp[q] = pack8(a, c);
      }
    } else {
      const float* v = (const float*)cv;
#pragma unroll
      for (int c = 0; c < 8; ++c) p.IW[(size_t)row * 8 + c] = v[c] * 0.044194173824159216f;
#pragma unroll
      for (int c = 0; c < 4; ++c) {
        p.BETA[(size_t)row * 4 + c] = 1.f / (1.f + expf(-v[8 + c]));
        float xx = v[12 + c] + p.dtb[c];
        float sp = xx > 20.f ? xx : log1pf(expf(xx));
        p.G[(size_t)row * 4 + c] = -expf(p.alog[c]) * sp;
      }
    }
  }
}

DI void inproj_tile(const Params& p, int tile, char* smem) {
  const int mt = tile / 37, nt = tile % 37;
  const int m0 = mt * 128, n0 = nt * 128;
  f32x16 acc[2][2];
  gemm_tile(p.XB, p.Wt, m0, n0, 1024, smem, acc);
  const float4* cv = (const float4*)stage_rows(acc, smem);
  const int t = threadIdx.x;
  inproj_epilogue(p, m0 + (t & 127), nt, t >> 7, cv);
}

template <int MODE> DI void gemm_tile256(const Params& p, int tile, char* smem) {
  const int mt = MODE == 0 ? (tile & 127) : (tile >> 2), n2 = MODE == 0 ? (tile >> 7) : (tile & 3);
  const int m0 = mt * 128, n0 = n2 * 256;
  ush* As = (ush*)smem;
  ush* Bs = As + 128 * 72;
  int t_ = threadIdx.x;
  asm volatile("" : "+v"(t_));
  const int t = t_, lane = t & 63, w = t >> 6, wm = w >> 1, wn = w & 1, r = lane & 31, h = lane >> 5;
  f32x16 acc[2][4];
#pragma unroll
  for (int i = 0; i < 2; ++i)
#pragma unroll
    for (int j = 0; j < 4; ++j) acc[i][j] = zero16();
  u32x4 ra[4], rb[8];
  const int lrow = t >> 3, lkc = t & 7;
  const unsigned voff = (unsigned)(lrow * 1024 + lkc * 8) * 2u;
  const char* abase = (const char*)((MODE == 0 ? p.XB : p.MIX) + (size_t)m0 * 1024);
  const char* bbase = (const char*)((MODE == 0 ? p.Wt : p.Wo) + (size_t)n0 * 1024);
#pragma unroll
  for (int i = 0; i < 4; ++i) ra[i] = *(const u32x4*)(abase + (size_t)i * 65536 + voff);
#pragma unroll
  for (int i = 0; i < 8; ++i) rb[i] = *(const u32x4*)(bbase + (size_t)i * 65536 + voff);
  for (int k0 = 0; k0 < 1024; k0 += 64) {
    __syncthreads();
#pragma unroll
    for (int i = 0; i < 4; ++i) *(u32x4*)(As + (lrow + 32 * i) * 72 + lkc * 8) = ra[i];
#pragma unroll
    for (int i = 0; i < 8; ++i) *(u32x4*)(Bs + (lrow + 32 * i) * 72 + lkc * 8) = rb[i];
    __syncthreads();
    {
      const int kn = k0 + 64 < 1024 ? k0 + 64 : k0;
#pragma unroll
      for (int i = 0; i < 4; ++i) ra[i] = *(const u32x4*)(abase + ((size_t)i * 65536 + (size_t)kn * 2) + voff);
#pragma unroll
      for (int i = 0; i < 8; ++i) rb[i] = *(const u32x4*)(bbase + ((size_t)i * 65536 + (size_t)kn * 2) + voff);
    }
#pragma unroll
    for (int s = 0; s < 4; ++s) {
      bf16x8 af[2], bfr[4];
#pragma unroll
      for (int i = 0; i < 2; ++i) af[i] = *(const bf16x8*)(As + (wm * 64 + i * 32 + r) * 72 + s * 16 + h * 8);
#pragma unroll
      for (int j = 0; j < 4; ++j) bfr[j] = *(const bf16x8*)(Bs + (wn * 128 + j * 32 + r) * 72 + s * 16 + h * 8);
#pragma unroll
      for (int i = 0; i < 2; ++i)
#pragma unroll
        for (int j = 0; j < 4; ++j) acc[i][j] = MFMA32(af[i], bfr[j], acc[i][j]);
    }
  }
  __syncthreads();
  const int nt = __builtin_amdgcn_readfirstlane(2 * n2 + wn);
  if (MODE == 1 || nt < 37) {
    float* Cw = (float*)smem + w * 4384;
#pragma unroll
    for (int jp = 0; jp < 2; ++jp) {
#pragma unroll
      for (int i = 0; i < 2; ++i)
#pragma unroll
        for (int jj = 0; jj < 2; ++jj)
#pragma unroll
          for (int reg = 0; reg < 16; ++reg)
            Cw[(i * 32 + crow(reg, h)) * 68 + jj * 32 + r] = acc[i][2 * jp + jj][reg];
      if (MODE == 0) {
        inproj_epilogue(p, m0 + wm * 64 + lane, nt, jp, (const float4*)(Cw + lane * 68));
      } else {
        const int c4 = lane & 15, r4 = lane >> 4;
#pragma unroll 4
        for (int ps = 0; ps < 16; ++ps) {
          const int lr = ps * 4 + r4;
          const float4 f = *(const float4*)(Cw + lr * 68 + c4 * 4);
          const size_t off = (size_t)(m0 + wm * 64 + lr) * 1024 + n0 + wn * 128 + jp * 64 + c4 * 4;
          const float4 xv = *(const float4*)(p.x + off);
          *(float4*)(p.out + off) = make_float4(xv.x + f.x, xv.y + f.y, xv.z + f.z, xv.w + f.w);
        }
      }
    }
  }
  __syncthreads();
}

DI void dn_prep_task(const Params& p, int task, char* smem) {
  int t_ = threadIdx.x;
  asm volatile("" : "+v"(t_));
  const int t = t_, lane = t & 63, w = t >> 6;
  const int h = task & 3, c = (task >> 2) & 127, b = task >> 9;
  const size_t ch = (size_t)(b * 4 + h) * 128 + c;
  const size_t row0 = (size_t)b * SEQL + c * 64;
  ush* Qs = (ush*)smem;
  ush* Ks = Qs + 64 * 136;
  ush* Vs = Ks + 64 * 136;
  float* As = (float*)(smem + 52224);
  float* gcs = (float*)(smem + 68608);
  float* bts = gcs + 64;
  float* ebg = bts + 64;
  float* ekd = ebg + 64;
  float* egc = ekd + 64;
  if (w == 0) {
    float g = p.G[(row0 + lane) * 4 + h];
#pragma unroll
    for (int o = 1; o < 64; o <<= 1) { float y = __shfl_up(g, o); if (lane >= o) g += y; }
    float bt = p.BETA[(row0 + lane) * 4 + h];
    float gl = __shfl(g, 63);
    gcs[lane] = g; bts[lane] = bt; ebg[lane] = bt * expf(g); ekd[lane] = expf(gl - g); egc[lane] = expf(g);
    if (lane == 63) p.GL[ch] = expf(g);
  }
  {
    float* cws = As;
    for (int e = t; e < 1536; e += 256) {
      int j = e / 384, rem = e - j * 384, X = rem >> 7, col = rem & 127;
      cws[e] = p.convw[(size_t)j * 1536 + X * 512 + h * 128 + col];
    }
  }
  __syncthreads();
  {
    const int i = t >> 2, cg = t & 3;
#pragma unroll 1
    for (int X = 0; X < 3; ++X) {
      const ush* src = X == 0 ? p.DQ : (X == 1 ? p.DK : p.DV);
      ush* dstS = X == 0 ? Qs : (X == 1 ? Ks : Vs);
      float y[32];
#pragma unroll
      for (int e = 0; e < 32; ++e) y[e] = 0.f;
#pragma unroll
      for (int j = 0; j < 4; ++j) {
        const int pos = c * 64 + i - 3 + j;
        const float vz = pos >= 0 ? 1.f : 0.f;
        const int posc = pos >= 0 ? pos : 0;
        {
          const u32x4* rp = (const u32x4*)(src + ((size_t)b * SEQL + posc) * 512 + h * 128 + cg * 32);
          const float4* wp = (const float4*)(As + (j * 3 + X) * 128 + cg * 32);
#pragma unroll
          for (int q = 0; q < 4; ++q) {
            u32x4 d = rp[q];
            float4 wa = wp[q * 2], wb = wp[q * 2 + 1];
            wa = scl4(wa, vz); wb = scl4(wb, vz);
            y[q * 8 + 0] += wa.x * bflo(d[0]); y[q * 8 + 1] += wa.y * bfhi(d[0]);
            y[q * 8 + 2] += wa.z * bflo(d[1]); y[q * 8 + 3] += wa.w * bfhi(d[1]);
            y[q * 8 + 4] += wb.x * bflo(d[2]); y[q * 8 + 5] += wb.y * bfhi(d[2]);
            y[q * 8 + 6] += wb.z * bflo(d[3]); y[q * 8 + 7] += wb.w * bfhi(d[3]);
          }
        }
      }
      float ss = 0.f;
#pragma unroll
      for (int e = 0; e < 32; ++e) { y[e] = silu_f(y[e]); ss += y[e] * y[e]; }
      float rs = 1.f;
      if (X < 2) {
        ss += __shfl_xor(ss, 1);
        ss += __shfl_xor(ss, 2);
        rs = rsqrtf(ss + 1e-6f);
        if (X == 0) rs *= 0.08838834764831845f;
      }
#pragma unroll
      for (int q = 0; q < 4; ++q) {
        u32x4 o;
        o[0] = pack2(y[q * 8 + 0] * rs, y[q * 8 + 1] * rs); o[1] = pack2(y[q * 8 + 2] * rs, y[q * 8 + 3] * rs);
        o[2] = pack2(y[q * 8 + 4] * rs, y[q * 8 + 5] * rs); o[3] = pack2(y[q * 8 + 6] * rs, y[q * 8 + 7] * rs);
        *(u32x4*)(dstS + i * 136 + cg * 32 + q * 8) = o;
      }
    }
  }
  __syncthreads();
  {
    const int ti = w >> 1, tj = w & 1, r = lane & 31, hh = lane >> 5;
    f32x16 skk = zero16(), sqk = zero16();
#pragma unroll
    for (int s = 0; s < 8; ++s) {
      bf16x8 ak = *(const bf16x8*)(Ks + (ti * 32 + r) * 136 + s * 16 + hh * 8);
      bf16x8 aq = *(const bf16x8*)(Qs + (ti * 32 + r) * 136 + s * 16 + hh * 8);
      bf16x8 bk = *(const bf16x8*)(Ks + (tj * 32 + r) * 136 + s * 16 + hh * 8);
      skk = MFMA32(ak, bk, skk);
      sqk = MFMA32(aq, bk, sqk);
    }
#pragma unroll
    for (int reg = 0; reg < 16; ++reg) {
      int ii = ti * 32 + crow(reg, hh), jj = tj * 32 + r;
      float dec = (jj <= ii) ? expf(gcs[ii] - gcs[jj]) : 0.f;
      As[ii * 64 + jj] = (jj < ii) ? bts[ii] * skk[reg] * dec : 0.f;
      p.INTRA[ch * 4096 + ii * 64 + jj] = f2bf(sqk[reg] * dec);
    }
  }
  __syncthreads();
  {
    float xs[64];
#pragma unroll
    for (int i = 0; i < 64; ++i) xs[i] = 0.f;
    const int col = t & 127;
    const bool isw = t >= 128;
#pragma unroll
    for (int i = 0; i < 64; ++i) {
      float a = isw ? ebg[i] * bf2f(Ks[i * 136 + col]) : bts[i] * bf2f(Vs[i * 136 + col]);
#pragma unroll
      for (int j4 = 0; j4 < (i + 3) / 4; ++j4) {
        float4 av = *(const float4*)(As + i * 64 + j4 * 4);
        a -= av.x * xs[j4 * 4 + 0];
        a -= av.y * xs[j4 * 4 + 1];
        a -= av.z * xs[j4 * 4 + 2];
        a -= av.w * xs[j4 * 4 + 3];
      }
      xs[i] = a;
    }
    if (!isw) {
#pragma unroll
      for (int q = 0; q < 8; ++q) {
        u32x4 o;
        o[0] = pack2(xs[q * 8 + 0], xs[q * 8 + 1]); o[1] = pack2(xs[q * 8 + 2], xs[q * 8 + 3]);
        o[2] = pack2(xs[q * 8 + 4], xs[q * 8 + 5]); o[3] = pack2(xs[q * 8 + 6], xs[q * 8 + 7]);
        *(u32x4*)(p.UT + ch * 8192 + col * 64 + q * 8) = o;
      }
    } else {
#pragma unroll
      for (int i = 0; i < 64; ++i) p.WG[ch * 8192 + i * 128 + col] = f2bf(xs[i]);
    }
  }
  {
    const int i = t >> 2, cg = t & 3;
    const float e = egc[i];
#pragma unroll
    for (int q = 0; q < 4; ++q) {
      u32x4 d = *(const u32x4*)(Qs + i * 136 + cg * 32 + q * 8);
      u32x4 o;
#pragma unroll
      for (int k = 0; k < 4; ++k) o[k] = pack2(bflo(d[k]) * e, bfhi(d[k]) * e);
      *(u32x4*)(p.QG + ch * 8192 + i * 128 + cg * 32 + q * 8) = o;
    }
    const int d_ = t & 127, ih = t >> 7;
#pragma unroll
    for (int q = 0; q < 4; ++q) {
      float vv[8];
#pragma unroll
      for (int k = 0; k < 8; ++k) { int ii = ih * 32 + q * 8 + k; vv[k] = bf2f(Ks[ii * 136 + d_]) * ekd[ii]; }
      u32x4 o;
      o[0] = pack2(vv[0], vv[1]); o[1] = pack2(vv[2], vv[3]); o[2] = pack2(vv[4], vv[5]); o[3] = pack2(vv[6], vv[7]);
      *(u32x4*)(p.KDT + ch * 8192 + d_ * 64 + ih * 32 + q * 8) = o;
    }
  }
  __syncthreads();
}

DI void dn_scan(const Params& p, int sw, char* smem) {
  int t_ = threadIdx.x;
  asm volatile("" : "+v"(t_));
  const int t = t_, lane = t & 63, w = t >> 6, r = lane & 31, hh = lane >> 5;
  const int bh = sw & 7, slice = sw >> 3;
  const int b = bh >> 2, h = bh & 3;
  ush* ST = (ush*)smem;
  ush* VNT = ST + 32 * 136;
  for (int i = t; i < 32 * 136 / 2; i += 256) ((unsigned*)ST)[i] = 0u;
  f32x16 S = zero16();
  const int wv = w & 1;
  const bool isP = w < 2;
  const ush* Abase = isP ? p.WG : p.QG;
  bf16x8 a32[8], kd[4], in4[4];
  u32x2 u4[4];
  bf16x8 na32[8], nkd[4], nin4[4];
  u32x2 nu4[4];
#pragma unroll
  for (int s = 0; s < 4; ++s) { in4[s] = (bf16x8){0,0,0,0,0,0,0,0}; nin4[s] = in4[s]; u4[s] = (u32x2){0u, 0u}; nu4[s] = u4[s]; }
  {
    const size_t ch = (size_t)bh * 128;
#pragma unroll
    for (int s = 0; s < 8; ++s) a32[s] = *(const bf16x8*)(Abase + ch * 8192 + (32 * wv + r) * 128 + s * 16 + hh * 8);
#pragma unroll
    for (int s = 0; s < 4; ++s) kd[s] = *(const bf16x8*)(p.KDT + ch * 8192 + (32 * w + r) * 64 + s * 16 + hh * 8);
    if (!isP) {
#pragma unroll
      for (int s = 0; s < 4; ++s) in4[s] = *(const bf16x8*)(p.INTRA + ch * 4096 + (32 * wv + r) * 64 + s * 16 + hh * 8);
    } else {
#pragma unroll
      for (int g = 0; g < 4; ++g) u4[g] = *(const u32x2*)(p.UT + ch * 8192 + (slice * 32 + r) * 64 + 32 * wv + 8 * g + 4 * hh);
    }
  }
  __syncthreads();
  for (int c = 0; c < 128; ++c) {
    {
      const size_t ch = (size_t)bh * 128 + (c + 1 < 128 ? c + 1 : 127);
#pragma unroll
      for (int s = 0; s < 8; ++s) na32[s] = *(const bf16x8*)(Abase + ch * 8192 + (32 * wv + r) * 128 + s * 16 + hh * 8);
#pragma unroll
      for (int s = 0; s < 4; ++s) nkd[s] = *(const bf16x8*)(p.KDT + ch * 8192 + (32 * w + r) * 64 + s * 16 + hh * 8);
      if (!isP) {
#pragma unroll
        for (int s = 0; s < 4; ++s) nin4[s] = *(const bf16x8*)(p.INTRA + ch * 4096 + (32 * wv + r) * 64 + s * 16 + hh * 8);
      } else {
#pragma unroll
        for (int g = 0; g < 4; ++g) nu4[g] = *(const u32x2*)(p.UT + ch * 8192 + (slice * 32 + r) * 64 + 32 * wv + 8 * g + 4 * hh);
      }
    }
    const float gl = p.GL[bh * 128 + c];
    f32x16 acc = zero16();
#pragma unroll
    for (int s = 0; s < 8; ++s) {
      bf16x8 bS = *(const bf16x8*)(ST + r * 136 + s * 16 + hh * 8);
      acc = MFMA32(a32[s], bS, acc);
    }
    if (isP) {
#pragma unroll
      for (int g = 0; g < 4; ++g) {
        float v0 = bflo(u4[g][0]) - acc[4 * g + 0], v1 = bfhi(u4[g][0]) - acc[4 * g + 1];
        float v2 = bflo(u4[g][1]) - acc[4 * g + 2], v3 = bfhi(u4[g][1]) - acc[4 * g + 3];
        u32x2 o; o[0] = pack2(v0, v1); o[1] = pack2(v2, v3);
        *(u32x2*)(VNT + r * 72 + 32 * wv + 8 * g + 4 * hh) = o;
      }
    }
    __syncthreads();
    bf16x8 bV[4];
#pragma unroll
    for (int s = 0; s < 4; ++s) bV[s] = *(const bf16x8*)(VNT + r * 72 + s * 16 + hh * 8);
    if (!isP) {
#pragma unroll
      for (int s = 0; s < 4; ++s) acc = MFMA32(in4[s], bV[s], acc);
      float* od = p.OD + ((size_t)b * SEQL + c * 64 + 32 * wv) * 512 + h * 128 + slice * 32 + r;
#pragma unroll
      for (int reg = 0; reg < 16; ++reg) od[(size_t)crow(reg, hh) * 512] = acc[reg];
    }
#pragma unroll
    for (int i = 0; i < 16; ++i) S[i] *= gl;
#pragma unroll
    for (int s = 0; s < 4; ++s) S = MFMA32(kd[s], bV[s], S);
#pragma unroll
    for (int g = 0; g < 4; ++g) {
      u32x2 o; o[0] = pack2(S[4 * g + 0], S[4 * g + 1]); o[1] = pack2(S[4 * g + 2], S[4 * g + 3]);
      *(u32x2*)(ST + r * 136 + 32 * w + 8 * g + 4 * hh) = o;
    }
    __syncthreads();
#pragma unroll
    for (int s = 0; s < 8; ++s) a32[s] = na32[s];
#pragma unroll
    for (int s = 0; s < 4; ++s) { kd[s] = nkd[s]; in4[s] = nin4[s]; u4[s] = nu4[s]; }
  }
}

DI float relu_i(float x) { int v = __float_as_int(x); return __int_as_float(v > 0 ? v : 0); }
DI unsigned ukey(float f) { unsigned u = __float_as_uint(f); return (u & 0x80000000u) ? ~u : (u | 0x80000000u); }

template <int CTRL> DI unsigned dppmov_u(unsigned x) {
  return (unsigned)__builtin_amdgcn_update_dpp(0, (int)x, CTRL, 0xF, 0xF, true);
}
DI unsigned wave_max_u32(unsigned v) {
  unsigned y;
  y = dppmov_u<0xB1>(v); v = v > y ? v : y;
  y = dppmov_u<0x4E>(v); v = v > y ? v : y;
  y = dppmov_u<0x141>(v); v = v > y ? v : y;
  y = dppmov_u<0x140>(v); v = v > y ? v : y;
  const unsigned a = (unsigned)__builtin_amdgcn_readlane((int)v, 0), b = (unsigned)__builtin_amdgcn_readlane((int)v, 16);
  const unsigned c = (unsigned)__builtin_amdgcn_readlane((int)v, 32), d = (unsigned)__builtin_amdgcn_readlane((int)v, 48);
  const unsigned ab = a > b ? a : b, cd = c > d ? c : d;
  return ab > cd ? ab : cd;
}
DI unsigned wave_min_u32(unsigned v) {
  unsigned y;
  y = dppmov_u<0xB1>(v); v = v < y ? v : y;
  y = dppmov_u<0x4E>(v); v = v < y ? v : y;
  y = dppmov_u<0x141>(v); v = v < y ? v : y;
  y = dppmov_u<0x140>(v); v = v < y ? v : y;
  const unsigned a = (unsigned)__builtin_amdgcn_readlane((int)v, 0), b = (unsigned)__builtin_amdgcn_readlane((int)v, 16);
  const unsigned c = (unsigned)__builtin_amdgcn_readlane((int)v, 32), d = (unsigned)__builtin_amdgcn_readlane((int)v, 48);
  const unsigned ab = a < b ? a : b, cd = c < d ? c : d;
  return ab < cd ? ab : cd;
}
DI unsigned inv_ukey(unsigned k) { return (k & 0x80000000u) ? (k & 0x7fffffffu) : ~k; }
DI void compact16(unsigned* bk, unsigned* bi, int& cnt, float& th_out, int lane) {
  const int n = cnt;
  unsigned k[8], ix[8], raw[8];
  unsigned kmx = 0u, kmn = 0xffffffffu;
#pragma unroll
  for (int q = 0; q < 8; ++q) {
    int e = lane + 64 * q; raw[q] = bk[e]; ix[q] = bi[e];
    const unsigned kk = ukey(__uint_as_float(raw[q]));
    const bool v = e < n;
    k[q] = v ? kk : 0u;
    kmx = (v && kk > kmx) ? kk : kmx;
    kmn = (v && kk < kmn) ? kk : kmn;
  }
  kmx = wave_max_u32(kmx); kmn = wave_min_u32(kmn);
  const unsigned diff = kmx ^ kmn;
  unsigned P = kmn;
  if (diff) {
    const int top = 31 - __builtin_clz(diff);
    P = kmx & ~((2u << top) - 1u);
#pragma unroll 1
    for (int bit = top; bit >= 0; --bit) {
      const unsigned tk = P | (1u << bit);
      int c = 0;
#pragma unroll
      for (int q = 0; q < 8; ++q) c += __popcll(__builtin_amdgcn_ballot_w64(k[q] >= tk));
      if (c >= 256) { P = tk; if (c <= 320) break; }
    }
  }
  int base = 0;
#pragma unroll
  for (int q = 0; q < 8; ++q) {
    const bool keep = k[q] >= P && k[q] != 0u;
    unsigned long long m = __builtin_amdgcn_ballot_w64(keep);
    int pre = base + (int)mbcnt64(m);
    if (keep) { bk[pre] = raw[q]; bi[pre] = ix[q]; }
    base += __popcll(m);
  }
  cnt = base;
  th_out = __uint_as_float(inv_ukey(P));
}

DI int final_select(unsigned* bk, unsigned* bi, int cnt, int lane) {
  if (cnt <= 256) return cnt;
  unsigned k[8], ix[8];
  unsigned kmx = 0u, kmn = 0xffffffffu;
#pragma unroll
  for (int q = 0; q < 8; ++q) {
    int e = lane + 64 * q; unsigned kk = ukey(__uint_as_float(bk[e])); ix[q] = bi[e];
    const bool v = e < cnt;
    k[q] = v ? kk : 0u;
    kmx = (v && kk > kmx) ? kk : kmx;
    kmn = (v && kk < kmn) ? kk : kmn;
  }
  kmx = wave_max_u32(kmx); kmn = wave_min_u32(kmn);
  const unsigned diff = kmx ^ kmn;
  unsigned P = kmn;
  if (diff) {
    const int top = 31 - __builtin_clz(diff);
    P = kmx & ~((2u << top) - 1u);
#pragma unroll 1
    for (int bit = top; bit >= 0; --bit) {
      const unsigned tk = P | (1u << bit);
      int c = 0;
#pragma unroll
      for (int q = 0; q < 8; ++q) c += __popcll(__ballot(k[q] >= tk));
      if (c >= 256) { P = tk; if (c == 256) break; }
    }
  }
  int cge = 0, cgt = 0;
#pragma unroll
  for (int q = 0; q < 8; ++q) { cge += __popcll(__ballot(k[q] >= P)); cgt += __popcll(__ballot(k[q] > P)); }
  const bool cut = (cge == 256);
  const int need = 256 - cgt;
  int base = 0, eqseen = 0;
#pragma unroll
  for (int q = 0; q < 8; ++q) {
    bool gt = k[q] > P, eq = k[q] == P, ge = k[q] >= P;
    unsigned long long me = __ballot(eq);
    int epre = eqseen + (int)mbcnt64(me);
    bool keep = cut ? ge : (gt || (eq && epre < need));
    unsigned long long m = __ballot(keep);
    int pre = base + (int)mbcnt64(m);
    if (keep) bi[pre] = ix[q];
    base += __popcll(m);
    eqseen += __popcll(me);
  }
  return base;
}

#define MFMA8(a, b, c) __builtin_amdgcn_mfma_f32_16x16x32_fp8_fp8((a), (b), (c), 0, 0, 0)
typedef __attribute__((ext_vector_type(4))) float f32x4v;
typedef __attribute__((ext_vector_type(2))) float f32x2v;
DI int pidx(int h, int key) { return h * 256 + (key ^ ((h & 1) << 5)); }
DI long mk64(unsigned lo, unsigned hi) { return (long)(((unsigned long long)hi << 32) | lo); }

DI void sparse_attn_query(const Params& p, size_t rowb, size_t row, const unsigned* sel, int nsel, float* pbuf, int lane) {
  const int m16 = lane & 15, kg = lane >> 4;
  long afr[16];
  {
    unsigned alo0, alo1, ahi0, ahi1;
    {
      const u32x4 qa = *(const u32x4*)(p.QA + row * 512 + (m16 & 7) * 64 + kg * 16);
      const u32x4 qb = *(const u32x4*)(p.QA + row * 512 + (m16 & 7) * 64 + kg * 16 + 8);
      alo0 = cvt4_fp8(bflo(qa[0]), bfhi(qa[0]), bflo(qa[1]), bfhi(qa[1]));
      alo1 = cvt4_fp8(bflo(qa[2]), bfhi(qa[2]), bflo(qa[3]), bfhi(qa[3]));
      ahi0 = cvt4_fp8(bflo(qb[0]), bfhi(qb[0]), bflo(qb[1]), bfhi(qb[1]));
      ahi1 = cvt4_fp8(bflo(qb[2]), bfhi(qb[2]), bflo(qb[3]), bfhi(qb[3]));
    }
#pragma unroll
    for (int s = 0; s < 16; ++s) {
      const bool on = (m16 == (s >> 1));
      afr[s] = mk64(on ? ((s & 1) ? ahi0 : alo0) : 0u, on ? ((s & 1) ? ahi1 : alo1) : 0u);
    }
  }
  const int ntile = (nsel + 15) >> 4;
  u32x4 bc[8], bn[8], bnn[8];
  {
    const int j = m16 < nsel ? m16 : nsel - 1;
    const unsigned char* kb = p.K8 + (rowb + sel[j]) * 512 + kg * 16;
#pragma unroll
    for (int h = 0; h < 8; ++h) { bc[h] = *(const u32x4*)(kb + h * 64); bn[h] = bc[h]; bnn[h] = bc[h]; }
    {
      const int kn = 16 + m16;
      const int j1 = kn < nsel ? kn : nsel - 1;
      const unsigned char* kb1 = p.K8 + (rowb + sel[j1]) * 512 + kg * 16;
#pragma unroll
      for (int h = 0; h < 8; ++h) bn[h] = *(const u32x4*)(kb1 + h * 64);
    }
  }
#pragma unroll 1
  for (int T = 0; T < ntile; ++T) {
    {
      const int kn = (T + 2) * 16 + m16;
      const int j = kn < nsel ? kn : nsel - 1;
      const unsigned char* kb = p.K8 + (rowb + sel[j]) * 512 + kg * 16;
#pragma unroll
      for (int h = 0; h < 8; ++h) bnn[h] = *(const u32x4*)(kb + h * 64);
    }
    f32x4v acc0 = {0.f, 0.f, 0.f, 0.f}, acc1 = {0.f, 0.f, 0.f, 0.f};
#pragma unroll
    for (int h = 0; h < 8; ++h) {
      acc0 = MFMA8(afr[2 * h], mk64(bc[h][0], bc[h][1]), acc0);
      acc1 = MFMA8(afr[2 * h + 1], mk64(bc[h][2], bc[h][3]), acc1);
    }
    const int key = T * 16 + m16;
    if (kg < 2) {
      const bool ok = key < nsel;
#pragma unroll
      for (int i = 0; i < 4; ++i) pbuf[pidx(4 * kg + i, key)] = ok ? (acc0[i] + acc1[i]) * 0.125f : -1e30f;
    }
#pragma unroll
    for (int h = 0; h < 8; ++h) { bc[h] = bn[h]; bn[h] = bnn[h]; }
  }
  for (int T = ntile; T < 16; ++T) {
    if (kg < 2) {
#pragma unroll
      for (int i = 0; i < 4; ++i) pbuf[pidx(4 * kg + i, T * 16 + m16)] = -1e30f;
    }
  }
  const int hl = lane >> 3, l8 = lane & 7;
  float inv;
  {
    float4 lg[8];
    float mx = -1e30f;
#pragma unroll
    for (int j = 0; j < 8; ++j) {
      lg[j] = *(const float4*)(pbuf + pidx(hl, 32 * j + 4 * l8));
      mx = fmaxf(mx, fmaxf(fmaxf(lg[j].x, lg[j].y), fmaxf(lg[j].z, lg[j].w)));
    }
    mx = fmaxf(mx, dppmov<0xB1>(mx));
    mx = fmaxf(mx, dppmov<0x4E>(mx));
    mx = fmaxf(mx, dppmov<0x141>(mx));
    float sum = 0.f;
#pragma unroll
    for (int j = 0; j < 8; ++j) {
      lg[j].x = __expf(lg[j].x - mx); lg[j].y = __expf(lg[j].y - mx); lg[j].z = __expf(lg[j].z - mx); lg[j].w = __expf(lg[j].w - mx);
      sum += (lg[j].x + lg[j].y) + (lg[j].z + lg[j].w);
      *(float4*)(pbuf + pidx(hl, 32 * j + 4 * l8)) = lg[j];
    }
    sum = red8(sum);
    inv = 1.f / sum;
  }
  const int kpar = lane >> 5, l5 = lane & 31, h16 = l5 >> 2;
  f32x2v o2[8];
#pragma unroll
  for (int e = 0; e < 8; ++e) o2[e] = (f32x2v){0.f, 0.f};
  const int nstep = (nsel + 15) >> 4;
  const unsigned char* vbase = p.V8 + rowb * 512 + l5 * 16;
  u32x4 vc[8], vn[8], vnn[8];
#define LOADV16(dst, J0)                                                            \
  {                                                                                 \
    _Pragma("unroll") for (int g = 0; g < 4; ++g) {                                 \
      const uint4 i4 = *(const uint4*)(sel + (J0) + 4 * g);                         \
      const unsigned ia = kpar ? i4.y : i4.x, ib = kpar ? i4.w : i4.z;              \
      const unsigned ida = ((J0) + 4 * g + kpar < nsel) ? ia : sel[0];              \
      const unsigned idb = ((J0) + 4 * g + 2 + kpar < nsel) ? ib : sel[0];          \
      dst[2 * g] = *(const u32x4*)(vbase + (size_t)ida * 512);                      \
      dst[2 * g + 1] = *(const u32x4*)(vbase + (size_t)idb * 512);                  \
    }                                                                               \
  }
  LOADV16(vc, 0);
#pragma unroll
  for (int e = 0; e < 8; ++e) { vn[e] = vc[e]; vnn[e] = vc[e]; }
  LOADV16(vn, 16);
#pragma unroll 1
  for (int st = 0; st < nstep; ++st) {
    { const int j0 = (st + 2) * 16; LOADV16(vnn, j0); }
#pragma unroll
    for (int e = 0; e < 8; ++e) {
      const float pj = pbuf[pidx(h16, st * 16 + 2 * e + kpar)];
      const f32x2v pp = {pj, pj};
      const u32x4 v = vc[e];
#pragma unroll
      for (int k = 0; k < 4; ++k) {
        o2[2 * k] = __builtin_elementwise_fma(__builtin_amdgcn_cvt_pk_f32_fp8((int)v[k], false), pp, o2[2 * k]);
        o2[2 * k + 1] = __builtin_elementwise_fma(__builtin_amdgcn_cvt_pk_f32_fp8((int)v[k], true), pp, o2[2 * k + 1]);
      }
    }
#pragma unroll
    for (int e = 0; e < 8; ++e) { vc[e] = vn[e]; vn[e] = vnn[e]; }
  }
#undef LOADV16
  float o[16];
#pragma unroll
  for (int e = 0; e < 8; ++e) { o[2 * e] = o2[e].x; o[2 * e + 1] = o2[e].y; }
#pragma unroll
  for (int e = 0; e < 16; ++e) o[e] += __shfl_xor(o[e], 32);
  const float invh = __shfl(inv, h16 * 8);
  if (kpar == 0) {
    const u32x4 ga0 = *(const u32x4*)(p.GA + row * 512 + l5 * 16);
    const u32x4 ga1 = *(const u32x4*)(p.GA + row * 512 + l5 * 16 + 8);
    u32x4 ov0, ov1;
#pragma unroll
    for (int k = 0; k < 4; ++k) {
      ov0[k] = pack2(o[2 * k] * invh * bflo(ga0[k]), o[2 * k + 1] * invh * bfhi(ga0[k]));
      ov1[k] = pack2(o[8 + 2 * k] * invh * bflo(ga1[k]), o[8 + 2 * k + 1] * invh * bfhi(ga1[k]));
    }
    *(u32x4*)(p.MIX + row * 1024 + l5 * 16) = ov0;
    *(u32x4*)(p.MIX + row * 1024 + l5 * 16 + 8) = ov1;
  }
}

DI void attn_task(const Params& p, int task, char* smem, int qsel = 0) {
  int t_ = threadIdx.x;
  asm volatile("" : "+v"(t_));
  const int t = t_, lane = t & 63, w = t >> 6, r = lane & 31, hh = lane >> 5;
  const int b = task & 1, s16 = 511 - (task >> 1);
  const int tq0 = s16 * 16 + 4 * w;
  const size_t rowb = (size_t)b * SEQL;
  unsigned* bkey = (unsigned*)smem + w * 4096;
  unsigned* bidx = bkey + 2048;
  const int ql = 2 * ((r >> 2) & 1) + (r >> 4), hd = (r & 3) + 4 * ((r >> 3) & 1);
  bf16x8 aq[4];
#pragma unroll
  for (int s = 0; s < 4; ++s) aq[s] = *(const bf16x8*)(p.IQ + (rowb + tq0 + ql) * 512 + hd * 64 + s * 16 + hh * 8);
  float w0[8], w1[8];
#pragma unroll
  for (int i = 0; i < 8; ++i) {
    w0[i] = p.IW[(rowb + tq0 + 2 * hh) * 8 + i];
    w1[i] = p.IW[(rowb + tq0 + 2 * hh + 1) * 8 + i];
  }
  const int tqa = tq0 + 2 * hh, tqb = tqa + 1;
  float tha = -__builtin_inff(), thb = -__builtin_inff();
  int cnt0 = 0, cnt1 = 0, cnt2 = 0, cnt3 = 0;
  const int ntile = ((s16 * 16 + 15) >> 5) + 1;
  const int offa = hh ? 1024 : 0, offb = hh ? 1536 : 512;
  auto tile_body = [&](const f32x16& acc, int kt) -> bool {
    float sa = 0.f, sb = 0.f;
#pragma unroll
    for (int i = 0; i < 8; ++i) {
      sa = fmaf(w0[i], relu_i(acc[i]), sa);
      sb = fmaf(w1[i], relu_i(acc[8 + i]), sb);
    }
    const int key = kt * 32 + r;
    const bool pa = (key <= tqa) & (sa >= tha);
    const bool pb = (key <= tqb) & (sb >= thb);
    {
      const unsigned long long m = __builtin_amdgcn_ballot_w64(pa);
      const int nlo = __popc((unsigned)m), nhi = __popc((unsigned)(m >> 32));
      const int pos = (int)mbcnt64(m) + (hh ? cnt2 - nlo : cnt0);
      if (pa && pos < 512) { bkey[offa + pos] = __float_as_uint(sa); bidx[offa + pos] = (unsigned)key; }
      cnt0 += nlo; cnt2 += nhi;
    }
    {
      const unsigned long long m = __builtin_amdgcn_ballot_w64(pb);
      const int nlo = __popc((unsigned)m), nhi = __popc((unsigned)(m >> 32));
      const int pos = (int)mbcnt64(m) + (hh ? cnt3 - nlo : cnt1);
      if (pb && pos < 512) { bkey[offb + pos] = __float_as_uint(sb); bidx[offb + pos] = (unsigned)key; }
      cnt1 += nlo; cnt3 += nhi;
    }
    return (cnt0 > 448) | (cnt1 > 448) | (cnt2 > 448) | (cnt3 > 448);
  };
  {
    ush* tile = (ush*)(smem + 65536);
    __shared__ int s_need[2];
    const int lkey = t >> 3, lch = t & 7;
    const ush* gsrc = p.IK + (rowb + lkey) * 64 + lch * 8;
    const int npair = (ntile + 1) >> 1;
    const int lp = npair - 1;
    u32x4 g0 = *(const u32x4*)(gsrc), g1 = *(const u32x4*)(gsrc + 2048);
    if (t < 2) s_need[t] = 0;
    for (int kp = 0; kp < npair; ++kp) {
      __syncthreads();
      const int need = kp > 0 ? s_need[(kp - 1) & 1] : 0;
      *(u32x4*)(tile + lkey * 72 + lch * 8) = g0;
      *(u32x4*)(tile + (lkey + 32) * 72 + lch * 8) = g1;
      __syncthreads();
      if (t == 0 && kp > 0) s_need[(kp - 1) & 1] = 0;
      {
        const int pn = kp + 1 < lp ? kp + 1 : lp;
        g0 = *(const u32x4*)(gsrc + (size_t)pn * 4096);
        g1 = *(const u32x4*)(gsrc + (size_t)pn * 4096 + 2048);
      }
      if (need) {
        if (cnt0 > 320) { float th; compact16(bkey, bidx, cnt0, th, lane); if (hh == 0) tha = th; }
        if (cnt1 > 320) { float th; compact16(bkey + 512, bidx + 512, cnt1, th, lane); if (hh == 0) thb = th; }
        if (cnt2 > 320) { float th; compact16(bkey + 1024, bidx + 1024, cnt2, th, lane); if (hh == 1) tha = th; }
        if (cnt3 > 320) { float th; compact16(bkey + 1536, bidx + 1536, cnt3, th, lane); if (hh == 1) thb = th; }
      }
      bf16x8 bta[4], btb[4];
#pragma unroll
      for (int s = 0; s < 4; ++s) {
        bta[s] = *(const bf16x8*)(tile + r * 72 + s * 16 + hh * 8);
        btb[s] = *(const bf16x8*)(tile + (32 + r) * 72 + s * 16 + hh * 8);
      }
      f32x16 acca = zero16(), accb = zero16();
#pragma unroll
      for (int s = 0; s < 4; ++s) { acca = MFMA32(aq[s], bta[s], acca); accb = MFMA32(aq[s], btb[s], accb); }
      bool nd = tile_body(acca, 2 * kp);
      if (2 * kp + 1 < ntile) nd |= tile_body(accb, 2 * kp + 1);
      if (nd && lane == 0) s_need[kp & 1] = 1;
    }
    __syncthreads();
  }
  const bool lo = qsel != 2, hi = qsel != 1;
  int nsel_q[4] = {0, 0, 0, 0};
  {
    int c0 = cnt0 > 512 ? 512 : cnt0, c1 = cnt1 > 512 ? 512 : cnt1, c2 = cnt2 > 512 ? 512 : cnt2, c3 = cnt3 > 512 ? 512 : cnt3;
    if (lo) {
      nsel_q[0] = final_select(bkey, bidx, c0, lane);
      nsel_q[1] = final_select(bkey + 512, bidx + 512, c1, lane);
    }
    if (hi) {
      nsel_q[2] = final_select(bkey + 1024, bidx + 1024, c2, lane);
      nsel_q[3] = final_select(bkey + 1536, bidx + 1536, c3, lane);
    }
  }
  float* pbuf = (float*)bkey;
#pragma unroll
  for (int q = 0; q < 4; ++q) {
    if (q < 2 ? lo : hi) sparse_attn_query(p, rowb, rowb + tq0 + q, bidx + q * 512, nsel_q[q], pbuf, lane);
  }
}

DI void dn_norm(const Params& p, int wave, int nw, int lane) {
  const float4* nwp = (const float4*)(p.dnw + (lane & 15) * 8);
  const float4 n0 = nwp[0], n1 = nwp[1];
  for (int row0 = wave; row0 < NTOK; row0 += 4 * nw) {
    float4 a[4], c[4];
    u32x4 z[4];
#pragma unroll
    for (int j = 0; j < 4; ++j) {
      const int row = row0 + j * nw;
      const float4* op = (const float4*)(p.OD + (size_t)row * 512 + lane * 8);
      a[j] = op[0]; c[j] = op[1];
      z[j] = *(const u32x4*)(p.SZ + (size_t)row * 512 + lane * 8);
    }
#pragma unroll
    for (int j = 0; j < 4; ++j) {
      const int row = row0 + j * nw;
      float ss = a[j].x * a[j].x + a[j].y * a[j].y + a[j].z * a[j].z + a[j].w * a[j].w + c[j].x * c[j].x + c[j].y * c[j].y + c[j].z * c[j].z + c[j].w * c[j].w;
      ss += __shfl_xor(ss, 1); ss += __shfl_xor(ss, 2); ss += __shfl_xor(ss, 4); ss += __shfl_xor(ss, 8);
      const float rs = rsqrtf(ss * (1.f / 128.f) + 1e-6f);
      u32x4 o;
      o[0] = pack2(a[j].x * rs * n0.x * bflo(z[j][0]), a[j].y * rs * n0.y * bfhi(z[j][0]));
      o[1] = pack2(a[j].z * rs * n0.z * bflo(z[j][1]), a[j].w * rs * n0.w * bfhi(z[j][1]));
      o[2] = pack2(c[j].x * rs * n1.x * bflo(z[j][2]), c[j].y * rs * n1.y * bfhi(z[j][2]));
      o[3] = pack2(c[j].z * rs * n1.z * bflo(z[j][3]), c[j].w * rs * n1.w * bfhi(z[j][3]));
      *(u32x4*)(p.MIX + (size_t)row * 1024 + 512 + lane * 8) = o;
    }
  }
}

DI void dn_norm_rows(const Params& p, int row_base, int lane) {
  const float4* nwp = (const float4*)(p.dnw + (lane & 15) * 8);
  const float4 n0 = nwp[0], n1 = nwp[1];
#pragma unroll 1
  for (int r4 = 0; r4 < 16; r4 += 4) {
    float4 a[4], c[4];
    u32x4 z[4];
#pragma unroll
    for (int j = 0; j < 4; ++j) {
      const int row = row_base + r4 + j;
      const float4* op = (const float4*)(p.OD + (size_t)row * 512 + lane * 8);
      a[j] = op[0]; c[j] = op[1];
      z[j] = *(const u32x4*)(p.SZ + (size_t)row * 512 + lane * 8);
    }
#pragma unroll
    for (int j = 0; j < 4; ++j) {
      const int row = row_base + r4 + j;
      float ss = a[j].x * a[j].x + a[j].y * a[j].y + a[j].z * a[j].z + a[j].w * a[j].w + c[j].x * c[j].x + c[j].y * c[j].y + c[j].z * c[j].z + c[j].w * c[j].w;
      ss += __shfl_xor(ss, 1); ss += __shfl_xor(ss, 2); ss += __shfl_xor(ss, 4); ss += __shfl_xor(ss, 8);
      const float rs = rsqrtf(ss * (1.f / 128.f) + 1e-6f);
      u32x4 o;
      o[0] = pack2(a[j].x * rs * n0.x * bflo(z[j][0]), a[j].y * rs * n0.y * bfhi(z[j][0]));
      o[1] = pack2(a[j].z * rs * n0.z * bflo(z[j][1]), a[j].w * rs * n0.w * bfhi(z[j][1]));
      o[2] = pack2(c[j].x * rs * n1.x * bflo(z[j][2]), c[j].y * rs * n1.y * bfhi(z[j][2]));
      o[3] = pack2(c[j].z * rs * n1.z * bflo(z[j][3]), c[j].w * rs * n1.w * bfhi(z[j][3]));
      *(u32x4*)(p.MIX + (size_t)row * 1024 + 512 + lane * 8) = o;
    }
  }
}

DI void outproj_tile(const Params& p, int tile, char* smem) {
  const int mt = tile >> 3, nt = tile & 7;
  const int m0 = mt * 128, n0 = nt * 128;
  f32x16 acc[2][2];
  gemm_tile(p.MIX, p.Wo, m0, n0, 1024, smem, acc);
  (void)stage_rows(acc, smem);
  int t_ = threadIdx.x;
  asm volatile("" : "+v"(t_));
  const int t = t_, c4 = t & 31, r0 = t >> 5;
  const float* Cs = (const float*)smem;
#pragma unroll 4
  for (int ps = 0; ps < 16; ++ps) {
    const int rr = ps * 8 + r0;
    const float4 f = *(const float4*)(Cs + rr * 132 + c4 * 4);
    const size_t off = (size_t)(m0 + rr) * 1024 + n0 + c4 * 4;
    const float4 xv = *(const float4*)(p.x + off);
    *(float4*)(p.out + off) = make_float4(xv.x + f.x, xv.y + f.y, xv.z + f.z, xv.w + f.w);
  }
}

#define XB_TMO      128
#define XB_XCNT(j)  (256  + 64 * (j))
#define XB_XSUB(j)  (1280 + 64 * (j))
#define XB_XGEN(j)  (2304 + 64 * (j))
#define XB_TOP      3328
#define XB_TOPGEN   3392
#define XCD_BAR_WORDS 3456
#define XB_SPIN_CAP (1u << 20)
#define LAS __attribute__((address_space(3)))
DI unsigned xb_ld(unsigned* p) { return __hip_atomic_load(p, __ATOMIC_RELAXED, __HIP_MEMORY_SCOPE_AGENT); }
DI unsigned xb_add(unsigned* p, unsigned v) { return __hip_atomic_fetch_add(p, v, __ATOMIC_RELAXED, __HIP_MEMORY_SCOPE_AGENT); }
DI unsigned xb_xcc_id() { return (unsigned)__builtin_amdgcn_s_getreg((3 << 11) | 20) & 0xFu; }
#define XB_SPIN(cond, bar) do { unsigned _sp = 0; while (cond) { __builtin_amdgcn_s_sleep(1); \
    if ((++_sp & 255u) == 0u) { if (xb_ld(&(bar)[XB_TMO])) break; if (_sp > XB_SPIN_CAP) { atomicAdd(&(bar)[XB_TMO], 1u); break; } } } } while (0)
struct XcdBarrier { unsigned* bar; unsigned x; volatile LAS unsigned* st; };
DI XcdBarrier xcd_barrier_post(unsigned* bar, volatile LAS unsigned* st) {
  XcdBarrier b; b.bar = bar; b.x = xb_xcc_id(); b.st = st;
  if (threadIdx.x == 0) (void)xb_add(&bar[XB_XCNT(b.x)], 1u);
  return b;
}
DI void xcd_barrier_complete(unsigned* bar, unsigned x, unsigned& nloc, unsigned& nx) {
  const unsigned G = gridDim.x * gridDim.y * gridDim.z;
  unsigned sum, cnt, mine, sp = 0u;
  for (;;) {
    sum = 0u; cnt = 0u; mine = 0u;
#pragma unroll
    for (unsigned j = 0; j < 16; ++j) { const unsigned c = xb_ld(&bar[XB_XCNT(j)]); sum += c; cnt += (c > 0u) ? 1u : 0u; mine = (j == x) ? c : mine; }
    if (sum == G) break;
    __builtin_amdgcn_s_sleep(1);
    if ((++sp & 255u) == 0u) { if (xb_ld(&bar[XB_TMO])) break; if (sp > XB_SPIN_CAP) { atomicAdd(&bar[XB_TMO], 1u); break; } }
  }
  nloc = mine > 0u ? mine : 1u; nx = cnt > 0u ? cnt : 1u;
}
DI void xcd_barrier(const XcdBarrier& b) {
  asm volatile("s_waitcnt vmcnt(0)" ::: "memory");
  __syncthreads();
  if (threadIdx.x == 0) {
    unsigned* bar = b.bar;
    __builtin_amdgcn_s_waitcnt(0);
    unsigned nloc = b.st[0], nx = b.st[1];
    if (nloc == 0u) { xcd_barrier_complete(bar, b.x, nloc, nx); b.st[0] = nloc; b.st[1] = nx; }
    const unsigned old = xb_add(&bar[XB_XSUB(b.x)], 1u);
    const unsigned gen = old / nloc;
    if (old + 1u == (gen + 1u) * nloc) {
      __builtin_amdgcn_fence(__ATOMIC_RELEASE, "agent");
      asm volatile("s_waitcnt vmcnt(0)" ::: "memory");
      const unsigned og = xb_add(&bar[XB_TOP], 1u);
      const unsigned tg = og / nx;
      if (og + 1u == (tg + 1u) * nx) xb_add(&bar[XB_TOPGEN], 1u);
      else XB_SPIN(xb_ld(&bar[XB_TOPGEN]) == tg, bar);
      __builtin_amdgcn_fence(__ATOMIC_ACQUIRE, "agent");
      xb_add(&bar[XB_XGEN(b.x)], 1u);
      asm volatile("s_waitcnt vmcnt(0)" ::: "memory");
    } else {
      XB_SPIN(xb_ld(&bar[XB_XGEN(b.x)]) == gen, bar);
      __builtin_amdgcn_fence(__ATOMIC_ACQUIRE, "agent");
      asm volatile("s_waitcnt vmcnt(0)" ::: "memory");
    }
  }
  __syncthreads();
}

__global__ void __launch_bounds__(256, 2) k_prep(Params p) {
  __shared__ __attribute__((aligned(16))) char smem[SMEM_BYTES];
  phase_prep(p, blockIdx.x * 256 + threadIdx.x, gridDim.x * 256, smem);
}
__global__ void __launch_bounds__(256, 2) k_inproj(Params p) {
  __shared__ __attribute__((aligned(16))) char smem[SMEM_BYTES];
  for (int tile = blockIdx.x; tile < 128 * 37; tile += gridDim.x) inproj_tile(p, tile, smem);
}
__global__ void __launch_bounds__(256, 2) k_dnprep(Params p) {
  __shared__ __attribute__((aligned(16))) char smem[SMEM_BYTES];
  for (int task = blockIdx.x; task < 1024; task += gridDim.x) dn_prep_task(p, task, smem);
}
__global__ void __launch_bounds__(256, 2) k_scan(Params p) {
  __shared__ __attribute__((aligned(16))) char smem[SMEM_BYTES];
  dn_scan(p, blockIdx.x, smem);
}
__global__ void __launch_bounds__(256, 2) k_attn(Params p) {
  __shared__ __attribute__((aligned(16))) char smem[SMEM_BYTES];
  for (int task = blockIdx.x; task < 1024; task += gridDim.x) attn_task(p, task, smem);
}
__global__ void __launch_bounds__(256, 2) k_dnnorm(Params p) {
  dn_norm(p, (blockIdx.x * 256 + threadIdx.x) >> 6, (gridDim.x * 256) >> 6, threadIdx.x & 63);
}
__global__ void __launch_bounds__(256, 2) k_outproj(Params p) {
  __shared__ __attribute__((aligned(16))) char smem[SMEM_BYTES];
  for (int tile = blockIdx.x; tile < 1024; tile += gridDim.x) outproj_tile(p, tile, smem);
}

__global__ void __launch_bounds__(256, 2) k_mega(Params p) {
  __shared__ __attribute__((aligned(16))) char smem[SMEM_BYTES];
  __shared__ uint4 xb_words;
  __shared__ int s_task;
  cg::grid_group grid = cg::this_grid();
  if (threadIdx.x == 0) xb_words = make_uint4(0u, 0u, 0u, 0u);
  __syncthreads();
  XcdBarrier xb = xcd_barrier_post(p.counters + 64, (volatile LAS unsigned*)&xb_words);
  const int gtid = blockIdx.x * 256 + threadIdx.x, gsize = gridDim.x * 256;
  phase_prep(p, gtid, gsize, smem);
  if (p.use_cg_sync) grid.sync();
  xcd_barrier(xb);
  for (int tile = blockIdx.x; tile < 128 * 19; tile += gridDim.x) gemm_tile256<0>(p, tile, smem);
  xcd_barrier(xb);
  for (int task = blockIdx.x; task < 1024; task += gridDim.x) dn_prep_task(p, task, smem);
  xcd_barrier(xb);
  if (blockIdx.x < 32) {
    __builtin_amdgcn_s_setprio(3);
    dn_scan(p, blockIdx.x, smem);
    __builtin_amdgcn_s_setprio(0);
    asm volatile("s_waitcnt vmcnt(0)" ::: "memory");
    __syncthreads();
    if (threadIdx.x == 0) {
      __builtin_amdgcn_fence(__ATOMIC_RELEASE, "agent");
      asm volatile("s_waitcnt vmcnt(0)" ::: "memory");
      atomicAdd(&p.counters[32], 1u);
    }
    __syncthreads();
  }
  {
    int pb = (int)((xb.x >> 2) & 1u);
    int tries = 0;
    while (tries < 2) {
      if (threadIdx.x == 0) s_task = (int)atomicAdd(&p.counters[pb], 1u);
      __syncthreads();
      const int tk = s_task;
      __syncthreads();
      if (tk >= 512 + QSPLIT) { pb ^= 1; ++tries; continue; }
      if (tk < 512 - QSPLIT) attn_task(p, tk * 2 + pb, smem, 0);
      else { const int j = tk - (512 - QSPLIT); attn_task(p, ((512 - QSPLIT) + (j >> 1)) * 2 + pb, smem, 1 + (j & 1)); }
    }
  }
  {
    if (threadIdx.x == 0) {
      unsigned sp = 0;
      while (__hip_atomic_load(&p.counters[32], __ATOMIC_RELAXED, __HIP_MEMORY_SCOPE_AGENT) < 32u) {
        __builtin_amdgcn_s_sleep(4);
        if (++sp > (1u << 22)) break;
      }
      __builtin_amdgcn_fence(__ATOMIC_ACQUIRE, "agent");
      asm volatile("s_waitcnt vmcnt(0)" ::: "memory");
    }
    __syncthreads();
    while (true) {
      if (threadIdx.x == 0) s_task = (int)atomicAdd(&p.counters[33], 1u);
      __syncthreads();
      const int ck = s_task;
      __syncthreads();
      if (ck >= 256) break;
      int tn_ = threadIdx.x;
      asm volatile("" : "+v"(tn_));
      dn_norm_rows(p, ck * 64 + (tn_ >> 6) * 16, tn_ & 63);
    }
  }
  xcd_barrier(xb);
  for (int tile = blockIdx.x; tile < 512; tile += gridDim.x) gemm_tile256<1>(p, tile, smem);
}

extern "C" void kernel_launch(void* const* d_in, const int* in_sizes, int n_in, void* d_out, int out_size, void* d_ws,
                              size_t ws_size, hipStream_t stream) {
  Params p{};
  p.x = (const float*)d_in[0]; p.ln_w = (const float*)d_in[1]; p.w_in = (const float*)d_in[2];
  p.aqw = (const float*)d_in[3]; p.akw = (const float*)d_in[4]; p.ikw = (const float*)d_in[5];
  p.ikb = (const float*)d_in[6]; p.convw = (const float*)d_in[7]; p.alog = (const float*)d_in[8];
  p.dtb = (const float*)d_in[9]; p.dnw = (const float*)d_in[10]; p.w_out = (const float*)d_in[11];
  p.out = (float*)d_out;
  char* ws = (char*)d_ws;
  const size_t MB = 1u << 20;
  p.Wt = (ush*)(ws + 0);
  p.Wo = (ush*)(ws + 10 * MB);
  p.XB = (ush*)(ws + 12 * MB);
  p.MIX = (ush*)(ws + 12 * MB);
  p.QA = (ush*)(ws + 45 * MB); p.KA = (ush*)(ws + 61 * MB); p.VA = (ush*)(ws + 77 * MB);
  p.GA = (ush*)(ws + 93 * MB); p.IQ = (ush*)(ws + 109 * MB); p.DQ = (ush*)(ws + 125 * MB);
  p.DK = (ush*)(ws + 141 * MB); p.DV = (ush*)(ws + 157 * MB); p.SZ = (ush*)(ws + 173 * MB);
  p.IK = (ush*)(ws + 189 * MB);
  p.IW = (float*)(ws + 191 * MB);
  p.BETA = (float*)(ws + 191 * MB + 512 * 1024);
  p.G = (float*)(ws + 191 * MB + 768 * 1024);
  p.INTRA = (ush*)(ws + 192 * MB);
  p.GL = (float*)(ws + 200 * MB);
  p.OD = (float*)(ws + 201 * MB);
  p.counters = (unsigned*)(ws + 233 * MB);
  p.K8 = (unsigned char*)(ws + 61 * MB);
  p.V8 = (unsigned char*)(ws + 77 * MB);
  char* o8 = (char*)d_out;
  p.UT = (ush*)(o8); p.WG = (ush*)(o8 + 16 * MB); p.QG = (ush*)(o8 + 32 * MB); p.KDT = (ush*)(o8 + 48 * MB);

#if MEGA
  static int grid_blocks = 0;
  if (!grid_blocks) {
    int dev = 0, cus = 0, per_cu = 0;
    hipGetDevice(&dev);
    hipDeviceGetAttribute(&cus, hipDeviceAttributeMultiprocessorCount, dev);
    hipOccupancyMaxActiveBlocksPerMultiprocessor(&per_cu, k_mega, 256, 0);
    if (per_cu > 2) per_cu = 2;
    grid_blocks = cus * per_cu;
  }
  hipMemsetAsync(p.counters, 0, (64 + XCD_BAR_WORDS) * sizeof(unsigned), stream);
  void* args[] = {&p};
  hipError_t e = hipLaunchCooperativeKernel((void*)k_mega, dim3(grid_blocks), dim3(256), args, 0, stream);
  if (e != hipSuccess) fprintf(stderr, "cooperative launch failed: %s (grid %d)\n", hipGetErrorString(e), grid_blocks);
#else
  k_prep<<<1024, 256, 0, stream>>>(p);
  k_inproj<<<128 * 37, 256, 0, stream>>>(p);
  k_dnprep<<<1024, 256, 0, stream>>>(p);
  k_scan<<<32, 256, 0, stream>>>(p);
  k_attn<<<1024, 256, 0, stream>>>(p);
  k_dnnorm<<<1024, 256, 0, stream>>>(p);
  k_outproj<<<1024, 256, 0, stream>>>(p);
#endif
}
```

```cpp
#include <hip/hip_runtime.h>
#include <hip/hip_cooperative_groups.h>
#include <cstdio>
#include <cstdint>
namespace cg = cooperative_groups;

#ifndef MEGA
#define MEGA 1
#endif

#define DI __device__ __forceinline__
typedef __attribute__((ext_vector_type(8))) short bf16x8;
typedef __attribute__((ext_vector_type(16))) float f32x16;
typedef __attribute__((ext_vector_type(4))) unsigned u32x4;
typedef __attribute__((ext_vector_type(2))) unsigned u32x2;
typedef __attribute__((ext_vector_type(2))) __bf16 bf2_t;
typedef unsigned short ush;
#define MFMA32(a, b, c) __builtin_amdgcn_mfma_f32_32x32x16_bf16((a), (b), (c), 0, 0, 0)

constexpr int NTOK = 16384;
constexpr int SEQL = 8192;
constexpr int NP = 4736;
constexpr int DIN = 4688;
constexpr int SMEM_BYTES = 74752;
constexpr int QSPLIT = 48;

struct Params {
  const float *x, *ln_w, *w_in, *aqw, *akw, *ikw, *ikb, *convw, *alog, *dtb, *dnw, *w_out;
  float* out;
  ush *Wt, *Wo, *XB, *MIX, *QA, *KA, *VA, *GA, *IQ, *DQ, *DK, *DV, *SZ, *IK, *INTRA;
  ush *UT, *WG, *QG, *KDT;
  float *IW, *BETA, *G, *GL, *OD;
  unsigned* counters;
  unsigned char *K8, *V8;
  int use_cg_sync, pad0;
};

DI ush f2bf(float x) { return __builtin_bit_cast(ush, (__bf16)x); }
DI float bf2f(ush b) { return __uint_as_float(((unsigned)b) << 16); }
DI unsigned pack2(float a, float b) { bf2_t v = {(__bf16)a, (__bf16)b}; return __builtin_bit_cast(unsigned, v); }
DI float bflo(unsigned u) { return __uint_as_float(u << 16); }
DI float bfhi(unsigned u) { return __uint_as_float(u & 0xffff0000u); }
DI int crow(int reg, int h) { return (reg & 3) + 8 * (reg >> 2) + 4 * h; }
DI float silu_f(float v) { return v / (1.f + __expf(-v)); }
DI f32x16 zero16() { f32x16 z; for (int i = 0; i < 16; ++i) z[i] = 0.f; return z; }

template <int CTRL> DI float dppmov(float x) {
  return __int_as_float(__builtin_amdgcn_update_dpp(0, __float_as_int(x), CTRL, 0xF, 0xF, true));
}
DI float red8(float d) {
  d += dppmov<0xB1>(d);
  d += dppmov<0x4E>(d);
  d += dppmov<0x141>(d);
  return d;
}
DI unsigned mbcnt64(unsigned long long m) {
  return __builtin_amdgcn_mbcnt_hi((unsigned)(m >> 32), __builtin_amdgcn_mbcnt_lo((unsigned)m, 0u));
}
DI int mapcol(int n) {
  if (n < 2560) return n;
  if (n < 4608) return n + 72;
  if (n < 4680) return n - 2048;
  if (n < 4688) return n;
  return -1;
}

DI void phase_prep(const Params& p, int gtid, int gsize, char* smem) {
  {
    unsigned* Ts = (unsigned*)smem;
    ush* Th = (ush*)smem;
    int t_ = threadIdx.x;
    asm volatile("" : "+v"(t_));
    const int t = t_;
    for (int tt = blockIdx.x; tt < 1472; tt += gridDim.x) {
      const bool is_in = tt < 1216;
      const int id = is_in ? tt : tt - 1216;
      const int nt = is_in ? id % 76 : (id & 15), kt = is_in ? id / 76 : (id >> 4);
      const float* src = is_in ? p.w_in : p.w_out;
      const int ld = is_in ? DIN : 1024;
      ush* dst = is_in ? p.Wt : p.Wo;
      {
        const int n = t & 63, ks = t >> 6;
        const int oc = is_in ? mapcol(nt * 64 + n) : nt * 64 + n;
#pragma unroll
        for (int it = 0; it < 16; ++it) {
          int k = it * 4 + ks;
          float v = oc >= 0 ? src[(size_t)(kt * 64 + k) * ld + oc] : 0.f;
          Th[n * 66 + k] = f2bf(v);
        }
      }
      __syncthreads();
      {
        const int n = t >> 2, kq = t & 3;
        u32x4 a, b;
#pragma unroll
        for (int i = 0; i < 4; ++i) { a[i] = Ts[n * 33 + kq * 8 + i]; b[i] = Ts[n * 33 + kq * 8 + 4 + i]; }
        u32x4* dp = (u32x4*)(dst + (size_t)(nt * 64 + n) * 1024 + kt * 64 + kq * 16);
        dp[0] = a; dp[1] = b;
      }
      __syncthreads();
    }
  }
  int wave = gtid >> 6, lane = gtid & 63, nw = gsize >> 6;
  for (int row = wave; row < NTOK; row += nw) {
    const float4* xr = (const float4*)(p.x + (size_t)row * 1024);
    float4 a[4];
    float ss = 0.f;
#pragma unroll
    for (int i = 0; i < 4; ++i) {
      a[i] = xr[lane + 64 * i];
      ss += a[i].x * a[i].x + a[i].y * a[i].y + a[i].z * a[i].z + a[i].w * a[i].w;
    }
#pragma unroll
    for (int o = 1; o < 64; o <<= 1) ss += __shfl_xor(ss, o);
    float rs = rsqrtf(ss * (1.f / 1024.f) + 1e-6f);
#pragma unroll
    for (int i = 0; i < 4; ++i) {
      float4 lw = ((const float4*)p.ln_w)[lane + 64 * i];
      u32x2 o;
      o[0] = pack2(a[i].x * rs * lw.x, a[i].y * rs * lw.y);
      o[1] = pack2(a[i].z * rs * lw.z, a[i].w * rs * lw.w);
      *(u32x2*)(p.XB + (size_t)row * 1024 + (lane + 64 * i) * 4) = o;
    }
  }
}

DI void gemm_tile(const ush* __restrict__ A, const ush* __restrict__ B, int m0, int n0, int K, char* smem,
                  f32x16 (&acc)[2][2]) {
  ush* As = (ush*)smem;
  ush* Bs = As + 128 * 72;
  int t_ = threadIdx.x;
  asm volatile("" : "+v"(t_));
  const int t = t_, lane = t & 63, w = t >> 6, wm = w >> 1, wn = w & 1, r = lane & 31, h = lane >> 5;
  u32x4 ra[4], rb[4];
#pragma unroll
  for (int i = 0; i < 2; ++i)
#pragma unroll
    for (int j = 0; j < 2; ++j) acc[i][j] = zero16();
#pragma unroll
  for (int i = 0; i < 4; ++i) {
    int c = t + 256 * i, row = c >> 3, kc = c & 7;
    ra[i] = *(const u32x4*)(A + (size_t)(m0 + row) * K + kc * 8);
    rb[i] = *(const u32x4*)(B + (size_t)(n0 + row) * K + kc * 8);
  }
  for (int k0 = 0; k0 < K; k0 += 64) {
    __syncthreads();
#pragma unroll
    for (int i = 0; i < 4; ++i) {
      int c = t + 256 * i, row = c >> 3, kc = c & 7;
      *(u32x4*)(As + row * 72 + kc * 8) = ra[i];
      *(u32x4*)(Bs + row * 72 + kc * 8) = rb[i];
    }
    __syncthreads();
    if (k0 + 64 < K) {
#pragma unroll
      for (int i = 0; i < 4; ++i) {
        int c = t + 256 * i, row = c >> 3, kc = c & 7;
        ra[i] = *(const u32x4*)(A + (size_t)(m0 + row) * K + k0 + 64 + kc * 8);
        rb[i] = *(const u32x4*)(B + (size_t)(n0 + row) * K + k0 + 64 + kc * 8);
      }
    }
#pragma unroll
    for (int s = 0; s < 4; ++s) {
      bf16x8 af[2], bfr[2];
#pragma unroll
      for (int i = 0; i < 2; ++i) af[i] = *(const bf16x8*)(As + (wm * 64 + i * 32 + r) * 72 + s * 16 + h * 8);
#pragma unroll
      for (int j = 0; j < 2; ++j) bfr[j] = *(const bf16x8*)(Bs + (wn * 64 + j * 32 + r) * 72 + s * 16 + h * 8);
#pragma unroll
      for (int i = 0; i < 2; ++i)
#pragma unroll
        for (int j = 0; j < 2; ++j) acc[i][j] = MFMA32(af[i], bfr[j], acc[i][j]);
    }
  }
  __syncthreads();
}

DI const float* stage_rows(f32x16 (&acc)[2][2], char* smem) {
  float* Cs = (float*)smem;
  int t_ = threadIdx.x;
  asm volatile("" : "+v"(t_));
  const int t = t_, lane = t & 63, w = t >> 6, wm = w >> 1, wn = w & 1, r = lane & 31, h = lane >> 5;
#pragma unroll
  for (int i = 0; i < 2; ++i)
#pragma unroll
    for (int j = 0; j < 2; ++j)
#pragma unroll
      for (int reg = 0; reg < 16; ++reg)
        Cs[(wm * 64 + i * 32 + crow(reg, h)) * 132 + wn * 64 + j * 32 + r] = acc[i][j][reg];
  __syncthreads();
  return Cs + (t & 127) * 132 + (t >> 7) * 64;
}
DI u32x4 pack8(float4 a, float4 b) {
  u32x4 o;
  o[0] = pack2(a.x, a.y); o[1] = pack2(a.z, a.w); o[2] = pack2(b.x, b.y); o[3] = pack2(b.z, b.w);
  return o;
}
DI float4 mul4(float4 a, float4 b) { return make_float4(a.x * b.x, a.y * b.y, a.z * b.z, a.w * b.w); }
DI float4 scl4(float4 a, float s) { return make_float4(a.x * s, a.y * s, a.z * s, a.w * s); }
DI unsigned cvt4_fp8(float a, float b, float c, float d) {
  int r = 0;
  r = __builtin_amdgcn_cvt_pk_fp8_f32(a, b, r, false);
  r = __builtin_amdgcn_cvt_pk_fp8_f32(c, d, r, true);
  return (unsigned)r;
}
DI float4 silu4(float4 a) { return make_float4(silu_f(a.x), silu_f(a.y), silu_f(a.z), silu_f(a.w)); }

DI void inproj_epilogue(const Params& p, int row, int nt, int half, const float4* cv) {
  if (nt < 36) {
    const int grp = nt >> 2;
    const int col = (nt & 3) * 128 + half * 64;
    ush* dst = (ush*)((char*)p.QA + (size_t)grp * (16u << 20));
    u32x4* dp = (u32x4*)(dst + (size_t)row * 512 + col);
    if (grp == 0) {
      float ss = 0.f;
#pragma unroll
      for (int q = 0; q < 16; ++q) { float4 f = cv[q]; ss += f.x * f.x + f.y * f.y + f.z * f.z + f.w * f.w; }
      const float rs = rsqrtf(ss * (1.f / 64.f) + 1e-6f);
      const float4* nw = (const float4*)p.aqw;
#pragma unroll
      for (int q = 0; q < 8; ++q)
        dp[q] = pack8(scl4(mul4(cv[2 * q], nw[2 * q]), rs), scl4(mul4(cv[2 * q + 1], nw[2 * q + 1]), rs));
    } else if (grp == 1) {
      float ss = 0.f;
#pragma unroll
      for (int q = 0; q < 16; ++q) { float4 f = cv[q]; ss += f.x * f.x + f.y * f.y + f.z * f.z + f.w * f.w; }
      const float rs = rsqrtf(ss * (1.f / 64.f) + 1e-6f);
      const float4* nw = (const float4*)p.akw;
      u32x4* d8 = (u32x4*)(p.K8 + (size_t)row * 512 + col);
#pragma unroll
      for (int q = 0; q < 4; ++q) {
        u32x4 o;
#pragma unroll
        for (int k = 0; k < 4; ++k) { float4 f = scl4(mul4(cv[4 * q + k], nw[4 * q + k]), rs); o[k] = cvt4_fp8(f.x, f.y, f.z, f.w); }
        d8[q] = o;
      }
    } else if (grp == 2) {
      u32x4* d8 = (u32x4*)(p.V8 + (size_t)row * 512 + col);
#pragma unroll
      for (int q = 0; q < 4; ++q) {
        u32x4 o;
#pragma unroll
        for (int k = 0; k < 4; ++k) { float4 f = cv[4 * q + k]; o[k] = cvt4_fp8(f.x, f.y, f.z, f.w); }
        d8[q] = o;
      }
    } else if (grp == 3 || grp == 8) {
#pragma unroll
      for (int q = 0; q < 8; ++q) dp[q] = pack8(silu4(cv[2 * q]), silu4(cv[2 * q + 1]));
    } else {
#pragma unroll
      for (int q = 0; q < 8; ++q) dp[q] = pack8(cv[2 * q], cv[2 * q + 1]);
    }
  } else {
    if (half == 0) {
      float mu = 0.f;
#pragma unroll
      for (int q = 0; q < 16; ++q) { float4 f = cv[q]; mu += f.x + f.y + f.z + f.w; }
      mu *= (1.f / 64.f);
      float var = 0.f;
#pragma unroll
      for (int q = 0; q < 16; ++q) {
        float4 f = cv[q];
        var += (f.x - mu) * (f.x - mu) + (f.y - mu) * (f.y - mu) + (f.z - mu) * (f.z - mu) + (f.w - mu) * (f.w - mu);
      }
      float rs = rsqrtf(var * (1.f / 64.f) + 1e-6f);
      const float4* kw = (const float4*)p.ikw;
      const float4* kb = (const float4*)p.ikb;
      u32x4* dp = (u32x4*)(p.IK + (size_t)row * 64);
#pragma unroll
      for (int q = 0; q < 8; ++q) {
        float4 a = cv[2 * q], c = cv[2 * q + 1], wa = kw[2 * q], wc = kw[2 * q + 1], ba = kb[2 * q], bc = kb[2 * q + 1];
        a = make_float4((a.x - mu) * rs * wa.x + ba.x, (a.y - mu) * rs * wa.y + ba.y, (a.z - mu) * rs * wa.z + ba.z, (a.w - mu) * rs * wa.w + ba.w);
        c = make_float4((c.x - mu) * rs * wc.x + bc.x, (c.y - mu) * rs * wc.y + bc.y, (c.z - mu) * rs * wc.z + bc.z, (c.w - mu) * rs * wc.w + bc.w);
        dp[q] = pack8(a, c);
      }
    } else {
      const float* v = (const float*)cv;
#pragma unroll
      for (int c = 0; c < 8; ++c) p.IW[(size_t)row * 8 + c] = v[c] * 0.044194173824159216f;
#pragma unroll
      for (int c = 0; c < 4; ++c) {
        p.BETA[(size_t)row * 4 + c] = 1.f / (1.f + expf(-v[8 + c]));
        float xx = v[12 + c] + p.dtb[c];
        float sp = xx > 20.f ? xx : log1pf(expf(xx));
        p.G[(size_t)row * 4 + c] = -expf(p.alog[c]) * sp;
      }
    }
  }
}

DI void inproj_tile(const Params& p, int tile, char* smem) {
  const int mt = tile / 37, nt = tile % 37;
  const int m0 = mt * 128, n0 = nt * 128;
  f32x16 acc[2][2];
  gemm_tile(p.XB, p.Wt, m0, n0, 1024, smem, acc);
  const float4* cv = (const float4*)stage_rows(acc, smem);
  const int t = threadIdx.x;
  inproj_epilogue(p, m0 + (t & 127), nt, t >> 7, cv);
}

template <int MODE> DI void gemm_tile256(const Params& p, int tile, char* smem) {
  const int mt = MODE == 0 ? (tile & 127) : (tile >> 2), n2 = MODE == 0 ? (tile >> 7) : (tile & 3);
  const int m0 = mt * 128, n0 = n2 * 256;
  ush* As = (ush*)smem;
  ush* Bs = As + 128 * 72;
  int t_ = threadIdx.x;
  asm volatile("" : "+v"(t_));
  const int t = t_, lane = t & 63, w = t >> 6, wm = w >> 1, wn = w & 1, r = lane & 31, h = lane >> 5;
  f32x16 acc[2][4];
#pragma unroll
  for (int i = 0; i < 2; ++i)
#pragma unroll
    for (int j = 0; j < 4; ++j) acc[i][j] = zero16();
  u32x4 ra[4], rb[8];
  const int lrow = t >> 3, lkc = t & 7;
  const unsigned voff = (unsigned)(lrow * 1024 + lkc * 8) * 2u;
  const char* abase = (const char*)((MODE == 0 ? p.XB : p.MIX) + (size_t)m0 * 1024);
  const char* bbase = (const char*)((MODE == 0 ? p.Wt : p.Wo) + (size_t)n0 * 1024);
#pragma unroll
  for (int i = 0; i < 4; ++i) ra[i] = *(const u32x4*)(abase + (size_t)i * 65536 + voff);
#pragma unroll
  for (int i = 0; i < 8; ++i) rb[i] = *(const u32x4*)(bbase + (size_t)i * 65536 + voff);
  for (int k0 = 0; k0 < 1024; k0 += 64) {
    __syncthreads();
#pragma unroll
    for (int i = 0; i < 4; ++i) *(u32x4*)(As + (lrow + 32 * i) * 72 + lkc * 8) = ra[i];
#pragma unroll
    for (int i = 0; i < 8; ++i) *(u32x4*)(Bs + (lrow + 32 * i) * 72 + lkc * 8) = rb[i];
    __syncthreads();
    {
      const int kn = k0 + 64 < 1024 ? k0 + 64 : k0;
#pragma unroll
      for (int i = 0; i < 4; ++i) ra[i] = *(const u32x4*)(abase + ((size_t)i * 65536 + (size_t)kn * 2) + voff);
#pragma unroll
      for (int i = 0; i < 8; ++i) rb[i] = *(const u32x4*)(bbase + ((size_t)i * 65536 + (size_t)kn * 2) + voff);
    }
#pragma unroll
    for (int s = 0; s < 4; ++s) {
      bf16x8 af[2], bfr[4];
#pragma unroll
      for (int i = 0; i < 2; ++i) af[i] = *(const bf16x8*)(As + (wm * 64 + i * 32 + r) * 72 + s * 16 + h * 8);
#pragma unroll
      for (int j = 0; j < 4; ++j) bfr[j] = *(const bf16x8*)(Bs + (wn * 128 + j * 32 + r) * 72 + s * 16 + h * 8);
#pragma unroll
      for (int i = 0; i < 2; ++i)
#pragma unroll
        for (int j = 0; j < 4; ++j) acc[i][j] = MFMA32(af[i], bfr[j], acc[i][j]);
    }
  }
  __syncthreads();
  const int nt = __builtin_amdgcn_readfirstlane(2 * n2 + wn);
  if (MODE == 1 || nt < 37) {
    float* Cw = (float*)smem + w * 4384;
#pragma unroll
    for (int jp = 0; jp < 2; ++jp) {
#pragma unroll
      for (int i = 0; i < 2; ++i)
#pragma unroll
        for (int jj = 0; jj < 2; ++jj)
#pragma unroll
          for (int reg = 0; reg < 16; ++reg)
            Cw[(i * 32 + crow(reg, h)) * 68 + jj * 32 + r] = acc[i][2 * jp + jj][reg];
      if (MODE == 0) {
        inproj_epilogue(p, m0 + wm * 64 + lane, nt, jp, (const float4*)(Cw + lane * 68));
      } else {
        const int c4 = lane & 15, r4 = lane >> 4;
#pragma unroll 4
        for (int ps = 0; ps < 16; ++ps) {
          const int lr = ps * 4 + r4;
          const float4 f = *(const float4*)(Cw + lr * 68 + c4 * 4);
          const size_t off = (size_t)(m0 + wm * 64 + lr) * 1024 + n0 + wn * 128 + jp * 64 + c4 * 4;
          const float4 xv = *(const float4*)(p.x + off);
          *(float4*)(p.out + off) = make_float4(xv.x + f.x, xv.y + f.y, xv.z + f.z, xv.w + f.w);
        }
      }
    }
  }
  __syncthreads();
}

DI void dn_prep_task(const Params& p, int task, char* smem) {
  int t_ = threadIdx.x;
  asm volatile("" : "+v"(t_));
  const int t = t_, lane = t & 63, w = t >> 6;
  const int h = task & 3, c = (task >> 2) & 127, b = task >> 9;
  const size_t ch = (size_t)(b * 4 + h) * 128 + c;
  const size_t row0 = (size_t)b * SEQL + c * 64;
  ush* Qs = (ush*)smem;
  ush* Ks = Qs + 64 * 136;
  ush* Vs = Ks + 64 * 136;
  float* As = (float*)(smem + 52224);
  float* gcs = (float*)(smem + 68608);
  float* bts = gcs + 64;
  float* ebg = bts + 64;
  float* ekd = ebg + 64;
  float* egc = ekd + 64;
  if (w == 0) {
    float g = p.G[(row0 + lane) * 4 + h];
#pragma unroll
    for (int o = 1; o < 64; o <<= 1) { float y = __shfl_up(g, o); if (lane >= o) g += y; }
    float bt = p.BETA[(row0 + lane) * 4 + h];
    float gl = __shfl(g, 63);
    gcs[lane] = g; bts[lane] = bt; ebg[lane] = bt * expf(g); ekd[lane] = expf(gl - g); egc[lane] = expf(g);
    if (lane == 63) p.GL[ch] = expf(g);
  }
  {
    float* cws = As;
    for (int e = t; e < 1536; e += 256) {
      int j = e / 384, rem = e - j * 384, X = rem >> 7, col = rem & 127;
      cws[e] = p.convw[(size_t)j * 1536 + X * 512 + h * 128 + col];
    }
  }
  __syncthreads();
  {
    const int i = t >> 2, cg = t & 3;
#pragma unroll 1
    for (int X = 0; X < 3; ++X) {
      const ush* src = X == 0 ? p.DQ : (X == 1 ? p.DK : p.DV);
      ush* dstS = X == 0 ? Qs : (X == 1 ? Ks : Vs);
      float y[32];
#pragma unroll
      for (int e = 0; e < 32; ++e) y[e] = 0.f;
#pragma unroll
      for (int j = 0; j < 4; ++j) {
        const int pos = c * 64 + i - 3 + j;
        const float vz = pos >= 0 ? 1.f : 0.f;
        const int posc = pos >= 0 ? pos : 0;
        {
          const u32x4* rp = (const u32x4*)(src + ((size_t)b * SEQL + posc) * 512 + h * 128 + cg * 32);
          const float4* wp = (const float4*)(As + (j * 3 + X) * 128 + cg * 32);
#pragma unroll
          for (int q = 0; q < 4; ++q) {
            u32x4 d = rp[q];
            float4 wa = wp[q * 2], wb = wp[q * 2 + 1];
            wa = scl4(wa, vz); wb = scl4(wb, vz);
            y[q * 8 + 0] += wa.x * bflo(d[0]); y[q * 8 + 1] += wa.y * bfhi(d[0]);
            y[q * 8 + 2] += wa.z * bflo(d[1]); y[q * 8 + 3] += wa.w * bfhi(d[1]);
            y[q * 8 + 4] += wb.x * bflo(d[2]); y[q * 8 + 5] += wb.y * bfhi(d[2]);
            y[q * 8 + 6] += wb.z * bflo(d[3]); y[q * 8 + 7] += wb.w * bfhi(d[3]);
          }
        }
      }
      float ss = 0.f;
#pragma unroll
      for (int e = 0; e < 32; ++e) { y[e] = silu_f(y[e]); ss += y[e] * y[e]; }
      float rs = 1.f;
      if (X < 2) {
        ss += __shfl_xor(ss, 1);
        ss += __shfl_xor(ss, 2);
        rs = rsqrtf(ss + 1e-6f);
        if (X == 0) rs *= 0.08838834764831845f;
      }
#pragma unroll
      for (int q = 0; q < 4; ++q) {
        u32x4 o;
        o[0] = pack2(y[q * 8 + 0] * rs, y[q * 8 + 1] * rs); o[1] = pack2(y[q * 8 + 2] * rs, y[q * 8 + 3] * rs);
        o[2] = pack2(y[q * 8 + 4] * rs, y[q * 8 + 5] * rs); o[3] = pack2(y[q * 8 + 6] * rs, y[q * 8 + 7] * rs);
        *(u32x4*)(dstS + i * 136 + cg * 32 + q * 8) = o;
      }
    }
  }
  __syncthreads();
  {
    const int ti = w >> 1, tj = w & 1, r = lane & 31, hh = lane >> 5;
    f32x16 skk = zero16(), sqk = zero16();
#pragma unroll
    for (int s = 0; s < 8; ++s) {
      bf16x8 ak = *(const bf16x8*)(Ks + (ti * 32 + r) * 136 + s * 16 + hh * 8);
      bf16x8 aq = *(const bf16x8*)(Qs + (ti * 32 + r) * 136 + s * 16 + hh * 8);
      bf16x8 bk = *(const bf16x8*)(Ks + (tj * 32 + r) * 136 + s * 16 + hh * 8);
      skk = MFMA32(ak, bk, skk);
      sqk = MFMA32(aq, bk, sqk);
    }
#pragma unroll
    for (int reg = 0; reg < 16; ++reg) {
      int ii = ti * 32 + crow(reg, hh), jj = tj * 32 + r;
      float dec = (jj <= ii) ? expf(gcs[ii] - gcs[jj]) : 0.f;
      As[ii * 64 + jj] = (jj < ii) ? bts[ii] * skk[reg] * dec : 0.f;
      p.INTRA[ch * 4096 + ii * 64 + jj] = f2bf(sqk[reg] * dec);
    }
  }
  __syncthreads();
  {
    float xs[64];
#pragma unroll
    for (int i = 0; i < 64; ++i) xs[i] = 0.f;
    const int col = t & 127;
    const bool isw = t >= 128;
#pragma unroll
    for (int i = 0; i < 64; ++i) {
      float a = isw ? ebg[i] * bf2f(Ks[i * 136 + col]) : bts[i] * bf2f(Vs[i * 136 + col]);
#pragma unroll
      for (int j4 = 0; j4 < (i + 3) / 4; ++j4) {
        float4 av = *(const float4*)(As + i * 64 + j4 * 4);
        a -= av.x * xs[j4 * 4 + 0];
        a -= av.y * xs[j4 * 4 + 1];
        a -= av.z * xs[j4 * 4 + 2];
        a -= av.w * xs[j4 * 4 + 3];
      }
      xs[i] = a;
    }
    if (!isw) {
#pragma unroll
      for (int q = 0; q < 8; ++q) {
        u32x4 o;
        o[0] = pack2(xs[q * 8 + 0], xs[q * 8 + 1]); o[1] = pack2(xs[q * 8 + 2], xs[q * 8 + 3]);
        o[2] = pack2(xs[q * 8 + 4], xs[q * 8 + 5]); o[3] = pack2(xs[q * 8 + 6], xs[q * 8 + 7]);
        *(u32x4*)(p.UT + ch * 8192 + col * 64 + q * 8) = o;
      }
    } else {
#pragma unroll
      for (int i = 0; i < 64; ++i) p.WG[ch * 8192 + i * 128 + col] = f2bf(xs[i]);
    }
  }
  {
    const int i = t >> 2, cg = t & 3;
    const float e = egc[i];
#pragma unroll
    for (int q = 0; q < 4; ++q) {
      u32x4 d = *(const u32x4*)(Qs + i * 136 + cg * 32 + q * 8);
      u32x4 o;
#pragma unroll
      for (int k = 0; k < 4; ++k) o[k] = pack2(bflo(d[k]) * e, bfhi(d[k]) * e);
      *(u32x4*)(p.QG + ch * 8192 + i * 128 + cg * 32 + q * 8) = o;
    }
    const int d_ = t & 127, ih = t >> 7;
#pragma unroll
    for (int q = 0; q < 4; ++q) {
      float vv[8];
#pragma unroll
      for (int k = 0; k < 8; ++k) { int ii = ih * 32 + q * 8 + k; vv[k] = bf2f(Ks[ii * 136 + d_]) * ekd[ii]; }
      u32x4 o;
      o[0] = pack2(vv[0], vv[1]); o[1] = pack2(vv[2], vv[3]); o[2] = pack2(vv[4], vv[5]); o[3] = pack2(vv[6], vv[7]);
      *(u32x4*)(p.KDT + ch * 8192 + d_ * 64 + ih * 32 + q * 8) = o;
    }
  }
  __syncthreads();
}

DI void dn_scan(const Params& p, int sw, char* smem) {
  int t_ = threadIdx.x;
  asm volatile("" : "+v"(t_));
  const int t = t_, lane = t & 63, w = t >> 6, r = lane & 31, hh = lane >> 5;
  const int bh = sw & 7, slice = sw >> 3;
  const int b = bh >> 2, h = bh & 3;
  ush* ST = (ush*)smem;
  ush* VNT = ST + 32 * 136;
  for (int i = t; i < 32 * 136 / 2; i += 256) ((unsigned*)ST)[i] = 0u;
  f32x16 S = zero16();
  const int wv = w & 1;
  const bool isP = w < 2;
  const ush* Abase = isP ? p.WG : p.QG;
  bf16x8 a32[8], kd[4], in4[4];
  u32x2 u4[4];
  bf16x8 na32[8], nkd[4], nin4[4];
  u32x2 nu4[4];
#pragma unroll
  for (int s = 0; s < 4; ++s) { in4[s] = (bf16x8){0,0,0,0,0,0,0,0}; nin4[s] = in4[s]; u4[s] = (u32x2){0u, 0u}; nu4[s] = u4[s]; }
  {
    const size_t ch = (size_t)bh * 128;
#pragma unroll
    for (int s = 0; s < 8; ++s) a32[s] = *(const bf16x8*)(Abase + ch * 8192 + (32 * wv + r) * 128 + s * 16 + hh * 8);
#pragma unroll
    for (int s = 0; s < 4; ++s) kd[s] = *(const bf16x8*)(p.KDT + ch * 8192 + (32 * w + r) * 64 + s * 16 + hh * 8);
    if (!isP) {
#pragma unroll
      for (int s = 0; s < 4; ++s) in4[s] = *(const bf16x8*)(p.INTRA + ch * 4096 + (32 * wv + r) * 64 + s * 16 + hh * 8);
    } else {
#pragma unroll
      for (int g = 0; g < 4; ++g) u4[g] = *(const u32x2*)(p.UT + ch * 8192 + (slice * 32 + r) * 64 + 32 * wv + 8 * g + 4 * hh);
    }
  }
  __syncthreads();
  for (int c = 0; c < 128; ++c) {
    {
      const size_t ch = (size_t)bh * 128 + (c + 1 < 128 ? c + 1 : 127);
#pragma unroll
      for (int s = 0; s < 8; ++s) na32[s] = *(const bf16x8*)(Abase + ch * 8192 + (32 * wv + r) * 128 + s * 16 + hh * 8);
#pragma unroll
      for (int s = 0; s < 4; ++s) nkd[s] = *(const bf16x8*)(p.KDT + ch * 8192 + (32 * w + r) * 64 + s * 16 + hh * 8);
      if (!isP) {
#pragma unroll
        for (int s = 0; s < 4; ++s) nin4[s] = *(const bf16x8*)(p.INTRA + ch * 4096 + (32 * wv + r) * 64 + s * 16 + hh * 8);
      } else {
#pragma unroll
        for (int g = 0; g < 4; ++g) nu4[g] = *(const u32x2*)(p.UT + ch * 8192 + (slice * 32 + r) * 64 + 32 * wv + 8 * g + 4 * hh);
      }
    }
    const float gl = p.GL[bh * 128 + c];
    f32x16 acc = zero16();
#pragma unroll
    for (int s = 0; s < 8; ++s) {
      bf16x8 bS = *(const bf16x8*)(ST + r * 136 + s * 16 + hh * 8);
      acc = MFMA32(a32[s], bS, acc);
    }
    if (isP) {
#pragma unroll
      for (int g = 0; g < 4; ++g) {
        float v0 = bflo(u4[g][0]) - acc[4 * g + 0], v1 = bfhi(u4[g][0]) - acc[4 * g + 1];
        float v2 = bflo(u4[g][1]) - acc[4 * g + 2], v3 = bfhi(u4[g][1]) - acc[4 * g + 3];
        u32x2 o; o[0] = pack2(v0, v1); o[1] = pack2(v2, v3);
        *(u32x2*)(VNT + r * 72 + 32 * wv + 8 * g + 4 * hh) = o;
      }
    }
    __syncthreads();
    bf16x8 bV[4];
#pragma unroll
    for (int s = 0; s < 4; ++s) bV[s] = *(const bf16x8*)(VNT + r * 72 + s * 16 + hh * 8);
    if (!isP) {
#pragma unroll
      for (int s = 0; s < 4; ++s) acc = MFMA32(in4[s], bV[s], acc);
      float* od = p.OD + ((size_t)b * SEQL + c * 64 + 32 * wv) * 512 + h * 128 + slice * 32 + r;
#pragma unroll
      for (int reg = 0; reg < 16; ++reg) od[(size_t)crow(reg, hh) * 512] = acc[reg];
    }
#pragma unroll
    for (int i = 0; i < 16; ++i) S[i] *= gl;
#pragma unroll
    for (int s = 0; s < 4; ++s) S = MFMA32(kd[s], bV[s], S);
#pragma unroll
    for (int g = 0; g < 4; ++g) {
      u32x2 o; o[0] = pack2(S[4 * g + 0], S[4 * g + 1]); o[1] = pack2(S[4 * g + 2], S[4 * g + 3]);
      *(u32x2*)(ST + r * 136 + 32 * w + 8 * g + 4 * hh) = o;
    }
    __syncthreads();
#pragma unroll
    for (int s = 0; s < 8; ++s) a32[s] = na32[s];
#pragma unroll
    for (int s = 0; s < 4; ++s) { kd[s] = nkd[s]; in4[s] = nin4[s]; u4[s] = nu4[s]; }
  }
}

DI float relu_i(float x) { int v = __float_as_int(x); return __int_as_float(v > 0 ? v : 0); }
DI unsigned ukey(float f) { unsigned u = __float_as_uint(f); return (u & 0x80000000u) ? ~u : (u | 0x80000000u); }

template <int CTRL> DI unsigned dppmov_u(unsigned x) {
  return (unsigned)__builtin_amdgcn_update_dpp(0, (int)x, CTRL, 0xF, 0xF, true);
}
DI unsigned wave_max_u32(unsigned v) {
  unsigned y;
  y = dppmov_u<0xB1>(v); v = v > y ? v : y;
  y = dppmov_u<0x4E>(v); v = v > y ? v : y;
  y = dppmov_u<0x141>(v); v = v > y ? v : y;
  y = dppmov_u<0x140>(v); v = v > y ? v : y;
  const unsigned a = (unsigned)__builtin_amdgcn_readlane((int)v, 0), b = (unsigned)__builtin_amdgcn_readlane((int)v, 16);
  const unsigned c = (unsigned)__builtin_amdgcn_readlane((int)v, 32), d = (unsigned)__builtin_amdgcn_readlane((int)v, 48);
  const unsigned ab = a > b ? a : b, cd = c > d ? c : d;
  return ab > cd ? ab : cd;
}
DI unsigned wave_min_u32(unsigned v) {
  unsigned y;
  y = dppmov_u<0xB1>(v); v = v < y ? v : y;
  y = dppmov_u<0x4E>(v); v = v < y ? v : y;
  y = dppmov_u<0x141>(v); v = v < y ? v : y;
  y = dppmov_u<0x140>(v); v = v < y ? v : y;
  const unsigned a = (unsigned)__builtin_amdgcn_readlane((int)v, 0), b = (unsigned)__builtin_amdgcn_readlane((int)v, 16);
  const unsigned c = (unsigned)__builtin_amdgcn_readlane((int)v, 32), d = (unsigned)__builtin_amdgcn_readlane((int)v, 48);
  const unsigned ab = a < b ? a : b, cd = c < d ? c : d;
  return ab < cd ? ab : cd;
}
DI unsigned inv_ukey(unsigned k) { return (k & 0x80000000u) ? (k & 0x7fffffffu) : ~k; }
DI void compact16(unsigned* bk, unsigned* bi, int& cnt, float& th_out, int lane) {
  const int n = cnt;
  unsigned k[8], ix[8], raw[8];
  unsigned kmx = 0u, kmn = 0xffffffffu;
#pragma unroll
  for (int q = 0; q < 8; ++q) {
    int e = lane + 64 * q; raw[q] = bk[e]; ix[q] = bi[e];
    const unsigned kk = ukey(__uint_as_float(raw[q]));
    const bool v = e < n;
    k[q] = v ? kk : 0u;
    kmx = (v && kk > kmx) ? kk : kmx;
    kmn = (v && kk < kmn) ? kk : kmn;
  }
  kmx = wave_max_u32(kmx); kmn = wave_min_u32(kmn);
  const unsigned diff = kmx ^ kmn;
  unsigned P = kmn;
  if (diff) {
    const int top = 31 - __builtin_clz(diff);
    P = kmx & ~((2u << top) - 1u);
#pragma unroll 1
    for (int bit = top; bit >= 0; --bit) {
      const unsigned tk = P | (1u << bit);
      int c = 0;
#pragma unroll
      for (int q = 0; q < 8; ++q) c += __popcll(__builtin_amdgcn_ballot_w64(k[q] >= tk));
      if (c >= 256) { P = tk; if (c <= 288) break; }
    }
  }
  int base = 0;
#pragma unroll
  for (int q = 0; q < 8; ++q) {
    const bool keep = k[q] >= P && k[q] != 0u;
    unsigned long long m = __builtin_amdgcn_ballot_w64(keep);
    int pre = base + (int)mbcnt64(m);
    if (keep) { bk[pre] = raw[q]; bi[pre] = ix[q]; }
    base += __popcll(m);
  }
  cnt = base;
  th_out = __uint_as_float(inv_ukey(P));
}

DI int final_select(unsigned* bk, unsigned* bi, int cnt, int lane) {
  if (cnt <= 256) return cnt;
  unsigned k[8], ix[8];
  unsigned kmx = 0u, kmn = 0xffffffffu;
#pragma unroll
  for (int q = 0; q < 8; ++q) {
    int e = lane + 64 * q; unsigned kk = ukey(__uint_as_float(bk[e])); ix[q] = bi[e];
    const bool v = e < cnt;
    k[q] = v ? kk : 0u;
    kmx = (v && kk > kmx) ? kk : kmx;
    kmn = (v && kk < kmn) ? kk : kmn;
  }
  kmx = wave_max_u32(kmx); kmn = wave_min_u32(kmn);
  const unsigned diff = kmx ^ kmn;
  unsigned P = kmn;
  if (diff) {
    const int top = 31 - __builtin_clz(diff);
    P = kmx & ~((2u << top) - 1u);
#pragma unroll 1
    for (int bit = top; bit >= 0; --bit) {
      const unsigned tk = P | (1u << bit);
      int c = 0;
#pragma unroll
      for (int q = 0; q < 8; ++q) c += __popcll(__ballot(k[q] >= tk));
      if (c >= 256) { P = tk; if (c == 256) break; }
    }
  }
  int cge = 0, cgt = 0;
#pragma unroll
  for (int q = 0; q < 8; ++q) { cge += __popcll(__ballot(k[q] >= P)); cgt += __popcll(__ballot(k[q] > P)); }
  const bool cut = (cge == 256);
  const int need = 256 - cgt;
  int base = 0, eqseen = 0;
#pragma unroll
  for (int q = 0; q < 8; ++q) {
    bool gt = k[q] > P, eq = k[q] == P, ge = k[q] >= P;
    unsigned long long me = __ballot(eq);
    int epre = eqseen + (int)mbcnt64(me);
    bool keep = cut ? ge : (gt || (eq && epre < need));
    unsigned long long m = __ballot(keep);
    int pre = base + (int)mbcnt64(m);
    if (keep) bi[pre] = ix[q];
    base += __popcll(m);
    eqseen += __popcll(me);
  }
  return base;
}

#define MFMA8(a, b, c) __builtin_amdgcn_mfma_f32_16x16x32_fp8_fp8((a), (b), (c), 0, 0, 0)
typedef __attribute__((ext_vector_type(4))) float f32x4v;
typedef __attribute__((ext_vector_type(2))) float f32x2v;
DI int pidx(int h, int key) { return h * 256 + (key ^ ((h & 1) << 5)); }
DI long mk64(unsigned lo, unsigned hi) { return (long)(((unsigned long long)hi << 32) | lo); }

DI void sparse_attn_query(const Params& p, size_t rowb, size_t row, const unsigned* sel, int nsel, float* pbuf, int lane) {
  const int m16 = lane & 15, kg = lane >> 4;
  long afr[16];
  {
    unsigned alo0, alo1, ahi0, ahi1;
    {
      const u32x4 qa = *(const u32x4*)(p.QA + row * 512 + (m16 & 7) * 64 + kg * 16);
      const u32x4 qb = *(const u32x4*)(p.QA + row * 512 + (m16 & 7) * 64 + kg * 16 + 8);
      alo0 = cvt4_fp8(bflo(qa[0]), bfhi(qa[0]), bflo(qa[1]), bfhi(qa[1]));
      alo1 = cvt4_fp8(bflo(qa[2]), bfhi(qa[2]), bflo(qa[3]), bfhi(qa[3]));
      ahi0 = cvt4_fp8(bflo(qb[0]), bfhi(qb[0]), bflo(qb[1]), bfhi(qb[1]));
      ahi1 = cvt4_fp8(bflo(qb[2]), bfhi(qb[2]), bflo(qb[3]), bfhi(qb[3]));
    }
#pragma unroll
    for (int s = 0; s < 16; ++s) {
      const bool on = (m16 == (s >> 1));
      afr[s] = mk64(on ? ((s & 1) ? ahi0 : alo0) : 0u, on ? ((s & 1) ? ahi1 : alo1) : 0u);
    }
  }
  const int ntile = (nsel + 15) >> 4;
  u32x4 bc[8], bn[8], bnn[8];
  {
    const int j = m16 < nsel ? m16 : nsel - 1;
    const unsigned char* kb = p.K8 + (rowb + sel[j]) * 512 + kg * 16;
#pragma unroll
    for (int h = 0; h < 8; ++h) { bc[h] = *(const u32x4*)(kb + h * 64); bn[h] = bc[h]; bnn[h] = bc[h]; }
    {
      const int kn = 16 + m16;
      const int j1 = kn < nsel ? kn : nsel - 1;
      const unsigned char* kb1 = p.K8 + (rowb + sel[j1]) * 512 + kg * 16;
#pragma unroll
      for (int h = 0; h < 8; ++h) bn[h] = *(const u32x4*)(kb1 + h * 64);
    }
  }
#pragma unroll 1
  for (int T = 0; T < ntile; ++T) {
    {
      const int kn = (T + 2) * 16 + m16;
      const int j = kn < nsel ? kn : nsel - 1;
      const unsigned char* kb = p.K8 + (rowb + sel[j]) * 512 + kg * 16;
#pragma unroll
      for (int h = 0; h < 8; ++h) bnn[h] = *(const u32x4*)(kb + h * 64);
    }
    f32x4v acc0 = {0.f, 0.f, 0.f, 0.f}, acc1 = {0.f, 0.f, 0.f, 0.f};
#pragma unroll
    for (int h = 0; h < 8; ++h) {
      acc0 = MFMA8(afr[2 * h], mk64(bc[h][0], bc[h][1]), acc0);
      acc1 = MFMA8(afr[2 * h + 1], mk64(bc[h][2], bc[h][3]), acc1);
    }
    const int key = T * 16 + m16;
    if (kg < 2) {
      const bool ok = key < nsel;
#pragma unroll
      for (int i = 0; i < 4; ++i) pbuf[pidx(4 * kg + i, key)] = ok ? (acc0[i] + acc1[i]) * 0.125f : -1e30f;
    }
#pragma unroll
    for (int h = 0; h < 8; ++h) { bc[h] = bn[h]; bn[h] = bnn[h]; }
  }
  for (int T = ntile; T < 16; ++T) {
    if (kg < 2) {
#pragma unroll
      for (int i = 0; i < 4; ++i) pbuf[pidx(4 * kg + i, T * 16 + m16)] = -1e30f;
    }
  }
  const int hl = lane >> 3, l8 = lane & 7;
  float inv;
  {
    float4 lg[8];
    float mx = -1e30f;
#pragma unroll
    for (int j = 0; j < 8; ++j) {
      lg[j] = *(const float4*)(pbuf + pidx(hl, 32 * j + 4 * l8));
      mx = fmaxf(mx, fmaxf(fmaxf(lg[j].x, lg[j].y), fmaxf(lg[j].z, lg[j].w)));
    }
    mx = fmaxf(mx, dppmov<0xB1>(mx));
    mx = fmaxf(mx, dppmov<0x4E>(mx));
    mx = fmaxf(mx, dppmov<0x141>(mx));
    float sum = 0.f;
#pragma unroll
    for (int j = 0; j < 8; ++j) {
      lg[j].x = __expf(lg[j].x - mx); lg[j].y = __expf(lg[j].y - mx); lg[j].z = __expf(lg[j].z - mx); lg[j].w = __expf(lg[j].w - mx);
      sum += (lg[j].x + lg[j].y) + (lg[j].z + lg[j].w);
      *(float4*)(pbuf + pidx(hl, 32 * j + 4 * l8)) = lg[j];
    }
    sum = red8(sum);
    inv = 1.f / sum;
  }
  const int kpar = lane >> 5, l5 = lane & 31, h16 = l5 >> 2;
  f32x2v o2[8];
#pragma unroll
  for (int e = 0; e < 8; ++e) o2[e] = (f32x2v){0.f, 0.f};
  const int nstep = (nsel + 15) >> 4;
  const unsigned char* vbase = p.V8 + rowb * 512 + l5 * 16;
  u32x4 vc[8], vn[8], vnn[8];
#define LOADV16(dst, J0)                                                            \
  {                                                                                 \
    _Pragma("unroll") for (int g = 0; g < 4; ++g) {                                 \
      const uint4 i4 = *(const uint4*)(sel + (J0) + 4 * g);                         \
      const unsigned ia = kpar ? i4.y : i4.x, ib = kpar ? i4.w : i4.z;              \
      const unsigned ida = ((J0) + 4 * g + kpar < nsel) ? ia : sel[0];              \
      const unsigned idb = ((J0) + 4 * g + 2 + kpar < nsel) ? ib : sel[0];          \
      dst[2 * g] = *(const u32x4*)(vbase + (size_t)ida * 512);                      \
      dst[2 * g + 1] = *(const u32x4*)(vbase + (size_t)idb * 512);                  \
    }                                                                               \
  }
  LOADV16(vc, 0);
#pragma unroll
  for (int e = 0; e < 8; ++e) { vn[e] = vc[e]; vnn[e] = vc[e]; }
  LOADV16(vn, 16);
#pragma unroll 1
  for (int st = 0; st < nstep; ++st) {
    { const int j0 = (st + 2) * 16; LOADV16(vnn, j0); }
#pragma unroll
    for (int e = 0; e < 8; ++e) {
      const float pj = pbuf[pidx(h16, st * 16 + 2 * e + kpar)];
      const f32x2v pp = {pj, pj};
      const u32x4 v = vc[e];
#pragma unroll
      for (int k = 0; k < 4; ++k) {
        o2[2 * k] = __builtin_elementwise_fma(__builtin_amdgcn_cvt_pk_f32_fp8((int)v[k], false), pp, o2[2 * k]);
        o2[2 * k + 1] = __builtin_elementwise_fma(__builtin_amdgcn_cvt_pk_f32_fp8((int)v[k], true), pp, o2[2 * k + 1]);
      }
    }
#pragma unroll
    for (int e = 0; e < 8; ++e) { vc[e] = vn[e]; vn[e] = vnn[e]; }
  }
#undef LOADV16
  float o[16];
#pragma unroll
  for (int e = 0; e < 8; ++e) { o[2 * e] = o2[e].x; o[2 * e + 1] = o2[e].y; }
#pragma unroll
  for (int e = 0; e < 16; ++e) o[e] += __shfl_xor(o[e], 32);
  const float invh = __shfl(inv, h16 * 8);
  if (kpar == 0) {
    const u32x4 ga0 = *(const u32x4*)(p.GA + row * 512 + l5 * 16);
    const u32x4 ga1 = *(const u32x4*)(p.GA + row * 512 + l5 * 16 + 8);
    u32x4 ov0, ov1;
#pragma unroll
    for (int k = 0; k < 4; ++k) {
      ov0[k] = pack2(o[2 * k] * invh * bflo(ga0[k]), o[2 * k + 1] * invh * bfhi(ga0[k]));
      ov1[k] = pack2(o[8 + 2 * k] * invh * bflo(ga1[k]), o[8 + 2 * k + 1] * invh * bfhi(ga1[k]));
    }
    *(u32x4*)(p.MIX + row * 1024 + l5 * 16) = ov0;
    *(u32x4*)(p.MIX + row * 1024 + l5 * 16 + 8) = ov1;
  }
}

DI void attn_task(const Params& p, int task, char* smem, int qsel = 0) {
  int t_ = threadIdx.x;
  asm volatile("" : "+v"(t_));
  const int t = t_, lane = t & 63, w = t >> 6, r = lane & 31, hh = lane >> 5;
  const int b = task & 1, s16 = 511 - (task >> 1);
  const int tq0 = s16 * 16 + 4 * w;
  const size_t rowb = (size_t)b * SEQL;
  unsigned* bkey = (unsigned*)smem + w * 4096;
  unsigned* bidx = bkey + 2048;
  const int ql = 2 * ((r >> 2) & 1) + (r >> 4), hd = (r & 3) + 4 * ((r >> 3) & 1);
  bf16x8 aq[4];
#pragma unroll
  for (int s = 0; s < 4; ++s) aq[s] = *(const bf16x8*)(p.IQ + (rowb + tq0 + ql) * 512 + hd * 64 + s * 16 + hh * 8);
  float w0[8], w1[8];
#pragma unroll
  for (int i = 0; i < 8; ++i) {
    w0[i] = p.IW[(rowb + tq0 + 2 * hh) * 8 + i];
    w1[i] = p.IW[(rowb + tq0 + 2 * hh + 1) * 8 + i];
  }
  const int tqa = tq0 + 2 * hh, tqb = tqa + 1;
  float tha = -__builtin_inff(), thb = -__builtin_inff();
  int cnt0 = 0, cnt1 = 0, cnt2 = 0, cnt3 = 0;
  const int ntile = ((s16 * 16 + 15) >> 5) + 1;
  const int offa = hh ? 1024 : 0, offb = hh ? 1536 : 512;
  auto tile_body = [&](const f32x16& acc, int kt) -> bool {
    float sa = 0.f, sb = 0.f;
#pragma unroll
    for (int i = 0; i < 8; ++i) {
      sa = fmaf(w0[i], relu_i(acc[i]), sa);
      sb = fmaf(w1[i], relu_i(acc[8 + i]), sb);
    }
    const int key = kt * 32 + r;
    const bool pa = (key <= tqa) & (sa >= tha);
    const bool pb = (key <= tqb) & (sb >= thb);
    {
      const unsigned long long m = __builtin_amdgcn_ballot_w64(pa);
      const int nlo = __popc((unsigned)m), nhi = __popc((unsigned)(m >> 32));
      const int pos = (int)mbcnt64(m) + (hh ? cnt2 - nlo : cnt0);
      if (pa && pos < 512) { bkey[offa + pos] = __float_as_uint(sa); bidx[offa + pos] = (unsigned)key; }
      cnt0 += nlo; cnt2 += nhi;
    }
    {
      const unsigned long long m = __builtin_amdgcn_ballot_w64(pb);
      const int nlo = __popc((unsigned)m), nhi = __popc((unsigned)(m >> 32));
      const int pos = (int)mbcnt64(m) + (hh ? cnt3 - nlo : cnt1);
      if (pb && pos < 512) { bkey[offb + pos] = __float_as_uint(sb); bidx[offb + pos] = (unsigned)key; }
      cnt1 += nlo; cnt3 += nhi;
    }
    return (cnt0 > 448) | (cnt1 > 448) | (cnt2 > 448) | (cnt3 > 448);
  };
  {
    ush* tile = (ush*)(smem + 65536);
    __shared__ int s_need[2];
    const int lkey = t >> 3, lch = t & 7;
    const ush* gsrc = p.IK + (rowb + lkey) * 64 + lch * 8;
    const int npair = (ntile + 1) >> 1;
    const int lp = npair - 1;
    u32x4 g0 = *(const u32x4*)(gsrc), g1 = *(const u32x4*)(gsrc + 2048);
    if (t < 2) s_need[t] = 0;
    for (int kp = 0; kp < npair; ++kp) {
      __syncthreads();
      const int need = kp > 0 ? s_need[(kp - 1) & 1] : 0;
      *(u32x4*)(tile + lkey * 72 + lch * 8) = g0;
      *(u32x4*)(tile + (lkey + 32) * 72 + lch * 8) = g1;
      __syncthreads();
      if (t == 0 && kp > 0) s_need[(kp - 1) & 1] = 0;
      {
        const int pn = kp + 1 < lp ? kp + 1 : lp;
        g0 = *(const u32x4*)(gsrc + (size_t)pn * 4096);
        g1 = *(const u32x4*)(gsrc + (size_t)pn * 4096 + 2048);
      }
      if (need) {
        if (cnt0 > 320) { float th; compact16(bkey, bidx, cnt0, th, lane); if (hh == 0) tha = th; }
        if (cnt1 > 320) { float th; compact16(bkey + 512, bidx + 512, cnt1, th, lane); if (hh == 0) thb = th; }
        if (cnt2 > 320) { float th; compact16(bkey + 1024, bidx + 1024, cnt2, th, lane); if (hh == 1) tha = th; }
        if (cnt3 > 320) { float th; compact16(bkey + 1536, bidx + 1536, cnt3, th, lane); if (hh == 1) thb = th; }
      }
      bf16x8 bta[4], btb[4];
#pragma unroll
      for (int s = 0; s < 4; ++s) {
        bta[s] = *(const bf16x8*)(tile + r * 72 + s * 16 + hh * 8);
        btb[s] = *(const bf16x8*)(tile + (32 + r) * 72 + s * 16 + hh * 8);
      }
      f32x16 acca = zero16(), accb = zero16();
#pragma unroll
      for (int s = 0; s < 4; ++s) { acca = MFMA32(aq[s], bta[s], acca); accb = MFMA32(aq[s], btb[s], accb); }
      bool nd = tile_body(acca, 2 * kp);
      if (2 * kp + 1 < ntile) nd |= tile_body(accb, 2 * kp + 1);
      if (nd && lane == 0) s_need[kp & 1] = 1;
    }
    __syncthreads();
  }
  const bool lo = qsel != 2, hi = qsel != 1;
  int nsel_q[4] = {0, 0, 0, 0};
  {
    int c0 = cnt0 > 512 ? 512 : cnt0, c1 = cnt1 > 512 ? 512 : cnt1, c2 = cnt2 > 512 ? 512 : cnt2, c3 = cnt3 > 512 ? 512 : cnt3;
    if (lo) {
      nsel_q[0] = final_select(bkey, bidx, c0, lane);
      nsel_q[1] = final_select(bkey + 512, bidx + 512, c1, lane);
    }
    if (hi) {
      nsel_q[2] = final_select(bkey + 1024, bidx + 1024, c2, lane);
      nsel_q[3] = final_select(bkey + 1536, bidx + 1536, c3, lane);
    }
  }
  float* pbuf = (float*)bkey;
#pragma unroll
  for (int q = 0; q < 4; ++q) {
    if (q < 2 ? lo : hi) sparse_attn_query(p, rowb, rowb + tq0 + q, bidx + q * 512, nsel_q[q], pbuf, lane);
  }
}

DI void dn_norm(const Params& p, int wave, int nw, int lane) {
  const float4* nwp = (const float4*)(p.dnw + (lane & 15) * 8);
  const float4 n0 = nwp[0], n1 = nwp[1];
  for (int row0 = wave; row0 < NTOK; row0 += 4 * nw) {
    float4 a[4], c[4];
    u32x4 z[4];
#pragma unroll
    for (int j = 0; j < 4; ++j) {
      const int row = row0 + j * nw;
      const float4* op = (const float4*)(p.OD + (size_t)row * 512 + lane * 8);
      a[j] = op[0]; c[j] = op[1];
      z[j] = *(const u32x4*)(p.SZ + (size_t)row * 512 + lane * 8);
    }
#pragma unroll
    for (int j = 0; j < 4; ++j) {
      const int row = row0 + j * nw;
      float ss = a[j].x * a[j].x + a[j].y * a[j].y + a[j].z * a[j].z + a[j].w * a[j].w + c[j].x * c[j].x + c[j].y * c[j].y + c[j].z * c[j].z + c[j].w * c[j].w;
      ss += __shfl_xor(ss, 1); ss += __shfl_xor(ss, 2); ss += __shfl_xor(ss, 4); ss += __shfl_xor(ss, 8);
      const float rs = rsqrtf(ss * (1.f / 128.f) + 1e-6f);
      u32x4 o;
      o[0] = pack2(a[j].x * rs * n0.x * bflo(z[j][0]), a[j].y * rs * n0.y * bfhi(z[j][0]));
      o[1] = pack2(a[j].z * rs * n0.z * bflo(z[j][1]), a[j].w * rs * n0.w * bfhi(z[j][1]));
      o[2] = pack2(c[j].x * rs * n1.x * bflo(z[j][2]), c[j].y * rs * n1.y * bfhi(z[j][2]));
      o[3] = pack2(c[j].z * rs * n1.z * bflo(z[j][3]), c[j].w * rs * n1.w * bfhi(z[j][3]));
      *(u32x4*)(p.MIX + (size_t)row * 1024 + 512 + lane * 8) = o;
    }
  }
}

DI void dn_norm_rows(const Params& p, int row_base, int lane) {
  const float4* nwp = (const float4*)(p.dnw + (lane & 15) * 8);
  const float4 n0 = nwp[0], n1 = nwp[1];
#pragma unroll 1
  for (int r4 = 0; r4 < 16; r4 += 4) {
    float4 a[4], c[4];
    u32x4 z[4];
#pragma unroll
    for (int j = 0; j < 4; ++j) {
      const int row = row_base + r4 + j;
      const float4* op = (const float4*)(p.OD + (size_t)row * 512 + lane * 8);
      a[j] = op[0]; c[j] = op[1];
      z[j] = *(const u32x4*)(p.SZ + (size_t)row * 512 + lane * 8);
    }
#pragma unroll
    for (int j = 0; j < 4; ++j) {
      const int row = row_base + r4 + j;
      float ss = a[j].x * a[j].x + a[j].y * a[j].y + a[j].z * a[j].z + a[j].w * a[j].w + c[j].x * c[j].x + c[j].y * c[j].y + c[j].z * c[j].z + c[j].w * c[j].w;
      ss += __shfl_xor(ss, 1); ss += __shfl_xor(ss, 2); ss += __shfl_xor(ss, 4); ss += __shfl_xor(ss, 8);
      const float rs = rsqrtf(ss * (1.f / 128.f) + 1e-6f);
      u32x4 o;
      o[0] = pack2(a[j].x * rs * n0.x * bflo(z[j][0]), a[j].y * rs * n0.y * bfhi(z[j][0]));
      o[1] = pack2(a[j].z * rs * n0.z * bflo(z[j][1]), a[j].w * rs * n0.w * bfhi(z[j][1]));
      o[2] = pack2(c[j].x * rs * n1.x * bflo(z[j][2]), c[j].y * rs * n1.y * bfhi(z[j][2]));
      o[3] = pack2(c[j].z * rs * n1.z * bflo(z[j][3]), c[j].w * rs * n1.w * bfhi(z[j][3]));
      *(u32x4*)(p.MIX + (size_t)row * 1024 + 512 + lane * 8) = o;
    }
  }
}

DI void outproj_tile(const Params& p, int tile, char* smem) {
  const int mt = tile >> 3, nt = tile & 7;
  const int m0 = mt * 128, n0 = nt * 128;
  f32x16 acc[2][2];
  gemm_tile(p.MIX, p.Wo, m0, n0, 1024, smem, acc);
  (void)stage_rows(acc, smem);
  int t_ = threadIdx.x;
  asm volatile("" : "+v"(t_));
  const int t = t_, c4 = t & 31, r0 = t >> 5;
  const float* Cs = (const float*)smem;
#pragma unroll 4
  for (int ps = 0; ps < 16; ++ps) {
    const int rr = ps * 8 + r0;
    const float4 f = *(const float4*)(Cs + rr * 132 + c4 * 4);
    const size_t off = (size_t)(m0 + rr) * 1024 + n0 + c4 * 4;
    const float4 xv = *(const float4*)(p.x + off);
    *(float4*)(p.out + off) = make_float4(xv.x + f.x, xv.y + f.y, xv.z + f.z, xv.w + f.w);
  }
}

#define XB_TMO      128
#define XB_XCNT(j)  (256  + 64 * (j))
#define XB_XSUB(j)  (1280 + 64 * (j))
#define XB_XGEN(j)  (2304 + 64 * (j))
#define XB_TOP      3328
#define XB_TOPGEN   3392
#define XCD_BAR_WORDS 3456
#define XB_SPIN_CAP (1u << 20)
#define LAS __attribute__((address_space(3)))
DI unsigned xb_ld(unsigned* p) { return __hip_atomic_load(p, __ATOMIC_RELAXED, __HIP_MEMORY_SCOPE_AGENT); }
DI unsigned xb_add(unsigned* p, unsigned v) { return __hip_atomic_fetch_add(p, v, __ATOMIC_RELAXED, __HIP_MEMORY_SCOPE_AGENT); }
DI unsigned xb_xcc_id() { return (unsigned)__builtin_amdgcn_s_getreg((3 << 11) | 20) & 0xFu; }
#define XB_SPIN(cond, bar) do { unsigned _sp = 0; while (cond) { __builtin_amdgcn_s_sleep(1); \
    if ((++_sp & 255u) == 0u) { if (xb_ld(&(bar)[XB_TMO])) break; if (_sp > XB_SPIN_CAP) { atomicAdd(&(bar)[XB_TMO], 1u); break; } } } } while (0)
struct XcdBarrier { unsigned* bar; unsigned x; volatile LAS unsigned* st; };
DI XcdBarrier xcd_barrier_post(unsigned* bar, volatile LAS unsigned* st) {
  XcdBarrier b; b.bar = bar; b.x = xb_xcc_id(); b.st = st;
  if (threadIdx.x == 0) (void)xb_add(&bar[XB_XCNT(b.x)], 1u);
  return b;
}
DI void xcd_barrier_complete(unsigned* bar, unsigned x, unsigned& nloc, unsigned& nx) {
  const unsigned G = gridDim.x * gridDim.y * gridDim.z;
  unsigned sum, cnt, mine, sp = 0u;
  for (;;) {
    sum = 0u; cnt = 0u; mine = 0u;
#pragma unroll
    for (unsigned j = 0; j < 16; ++j) { const unsigned c = xb_ld(&bar[XB_XCNT(j)]); sum += c; cnt += (c > 0u) ? 1u : 0u; mine = (j == x) ? c : mine; }
    if (sum == G) break;
    __builtin_amdgcn_s_sleep(1);
    if ((++sp & 255u) == 0u) { if (xb_ld(&bar[XB_TMO])) break; if (sp > XB_SPIN_CAP) { atomicAdd(&bar[XB_TMO], 1u); break; } }
  }
  nloc = mine > 0u ? mine : 1u; nx = cnt > 0u ? cnt : 1u;
}
DI void xcd_barrier(const XcdBarrier& b) {
  asm volatile("s_waitcnt vmcnt(0)" ::: "memory");
  __syncthreads();
  if (threadIdx.x == 0) {
    unsigned* bar = b.bar;
    __builtin_amdgcn_s_waitcnt(0);
    unsigned nloc = b.st[0], nx = b.st[1];
    if (nloc == 0u) { xcd_barrier_complete(bar, b.x, nloc, nx); b.st[0] = nloc; b.st[1] = nx; }
    const unsigned old = xb_add(&bar[XB_XSUB(b.x)], 1u);
    const unsigned gen = old / nloc;
    if (old + 1u == (gen + 1u) * nloc) {
      __builtin_amdgcn_fence(__ATOMIC_RELEASE, "agent");
      asm volatile("s_waitcnt vmcnt(0)" ::: "memory");
      const unsigned og = xb_add(&bar[XB_TOP], 1u);
      const unsigned tg = og / nx;
      if (og + 1u == (tg + 1u) * nx) xb_add(&bar[XB_TOPGEN], 1u);
      else XB_SPIN(xb_ld(&bar[XB_TOPGEN]) == tg, bar);
      __builtin_amdgcn_fence(__ATOMIC_ACQUIRE, "agent");
      xb_add(&bar[XB_XGEN(b.x)], 1u);
      asm volatile("s_waitcnt vmcnt(0)" ::: "memory");
    } else {
      XB_SPIN(xb_ld(&bar[XB_XGEN(b.x)]) == gen, bar);
      __builtin_amdgcn_fence(__ATOMIC_ACQUIRE, "agent");
      asm volatile("s_waitcnt vmcnt(0)" ::: "memory");
    }
  }
  __syncthreads();
}

__global__ void __launch_bounds__(256, 2) k_prep(Params p) {
  __shared__ __attribute__((aligned(16))) char smem[SMEM_BYTES];
  phase_prep(p, blockIdx.x * 256 + threadIdx.x, gridDim.x * 256, smem);
}
__global__ void __launch_bounds__(256, 2) k_inproj(Params p) {
  __shared__ __attribute__((aligned(16))) char smem[SMEM_BYTES];
  for (int tile = blockIdx.x; tile < 128 * 37; tile += gridDim.x) inproj_tile(p, tile, smem);
}
__global__ void __launch_bounds__(256, 2) k_dnprep(Params p) {
  __shared__ __attribute__((aligned(16))) char smem[SMEM_BYTES];
  for (int task = blockIdx.x; task < 1024; task += gridDim.x) dn_prep_task(p, task, smem);
}
__global__ void __launch_bounds__(256, 2) k_scan(Params p) {
  __shared__ __attribute__((aligned(16))) char smem[SMEM_BYTES];
  dn_scan(p, blockIdx.x, smem);
}
__global__ void __launch_bounds__(256, 2) k_attn(Params p) {
  __shared__ __attribute__((aligned(16))) char smem[SMEM_BYTES];
  for (int task = blockIdx.x; task < 1024; task += gridDim.x) attn_task(p, task, smem);
}
__global__ void __launch_bounds__(256, 2) k_dnnorm(Params p) {
  dn_norm(p, (blockIdx.x * 256 + threadIdx.x) >> 6, (gridDim.x * 256) >> 6, threadIdx.x & 63);
}
__global__ void __launch_bounds__(256, 2) k_outproj(Params p) {
  __shared__ __attribute__((aligned(16))) char smem[SMEM_BYTES];
  for (int tile = blockIdx.x; tile < 1024; tile += gridDim.x) outproj_tile(p, tile, smem);
}

__global__ void __launch_bounds__(256, 2) k_mega(Params p) {
  __shared__ __attribute__((aligned(16))) char smem[SMEM_BYTES];
  __shared__ uint4 xb_words;
  __shared__ int s_task;
  cg::grid_group grid = cg::this_grid();
  if (threadIdx.x == 0) xb_words = make_uint4(0u, 0u, 0u, 0u);
  __syncthreads();
  XcdBarrier xb = xcd_barrier_post(p.counters + 64, (volatile LAS unsigned*)&xb_words);
  const int gtid = blockIdx.x * 256 + threadIdx.x, gsize = gridDim.x * 256;
  phase_prep(p, gtid, gsize, smem);
  if (p.use_cg_sync) grid.sync();
  xcd_barrier(xb);
  for (int tile = blockIdx.x; tile < 128 * 19; tile += gridDim.x) gemm_tile256<0>(p, tile, smem);
  xcd_barrier(xb);
  for (int task = blockIdx.x; task < 1024; task += gridDim.x) dn_prep_task(p, task, smem);
  xcd_barrier(xb);
  if (blockIdx.x < 32) {
    __builtin_amdgcn_s_setprio(3);
    dn_scan(p, blockIdx.x, smem);
    __builtin_amdgcn_s_setprio(0);
    asm volatile("s_waitcnt vmcnt(0)" ::: "memory");
    __syncthreads();
    if (threadIdx.x == 0) {
      __builtin_amdgcn_fence(__ATOMIC_RELEASE, "agent");
      asm volatile("s_waitcnt vmcnt(0)" ::: "memory");
      atomicAdd(&p.counters[32], 1u);
    }
    __syncthreads();
  }
  {
    int pb = (int)((xb.x >> 2) & 1u);
    int tries = 0;
    while (tries < 2) {
      if (threadIdx.x == 0) s_task = (int)atomicAdd(&p.counters[pb], 1u);
      __syncthreads();
      const int tk = s_task;
      __syncthreads();
      if (tk >= 512 + QSPLIT) { pb ^= 1; ++tries; continue; }
      if (tk < 512 - QSPLIT) attn_task(p, tk * 2 + pb, smem, 0);
      else { const int j = tk - (512 - QSPLIT); attn_task(p, ((512 - QSPLIT) + (j >> 1)) * 2 + pb, smem, 1 + (j & 1)); }
    }
  }
  {
    if (threadIdx.x == 0) {
      unsigned sp = 0;
      while (__hip_atomic_load(&p.counters[32], __ATOMIC_RELAXED, __HIP_MEMORY_SCOPE_AGENT) < 32u) {
        __builtin_amdgcn_s_sleep(4);
        if (++sp > (1u << 22)) break;
      }
      __builtin_amdgcn_fence(__ATOMIC_ACQUIRE, "agent");
      asm volatile("s_waitcnt vmcnt(0)" ::: "memory");
    }
    __syncthreads();
    while (true) {
      if (threadIdx.x == 0) s_task = (int)atomicAdd(&p.counters[33], 1u);
      __syncthreads();
      const int ck = s_task;
      __syncthreads();
      if (ck >= 256) break;
      int tn_ = threadIdx.x;
      asm volatile("" : "+v"(tn_));
      dn_norm_rows(p, ck * 64 + (tn_ >> 6) * 16, tn_ & 63);
    }
  }
  xcd_barrier(xb);
  for (int tile = blockIdx.x; tile < 512; tile += gridDim.x) gemm_tile256<1>(p, tile, smem);
}

extern "C" void kernel_launch(void* const* d_in, const int* in_sizes, int n_in, void* d_out, int out_size, void* d_ws,
                              size_t ws_size, hipStream_t stream) {
  Params p{};
  p.x = (const float*)d_in[0]; p.ln_w = (const float*)d_in[1]; p.w_in = (const float*)d_in[2];
  p.aqw = (const float*)d_in[3]; p.akw = (const float*)d_in[4]; p.ikw = (const float*)d_in[5];
  p.ikb = (const float*)d_in[6]; p.convw = (const float*)d_in[7]; p.alog = (const float*)d_in[8];
  p.dtb = (const float*)d_in[9]; p.dnw = (const float*)d_in[10]; p.w_out = (const float*)d_in[11];
  p.out = (float*)d_out;
  char* ws = (char*)d_ws;
  const size_t MB = 1u << 20;
  p.Wt = (ush*)(ws + 0);
  p.Wo = (ush*)(ws + 10 * MB);
  p.XB = (ush*)(ws + 12 * MB);
  p.MIX = (ush*)(ws + 12 * MB);
  p.QA = (ush*)(ws + 45 * MB); p.KA = (ush*)(ws + 61 * MB); p.VA = (ush*)(ws + 77 * MB);
  p.GA = (ush*)(ws + 93 * MB); p.IQ = (ush*)(ws + 109 * MB); p.DQ = (ush*)(ws + 125 * MB);
  p.DK = (ush*)(ws + 141 * MB); p.DV = (ush*)(ws + 157 * MB); p.SZ = (ush*)(ws + 173 * MB);
  p.IK = (ush*)(ws + 189 * MB);
  p.IW = (float*)(ws + 191 * MB);
  p.BETA = (float*)(ws + 191 * MB + 512 * 1024);
  p.G = (float*)(ws + 191 * MB + 768 * 1024);
  p.INTRA = (ush*)(ws + 192 * MB);
  p.GL = (float*)(ws + 200 * MB);
  p.OD = (float*)(ws + 201 * MB);
  p.counters = (unsigned*)(ws + 233 * MB);
  p.K8 = (unsigned char*)(ws + 61 * MB);
  p.V8 = (unsigned char*)(ws + 77 * MB);
  char* o8 = (char*)d_out;
  p.UT = (ush*)(o8); p.WG = (ush*)(o8 + 16 * MB); p.QG = (ush*)(o8 + 32 * MB); p.KDT = (ush*)(o8 + 48 * MB);

#if MEGA
  static int grid_blocks = 0;
  if (!grid_blocks) {
    int dev = 0, cus = 0, per_cu = 0;
    hipGetDevice(&dev);
    hipDeviceGetAttribute(&cus, hipDeviceAttributeMultiprocessorCount, dev);
    hipOccupancyMaxActiveBlocksPerMultiprocessor(&per_cu, k_mega, 256, 0);
    if (per_cu > 2) per_cu = 2;
    grid_blocks = cus * per_cu;
  }
  hipMemsetAsync(p.counters, 0, (64 + XCD_BAR_WORDS) * sizeof(unsigned), stream);
  void* args[] = {&p};
  hipError_t e = hipLaunchCooperativeKernel((void*)k_mega, dim3(grid_blocks), dim3(256), args, 0, stream);
  if (e != hipSuccess) fprintf(stderr, "cooperative launch failed: %s (grid %d)\n", hipGetErrorString(e), grid_blocks);
#else
  k_prep<<<1024, 256, 0, stream>>>(p);
  k_inproj<<<128 * 37, 256, 0, stream>>>(p);
  k_dnprep<<<1024, 256, 0, stream>>>(p);
  k_scan<<<32, 256, 0, stream>>>(p);
  k_attn<<<1024, 256, 0, stream>>>(p);
  k_dnnorm<<<1024, 256, 0, stream>>>(p);
  k_outproj<<<1024, 256, 0, stream>>>(p);
#endif
}
```
